# Optimizing an MI355X kernel written in HIP

```python
import jax, jax.numpy as jnp
from jax import lax
import numpy as np


D_MODEL = 1024
BATCH = 2
SEQ = 8192
DEPTH = 2

GRID_W = 64
CTX_LEN = 256
N_MOD = 9
NA_HEADS = 8
HEAD_DIM = 64
NA_WIDTH = NA_HEADS * HEAD_DIM
NA_KH = 8
NA_KW = 16
POOL_GROUPS = 4
POOL_CH = 128
POOL_WIDTH = POOL_GROUPS * POOL_CH
POOL_WINDOWS = (2, 4, 8, 16)
MIX_WIDTH = NA_WIDTH + POOL_WIDTH
IN_WIDTH = 3 * NA_WIDTH + POOL_WIDTH
D_FF = 2816
ROPE_THETA = 10000.0
ROPE_PAIRS = HEAD_DIM // 4
RMS_EPS = 1e-6
NEG_INF = -1e30

kernel_name = 'hybrid_na_pool_macaron_dit_block'


def rms_norm(x, g):
    xf = x.astype(jnp.float32)
    y = xf * lax.rsqrt(jnp.mean(xf * xf, axis=-1, keepdims=True) + RMS_EPS)
    return (y * g.astype(jnp.float32)).astype(x.dtype)


def modulate(h, shift, scale):
    return h * (1.0 + scale) + shift


def mod_vectors(cvec, w_mod, b_mod):
    m = jax.nn.silu(cvec) @ w_mod + b_mod
    return jnp.split(m, N_MOD, axis=-1)


def swiglu(h, w_gate_up, w_down):
    gate, up = jnp.split(h @ w_gate_up, 2, axis=-1)
    return (jax.nn.silu(gate) * up) @ w_down


def sandwich_ffn(x, w_gate_up, w_down, g_pre, g_post, shift, scale, gate):
    h = modulate(rms_norm(x, g_pre), shift, scale)
    return x + 0.5 * gate * rms_norm(swiglu(h, w_gate_up, w_down), g_post)


def axial_rope(x, rows):
    seq = rows * GRID_W
    t = jnp.arange(seq)
    inv = ROPE_THETA ** (-jnp.arange(ROPE_PAIRS, dtype=jnp.float32) / ROPE_PAIRS)

    def rot(xa, pos):
        ang = pos.astype(jnp.float32)[:, None] * inv
        cos = jnp.cos(ang)[:, None, :]
        sin = jnp.sin(ang)[:, None, :]
        x1, x2 = jnp.split(xa, 2, axis=-1)
        return jnp.concatenate([x1 * cos - x2 * sin, x2 * cos + x1 * sin], axis=-1)

    xr, xc = jnp.split(x.astype(jnp.float32), 2, axis=-1)
    return jnp.concatenate([rot(xr, t // GRID_W), rot(xc, t % GRID_W)], axis=-1).astype(x.dtype)


def neighbourhood_attention(q, k, v, kc, vc, rpb, rows):
    b, s, h, dh = q.shape
    kh = min(NA_KH, rows)
    scale = dh ** -0.5
    q = q.reshape(b, rows, GRID_W, h, dh)
    k = k.reshape(b, rows, GRID_W, h, dh)
    v = v.reshape(b, rows, GRID_W, h, dh)
    r = np.arange(rows)
    row_start = np.clip(r - kh // 2, 0, rows - kh)
    row_idx = row_start[:, None] + np.arange(kh)[None, :]
    k_blk = k[:, row_idx]
    v_blk = v[:, row_idx]
    j = np.arange(GRID_W)
    col_start = np.clip(j - NA_KW // 2, 0, GRID_W - NA_KW)
    col_valid = (j[None, :] >= col_start[:, None]) & (j[None, :] < col_start[:, None] + NA_KW)
    dr = row_idx - r[:, None]
    dc = np.clip(j[None, :] - j[:, None] + NA_KW - 1, 0, 2 * NA_KW - 2)
    bias = rpb[:, dr + NA_KH - 1]
    bias = bias[..., dc]
    bias = jnp.transpose(bias, (0, 1, 3, 2, 4)).astype(jnp.float32)
    s_loc = jnp.einsum('brqhd,brkchd->bhrqkc', q, k_blk, preferred_element_type=jnp.float32) * scale
    s_loc = jnp.where(col_valid[:, None, :], s_loc + bias, NEG_INF)
    s_ctx = jnp.einsum('brqhd,bkhd->bhrqk', q, kc, preferred_element_type=jnp.float32) * scale
    n_loc = kh * GRID_W
    scores = jnp.concatenate([s_loc.reshape(b, h, rows, GRID_W, n_loc), s_ctx], axis=-1)
    p = jax.nn.softmax(scores, axis=-1).astype(v.dtype)
    p_loc = p[..., :n_loc].reshape(b, h, rows, GRID_W, kh, GRID_W)
    p_ctx = p[..., n_loc:]
    o = jnp.einsum('bhrqkc,brkchd->brqhd', p_loc, v_blk) + jnp.einsum('bhrqk,bkhd->brqhd', p_ctx, vc)
    return o.reshape(b, s, h * dh)


def context_attention(q, k, v):
    b, l, h, dh = q.shape
    sc = jnp.einsum('bqhd,bkhd->bhqk', q, k, preferred_element_type=jnp.float32) * dh ** -0.5
    p = jax.nn.softmax(sc, axis=-1).astype(v.dtype)
    return jnp.einsum('bhqk,bkhd->bqhd', p, v).reshape(b, l, h * dh)


def pool_mix(u, w_pool, pool_scale):
    length = u.shape[-2]
    ug = u.reshape(u.shape[:-1] + (POOL_GROUPS, POOL_CH))
    uf = ug.astype(jnp.float32)
    cs = jnp.cumsum(uf, axis=-3)
    pad = [(0, 0)] * cs.ndim
    pad[-3] = (1, 0)
    cs = jnp.pad(cs, pad)
    t = np.arange(length)
    outs = []
    for g, w in enumerate(POOL_WINDOWS):
        lo = np.clip(t - w // 2, 0, length)
        hi = np.clip(t - w // 2 + w, 0, length)
        cnt = (hi - lo).astype(np.float32)[:, None]
        csg = cs[..., g, :]
        outs.append((jnp.take(csg, hi, axis=-2) - jnp.take(csg, lo, axis=-2)) / cnt)
    pooled = jnp.stack(outs, axis=-2)
    d = (pooled - uf).astype(u.dtype)
    y = jnp.einsum('...gc,gcd->...gd', d, w_pool) * pool_scale.reshape(POOL_GROUPS, POOL_CH)
    return y.reshape(u.shape)


def token_mix(hx, hc, w_in, w_out, rpb, w_pool, pool_scale, with_ctx_out):
    b, s, _ = hx.shape
    rows = s // GRID_W
    l = hc.shape[1]
    qx, kx, vx, ux = jnp.split(hx @ w_in, [NA_WIDTH, 2 * NA_WIDTH, 3 * NA_WIDTH], axis=-1)
    if with_ctx_out:
        qc, kc, vc, uc = jnp.split(hc @ w_in, [NA_WIDTH, 2 * NA_WIDTH, 3 * NA_WIDTH], axis=-1)
    else:
        kc, vc = jnp.split(hc @ w_in[:, NA_WIDTH:3 * NA_WIDTH], 2, axis=-1)
    heads = lambda t, n: t.reshape(b, n, NA_HEADS, HEAD_DIM)
    qx = axial_rope(heads(qx, s), rows)
    kx = axial_rope(heads(kx, s), rows)
    kc_h, vc_h = heads(kc, l), heads(vc, l)
    na_x = neighbourhood_attention(qx, kx, heads(vx, s), kc_h, vc_h, rpb, rows)
    pool_x = pool_mix(ux.reshape(b, rows, GRID_W, POOL_WIDTH), w_pool, pool_scale).reshape(b, s, POOL_WIDTH)
    out_x = jnp.concatenate([na_x, pool_x], axis=-1) @ w_out
    if with_ctx_out:
        na_c = context_attention(heads(qc, l), kc_h, vc_h)
        pool_c = pool_mix(uc, w_pool, pool_scale)
        out_c = jnp.concatenate([na_c, pool_c], axis=-1) @ w_out
        return out_x, out_c
    return out_x, None


def setup_inputs(seed: int = 0) -> dict:
    key = jax.random.key(seed)
    ks = jax.random.split(key, 14)
    nrm = jax.random.normal
    f32 = jnp.float32
    return {
        'x': nrm(ks[0], (BATCH, SEQ, D_MODEL), f32),
        'c': nrm(ks[1], (BATCH, D_MODEL), f32),
        'ctx': nrm(ks[2], (BATCH, CTX_LEN, D_MODEL), f32),
        'c_ctx': nrm(ks[3], (D_MODEL,), f32),
        'w_mod': nrm(ks[4], (DEPTH, D_MODEL, N_MOD * D_MODEL), f32) * (0.5 * D_MODEL ** -0.5),
        'b_mod': nrm(ks[5], (DEPTH, N_MOD * D_MODEL), f32) * 0.01,
        'norm_g': 1.0 + 0.05 * nrm(ks[6], (DEPTH, 6, D_MODEL), f32),
        'w_ffn_gate_up': nrm(ks[7], (DEPTH, 2, D_MODEL, 2 * D_FF), f32) * D_MODEL ** -0.5,
        'w_ffn_down': nrm(ks[8], (DEPTH, 2, D_FF, D_MODEL), f32) * D_FF ** -0.5,
        'w_in': nrm(ks[9], (DEPTH, D_MODEL, IN_WIDTH), f32) * D_MODEL ** -0.5,
        'w_out': nrm(ks[10], (DEPTH, MIX_WIDTH, D_MODEL), f32) * MIX_WIDTH ** -0.5,
        'na_rpb': nrm(ks[11], (DEPTH, NA_HEADS, 2 * NA_KH - 1, 2 * NA_KW - 1), f32) * 0.1,
        'w_pool': nrm(ks[12], (DEPTH, POOL_GROUPS, POOL_CH, POOL_CH), f32) * POOL_CH ** -0.5,
        'pool_scale': 1.0 + 0.05 * nrm(ks[13], (DEPTH, POOL_WIDTH), f32),
    }


def reference(x, c, ctx, c_ctx, w_mod, b_mod, norm_g, w_ffn_gate_up, w_ffn_down, w_in, w_out, na_rpb, w_pool, pool_scale):
    for l in range(DEPTH):
        last = l == DEPTH - 1
        mx = [m[:, None, :] for m in mod_vectors(c, w_mod[l], b_mod[l])]
        mc = mod_vectors(c_ctx, w_mod[l], b_mod[l])
        g = norm_g[l]
        x = sandwich_ffn(x, w_ffn_gate_up[l, 0], w_ffn_down[l, 0], g[0], g[1], mx[0], mx[1], mx[2])
        ctx = sandwich_ffn(ctx, w_ffn_gate_up[l, 0], w_ffn_down[l, 0], g[0], g[1], mc[0], mc[1], mc[2])
        hx = modulate(rms_norm(x, g[2]), mx[3], mx[4])
        hc = modulate(rms_norm(ctx, g[2]), mc[3], mc[4])
        out_x, out_c = token_mix(hx, hc, w_in[l], w_out[l], na_rpb[l], w_pool[l], pool_scale[l], not last)
        x = x + mx[5] * rms_norm(out_x, g[3])
        x = sandwich_ffn(x, w_ffn_gate_up[l, 1], w_ffn_down[l, 1], g[4], g[5], mx[6], mx[7], mx[8])
        if not last:
            ctx = ctx + mc[5] * rms_norm(out_c, g[3])
            ctx = sandwich_ffn(ctx, w_ffn_gate_up[l, 1], w_ffn_down[l, 1], g[4], g[5], mc[6], mc[7], mc[8])
    return x
```

```cpp
#include <hip/hip_runtime.h>
#include <hip/hip_cooperative_groups.h>
#include <cstdio>
#include <cstdint>
namespace cg = cooperative_groups;
namespace pg8 {
#define PG8_LAS __attribute__((address_space(3)))
typedef unsigned short bf16_t;
typedef short bf16x8 __attribute__((ext_vector_type(8)));
typedef float f32x4 __attribute__((ext_vector_type(4)));
typedef unsigned u32x4 __attribute__((ext_vector_type(4)));
constexpr int BM = 256, BK = 64, HALF = 128, HTB = HALF * BK * 2  , STAGE_BYTES = 8 * HTB, NXCD = 8, WGM = 8;

__host__ __device__ __forceinline__ int lds_byte(int r, int c) { const int st = (r >> 4) * 2 + (c >> 5), rr = r & 15, cc = c & 31, ob = rr * 64 + cc * 2; return st * 1024 + (ob ^ (((ob >> 9) & 1) << 5)); }
__host__ __device__ __forceinline__ void stage_rc(int b, int& R, int& C) { const int st = b / 1024, sb = b % 1024, swz = sb ^ (((sb >> 9) & 1) << 5); R = (st >> 1) * 16 + swz / 64; C = (st & 1) * 32 + (swz % 64) / 2; }
__host__ __device__ __forceinline__ int perm32(int rho) { const int n = rho >> 4, i = rho & 15; return 8 * (i >> 2) + 4 * n + (i & 3); }

struct Unit { int pm, pn, kb; };
struct Gemm { const bf16_t* A; const bf16_t* Bt; int M, N, K, ld; };

struct StaticOrder {
    int nM, nN, nwg, G, c, pm0, ksplit, ntp;
    __host__ __device__ void init(int M, int N, int G_, int c_, int pm0_ = 0, int ksplit_ = 1, int ntp_ = 0) { nM = M / BM; nN = N / BM; nwg = nM * nN * ksplit_; G = G_; c = c_; pm0 = pm0_; ksplit = ksplit_; ntp = ntp_; }
    __host__ __device__ bool next(int i, Unit& u) const {
        const long L = (long)i * G + c; if (L >= nwg) return false;
        int wgid = (int)L; u.kb = (wgid % ksplit) * ntp; wgid /= ksplit; { const int nwg = nM * nN; const int q = nwg / NXCD, r = nwg % NXCD, xcd = wgid % NXCD, off = wgid / NXCD; wgid = (xcd < r ? xcd * (q + 1) : r * (q + 1) + (xcd - r) * q) + off; }
        const int nig = WGM * nN, gid = wgid / nig, fm = gid * WGM, gsz = (nM - fm) < WGM ? (nM - fm) : WGM;
        u.pm = pm0 + fm + ((wgid % nig) % gsz); u.pn = (wgid % nig) / gsz; return true;
    }
    __device__ __forceinline__ void a_ready(const Unit&) const {}
    __device__ __forceinline__ void done(const Unit&) const {}
};

__device__ __forceinline__ unsigned cvt_pk_bf16(float lo, float hi) { unsigned r; asm volatile("v_cvt_pk_bf16_f32 %0, %1, %2" : "=v"(r) : "v"(lo), "v"(hi)); return r; }
typedef float f32x2 __attribute__((ext_vector_type(2)));
template <class Epi, class Sched, bool ALIGN_EPI = false, bool SP2 = false>
__device__ __forceinline__ void gemm_phase(PG8_LAS unsigned char* lds, const Gemm g, const Sched& S, const Epi& E) {
    int tid_raw = threadIdx.x; asm volatile("" : "+v"(tid_raw));
    const int tid = tid_raw, wid = __builtin_amdgcn_readfirstlane(tid >> 6), lane = tid & 63, wr = wid >> 2, wc = wid & 3, fr = lane & 15, fq = lane >> 4;
    const int K = g.ld, nt = g.K / BK;
    unsigned voffA[2], voffB[2];
#pragma unroll
    for (int i = 0; i < 2; ++i) { int R, C; stage_rc(tid * 16 + i * 8192, R, C); const int Rb = E.perm ? ((R & ~31) + perm32(R & 31)) : R;
        voffA[i] = (unsigned)(R * K + C) * 2u; voffB[i] = (unsigned)(Rb * K + C) * 2u; }
    const size_t kstep = (size_t)(BK * 2);
    const size_t hstep = (size_t)HALF * K * 2;
    const size_t tstep = 2 * hstep;
    const unsigned ldsw = (unsigned)wid * 1024u;
    const int aoff = lds_byte(wr * 64 + fr, fq * 8), boff = lds_byte(wc * 32 + fr, fq * 8);
#define PG8_SA(b, h) (((b) * 2 + (h)) * HTB)
#define PG8_SB(b, h) ((4 + (b) * 2 + (h)) * HTB)
#define PG8_STAGE(bufoff, gbase, voff) do { _Pragma("unroll") for (int _i = 0; _i < 2; ++_i) \
        __builtin_amdgcn_global_load_lds((const unsigned*)((const char*)(gbase) + (voff)[_i]), (PG8_LAS unsigned*)(lds + (bufoff) + ldsw + _i * 8192), 16, 0, 0); } while (0)
#define PG8_LDA(dst, b, h) do { _Pragma("unroll") for (int m = 0; m < 4; ++m) _Pragma("unroll") for (int k = 0; k < 2; ++k) dst[m][k] = *(const PG8_LAS bf16x8*)(lds + PG8_SA(b, h) + aoff + m * 2048 + k * 1024); } while (0)
#define PG8_LDB(dst, b, h) do { _Pragma("unroll") for (int n = 0; n < 2; ++n) _Pragma("unroll") for (int k = 0; k < 2; ++k) dst[n][k] = *(const PG8_LAS bf16x8*)(lds + PG8_SB(b, h) + boff + n * 2048 + k * 1024); } while (0)
#define PG8_MMA(ai, bj, At, Bt) do { __builtin_amdgcn_s_setprio(1); _Pragma("unroll") for (int m = 0; m < 4; ++m) _Pragma("unroll") for (int n = 0; n < 2; ++n) _Pragma("unroll") for (int k = 0; k < 2; ++k) \
        acc[ai][bj][m][n] = __builtin_amdgcn_mfma_f32_16x16x32_bf16(Bt[n][k], At[m][k], acc[ai][bj][m][n], 0, 0, 0); __builtin_amdgcn_s_setprio(0); } while (0)
#define PG8_WAIT_V(n) asm volatile("s_waitcnt vmcnt(" #n ")" ::: "memory")
#define PG8_WAIT_L(n) asm volatile("s_waitcnt lgkmcnt(" #n ")" ::: "memory")
#define PG8_BAR __builtin_amdgcn_s_barrier()
#define PG8_SCHED __builtin_amdgcn_sched_barrier(0)
    Unit cur, nxt; int ui = 0;
    if (!S.next(0, cur)) return;
    f32x4 acc[2][2][4][2];
#pragma unroll
    for (int a = 0; a < 2; ++a)
#pragma unroll
        for (int b = 0; b < 2; ++b)
#pragma unroll
            for (int m = 0; m < 4; ++m)
#pragma unroll
                for (int n = 0; n < 2; ++n) acc[a][b][m][n] = (f32x4){0.f, 0.f, 0.f, 0.f};
    bf16x8 At[4][2], B0[2][2], B1[2][2];
    const char* cA = (const char*)g.A + (size_t)cur.pm * tstep + (size_t)cur.kb * (BK * 2); const char* cB = (const char*)g.Bt + (size_t)cur.pn * tstep + (size_t)cur.kb * (BK * 2);
    S.a_ready(cur);
    if constexpr (SP2) {
        PG8_STAGE(PG8_SB(0, 0), cB, voffB); PG8_STAGE(PG8_SB(0, 1), cB + hstep, voffB); PG8_STAGE(PG8_SA(0, 0), cA, voffA); PG8_STAGE(PG8_SA(0, 1), cA + hstep, voffA);
        if (wr == 1) PG8_BAR;
        PG8_WAIT_V(2); PG8_BAR;
        PG8_STAGE(PG8_SB(1, 0), cB + kstep, voffB); PG8_STAGE(PG8_SA(1, 0), cA + kstep, voffA); PG8_STAGE(PG8_SB(1, 1), cB + hstep + kstep, voffB);
        PG8_WAIT_V(6); PG8_BAR;
    } else {
        PG8_STAGE(PG8_SB(0, 0), cB, voffB); PG8_STAGE(PG8_SA(0, 0), cA, voffA); PG8_STAGE(PG8_SB(0, 1), cB + hstep, voffB); PG8_STAGE(PG8_SA(0, 1), cA + hstep, voffA);
        if (wr == 1) PG8_BAR;
        PG8_WAIT_V(4); PG8_BAR;
        PG8_STAGE(PG8_SB(1, 0), cB + kstep, voffB); PG8_STAGE(PG8_SA(1, 0), cA + kstep, voffA); PG8_STAGE(PG8_SB(1, 1), cB + hstep + kstep, voffB);
        PG8_WAIT_V(6); PG8_BAR;
    }
    for (;;) {
        const bool has_next = S.next(ui + 1, nxt);
        const char* nA = has_next ? (const char*)g.A + (size_t)nxt.pm * tstep + (size_t)nxt.kb * (BK * 2) : cA; const char* nB = has_next ? (const char*)g.Bt + (size_t)nxt.pn * tstep + (size_t)nxt.kb * (BK * 2) : cB;
        for (int t = 0; t < nt; t += 2) {
            const bool last = (t == nt - 2);
            const char* a1 = cA + (size_t)(t + 1) * kstep;
            const char* a2 = last ? nA : cA + (size_t)(t + 2) * kstep; const char* b2 = last ? nB : cB + (size_t)(t + 2) * kstep;
            const char* a3 = a2 + kstep; const char* b3 = b2 + kstep;
            if (last && has_next) S.a_ready(nxt);
            if constexpr (SP2) {
            PG8_LDB(B0, 0, 0); PG8_LDB(B1, 0, 1); PG8_SCHED; PG8_LDA(At, 0, 0); PG8_STAGE(PG8_SA(1, 1), a1 + hstep, voffA);
            PG8_WAIT_V(8); PG8_WAIT_L(0); PG8_BAR; PG8_MMA(0, 0, At, B0); PG8_MMA(0, 1, At, B1); PG8_BAR; PG8_SCHED;
            PG8_LDA(At, 0, 1); PG8_STAGE(PG8_SB(0, 0), b2, voffB); PG8_STAGE(PG8_SB(0, 1), b2 + hstep, voffB); PG8_STAGE(PG8_SA(0, 0), a2, voffA);
            PG8_WAIT_V(8); PG8_WAIT_L(0); PG8_BAR; PG8_MMA(1, 0, At, B0); PG8_MMA(1, 1, At, B1); PG8_BAR; PG8_SCHED;
            PG8_LDB(B0, 1, 0); PG8_LDB(B1, 1, 1); PG8_SCHED; PG8_LDA(At, 1, 0); PG8_STAGE(PG8_SA(0, 1), a2 + hstep, voffA);
            PG8_WAIT_V(8); PG8_WAIT_L(0); PG8_BAR; PG8_MMA(0, 0, At, B0); PG8_MMA(0, 1, At, B1); PG8_BAR; PG8_SCHED;
            PG8_LDA(At, 1, 1); PG8_STAGE(PG8_SB(1, 0), b3, voffB); PG8_STAGE(PG8_SB(1, 1), b3 + hstep, voffB); PG8_STAGE(PG8_SA(1, 0), a3, voffA);
            PG8_WAIT_V(8); PG8_WAIT_L(0); PG8_BAR; PG8_MMA(1, 0, At, B0); PG8_MMA(1, 1, At, B1); PG8_BAR; PG8_SCHED;
            } else {
            PG8_LDB(B0, 0, 0); PG8_SCHED; PG8_LDA(At, 0, 0); PG8_STAGE(PG8_SA(1, 1), a1 + hstep, voffA);
            PG8_WAIT_L(8); PG8_BAR; PG8_WAIT_L(0); PG8_MMA(0, 0, At, B0); PG8_BAR; PG8_SCHED;
            PG8_LDB(B1, 0, 1); PG8_STAGE(PG8_SB(0, 0), b2, voffB);
            PG8_BAR; PG8_WAIT_L(0); PG8_MMA(0, 1, At, B1); PG8_BAR;
            PG8_LDA(At, 0, 1); PG8_STAGE(PG8_SA(0, 0), a2, voffA);
            PG8_BAR; PG8_WAIT_L(0); PG8_MMA(1, 0, At, B0); PG8_BAR; PG8_SCHED;
            PG8_STAGE(PG8_SB(0, 1), b2 + hstep, voffB);
            PG8_WAIT_V(6); PG8_BAR; PG8_MMA(1, 1, At, B1); PG8_BAR;
            PG8_LDB(B0, 1, 0); PG8_SCHED; PG8_LDA(At, 1, 0); PG8_STAGE(PG8_SA(0, 1), a2 + hstep, voffA);
            PG8_WAIT_L(8); PG8_BAR; PG8_WAIT_L(0); PG8_MMA(0, 0, At, B0); PG8_BAR; PG8_SCHED;
            PG8_LDB(B1, 1, 1); PG8_STAGE(PG8_SB(1, 0), b3, voffB);
            PG8_BAR; PG8_WAIT_L(0); PG8_MMA(0, 1, At, B1); PG8_BAR;
            PG8_LDA(At, 1, 1); PG8_STAGE(PG8_SA(1, 0), a3, voffA);
            PG8_BAR; PG8_WAIT_L(0); PG8_MMA(1, 0, At, B0); PG8_BAR; PG8_SCHED;
            PG8_STAGE(PG8_SB(1, 1), b3 + hstep, voffB);
            PG8_WAIT_V(6); PG8_BAR; PG8_MMA(1, 1, At, B1); PG8_BAR;
            }
        }
        if constexpr (ALIGN_EPI) { if (wr == 0) PG8_BAR; }
        if constexpr (!Epi::AFTER_DRAIN) { E(acc, cur, wr, wc, fr, fq); S.done(cur); }
        if (!has_next) break;
#pragma unroll
        for (int a = 0; a < 2; ++a)
#pragma unroll
            for (int b = 0; b < 2; ++b)
#pragma unroll
                for (int m = 0; m < 4; ++m)
#pragma unroll
                    for (int n = 0; n < 2; ++n) acc[a][b][m][n] = (f32x4){0.f, 0.f, 0.f, 0.f};
        cur = nxt; cA = nA; cB = nB; ++ui;
        if constexpr (ALIGN_EPI) { if (wr == 1) PG8_BAR; }
    }
    PG8_WAIT_V(0);
    if constexpr (!ALIGN_EPI) { if (wr == 0) PG8_BAR; }
    PG8_BAR;
    if constexpr (Epi::AFTER_DRAIN) { E.fused(acc, cur, wr, wc, fr, fq, lds, wid, lane); S.done(cur); }
#undef PG8_SA
#undef PG8_SB
#undef PG8_STAGE
#undef PG8_LDA
#undef PG8_LDB
#undef PG8_MMA
#undef PG8_WAIT_V
#undef PG8_WAIT_L
#undef PG8_BAR
#undef PG8_SCHED
}
}

#ifndef MK_MULTI
#define MK_MULTI 0
#endif
typedef unsigned short bf16_t;
typedef short bf16x8 __attribute__((ext_vector_type(8)));
typedef float f32x4 __attribute__((ext_vector_type(4)));
typedef float f32x16 __attribute__((ext_vector_type(16)));
typedef unsigned u32x4 __attribute__((ext_vector_type(4)));
typedef unsigned u32x2 __attribute__((ext_vector_type(2)));
typedef float f32x2_t __attribute__((ext_vector_type(2)));
typedef __bf16 bf16x2_t __attribute__((ext_vector_type(2)));
#define LAS __attribute__((address_space(3)))

constexpr int DM = 1024, SEQ = 8192, NB = 2, CTXL = 256, MX = NB * SEQ, MC = NB * CTXL, MT = MX + MC;
constexpr int DFF = 2816, NH = 8, HD = 64, INW = 2048, NMODW = 9 * DM;
constexpr float RMS_EPS = 1e-6f;
constexpr float LOG2E = 1.4426950408889634f;
constexpr float QSCALE = 0.125f * LOG2E;
constexpr int NPHASE = 22;
constexpr int NTHREADS = 512, NWAVES = 8;
constexpr int LDS_BYTES = 147456;

constexpr size_t MiB = 1u << 20;
constexpr size_t WS_MOD = 0;
constexpr size_t WS_ROPEC = 256 * 1024;
constexpr size_t WS_ROPES = 256 * 1024 + 8192;
constexpr size_t WS_BAR = 3 * MiB;
constexpr size_t WS_CTXS = 512 * 1024;
constexpr size_t WS_WGU = 4 * MiB;
constexpr size_t WS_WD = 48 * MiB;
constexpr size_t WS_WIN = 70 * MiB;
constexpr size_t WS_WOUT = 78 * MiB;
constexpr size_t WS_XN = 82 * MiB;
constexpr size_t WS_Y = 115 * MiB;
constexpr size_t WS_XS = 147 * MiB;
constexpr size_t WS_H = 211 * MiB;
constexpr size_t SZ_QK = (size_t)MT * 512 * 2;
constexpr size_t WS_Q = WS_H, WS_K = WS_Q + SZ_QK, WS_U = WS_K + SZ_QK, WS_VT = WS_U + SZ_QK, WS_MIX = WS_VT + SZ_QK;
constexpr size_t WS_YP = WS_MIX + (size_t)MT * 1024 * 2;
constexpr size_t WS_END = WS_YP + (size_t)11 * MC * 1024 * 4;
static_assert(WS_XN + (size_t)MT * 1024 * 2 <= WS_Y && WS_Y + (size_t)MX * 1024 * 2 <= WS_XS && WS_XS + (size_t)MX * 1024 * 4 <= WS_H && WS_H + (size_t)MT * DFF * 2 <= WS_YP, "ws map");

struct Params {
    const float *x, *c, *ctx, *cctx, *wmod, *bmod, *normg, *wgu, *wd, *win, *wout, *rpb, *wpool, *pscale;
    float* out; unsigned char* ws;
};
typedef const __attribute__((address_space(4))) Params* KParams;

__device__ __forceinline__ unsigned cvtpk(float lo, float hi) { f32x2_t v = {lo, hi}; bf16x2_t b = __builtin_convertvector(v, bf16x2_t); return __builtin_bit_cast(unsigned, b); }
__device__ __forceinline__ float bf2f(unsigned short h) { return __uint_as_float(((unsigned)h) << 16); }
__device__ __forceinline__ float wave_sum(float v) {
#pragma unroll
    for (int o = 1; o < 64; o <<= 1) v += __shfl_xor(v, o);
    return v;
}

#define XB_TMO      128
#define XB_XCNT(j)  (256  + 64 * (j))
#define XB_XSUB(j)  (1280 + 64 * (j))
#define XB_XGEN(j)  (2304 + 64 * (j))
#define XB_TOP      3328
#define XB_TOPGEN   3392
#define XCD_BAR_WORDS 3456
#define XB_SPIN_CAP (1u << 18)

__device__ __forceinline__ unsigned xb_ld(unsigned* p)              { return __hip_atomic_load(p, __ATOMIC_RELAXED, __HIP_MEMORY_SCOPE_AGENT); }
__device__ __forceinline__ unsigned xb_add(unsigned* p, unsigned v) { return __hip_atomic_fetch_add(p, v, __ATOMIC_RELAXED, __HIP_MEMORY_SCOPE_AGENT); }
__device__ __forceinline__ unsigned xb_xcc_id() { return (unsigned)__builtin_amdgcn_s_getreg((3 << 11) | 20) & 0xFu; }
#define XB_SPIN(cond, bar) do { unsigned _sp = 0; while (cond) { __builtin_amdgcn_s_sleep(1); \
    if ((++_sp & 255u) == 0u) { if (xb_ld(&(bar)[XB_TMO])) break; if (_sp > XB_SPIN_CAP) { atomicAdd(&(bar)[XB_TMO], 1u); break; } } } } while (0)

struct XcdBarrier {
    unsigned* bar; unsigned x;
    volatile LAS unsigned* st;
};

__device__ __forceinline__ XcdBarrier xcd_barrier_post(unsigned* bar, volatile LAS unsigned* st) {
    XcdBarrier b; b.bar = bar; b.x = xb_xcc_id(); b.st = st;
    if (threadIdx.x == 0) (void)xb_add(&bar[XB_XCNT(b.x)], 1u);
    return b;
}
__device__ __forceinline__ void xcd_barrier_complete(unsigned* bar, unsigned x, unsigned& nloc, unsigned& nx) {
    const unsigned G = gridDim.x * gridDim.y * gridDim.z;
    unsigned sum, cnt, mine, sp = 0u;
    for (;;) {
        sum = 0u; cnt = 0u; mine = 0u;
#pragma unroll
        for (unsigned j = 0; j < 16; ++j) { const unsigned c = xb_ld(&bar[XB_XCNT(j)]); sum += c; cnt += (c > 0u) ? 1u : 0u; mine = (j == x) ? c : mine; }
        if (sum == G) break;
        __builtin_amdgcn_s_sleep(1);
        if ((++sp & 255u) == 0u) { if (xb_ld(&bar[XB_TMO])) break; if (sp > XB_SPIN_CAP) { atomicAdd(&bar[XB_TMO], 1u); break; } }
    }
    nloc = mine > 0u ? mine : 1u; nx = cnt > 0u ? cnt : 1u;
}

__device__ __forceinline__ void xcd_barrier(const XcdBarrier& b) {
    asm volatile("s_waitcnt vmcnt(0)" ::: "memory");
    __syncthreads();
    if (threadIdx.x == 0) {
        unsigned* bar = b.bar;
        __builtin_amdgcn_s_waitcnt(0);
        unsigned nloc = b.st[0], nx = b.st[1];
        if (nloc == 0u) { xcd_barrier_complete(bar, b.x, nloc, nx); b.st[0] = nloc; b.st[1] = nx; }
        const unsigned old = xb_add(&bar[XB_XSUB(b.x)], 1u);
        const unsigned gen = old / nloc;
        if (old + 1u == (gen + 1u) * nloc) {
            __builtin_amdgcn_fence(__ATOMIC_RELEASE, "agent");
            asm volatile("s_waitcnt vmcnt(0)" ::: "memory");
            const unsigned og = xb_add(&bar[XB_TOP], 1u);
            const unsigned tg = og / nx;
            if (og + 1u == (tg + 1u) * nx) xb_add(&bar[XB_TOPGEN], 1u);
            else XB_SPIN(xb_ld(&bar[XB_TOPGEN]) == tg, bar);
            __builtin_amdgcn_fence(__ATOMIC_ACQUIRE, "agent");
            xb_add(&bar[XB_XGEN(b.x)], 1u);
            asm volatile("s_waitcnt vmcnt(0)" ::: "memory");
        } else {
            XB_SPIN(xb_ld(&bar[XB_XGEN(b.x)]) == gen, bar);
            __builtin_amdgcn_fence(__ATOMIC_ACQUIRE, "agent");
            asm volatile("s_waitcnt vmcnt(0)" ::: "memory");
        }
    }
    __syncthreads();
}

using pg8::Unit;
enum { EPI_SWIGLU = 0, EPI_F32 = 1, EPI_QKU = 2, EPI_BF16 = 3 };
struct EpiAny {
    static constexpr bool AFTER_DRAIN = false;
    int mode; bool perm; void* O; int ldc; const float *ropeC, *ropeS; int pstride, ntp;
    __device__ __forceinline__ static float sw(float g, float u) { return g * u * __builtin_amdgcn_rcpf(1.0f + __builtin_amdgcn_exp2f(-g * LOG2E)); }
    __device__ __forceinline__ void operator()(const f32x4 (&acc)[2][2][4][2], const Unit& u, int wr, int wc, int fr, int fq) const {
        if (mode == EPI_SWIGLU) {
            bf16_t* H = (bf16_t*)O;
            const int row0 = u.pm * 256 + wr * 64 + fr, col0 = u.pn * 128 + wc * 32 + 8 * fq;
#pragma unroll
            for (int ai = 0; ai < 2; ++ai)
#pragma unroll
                for (int m = 0; m < 4; ++m) {
                    bf16_t* p = H + (size_t)(row0 + ai * 128 + m * 16) * DFF + col0;
                    const f32x4 g0 = acc[ai][0][m][0], g1 = acc[ai][0][m][1], u0 = acc[ai][1][m][0], u1 = acc[ai][1][m][1];
                    u32x4 w; w.x = cvtpk(sw(g0[0], u0[0]), sw(g0[1], u0[1])); w.y = cvtpk(sw(g0[2], u0[2]), sw(g0[3], u0[3]));
                    w.z = cvtpk(sw(g1[0], u1[0]), sw(g1[1], u1[1])); w.w = cvtpk(sw(g1[2], u1[2]), sw(g1[3], u1[3]));
                    *(u32x4*)p = w;
                }
        } else if (mode == EPI_F32) {
            float* Y = (float*)O + ((ntp > 0) ? (size_t)(u.kb / ntp) * (size_t)pstride : (size_t)0);
            const int row0 = u.pm * 256 + wr * 64 + fr, col0 = u.pn * 256 + wc * 32 + 4 * fq;
#pragma unroll
            for (int ai = 0; ai < 2; ++ai)
#pragma unroll
                for (int m = 0; m < 4; ++m) {
                    float* p = Y + (size_t)(row0 + ai * 128 + m * 16) * ldc + col0;
#pragma unroll
                    for (int bj = 0; bj < 2; ++bj)
#pragma unroll
                        for (int n = 0; n < 2; ++n) *(f32x4*)(p + bj * 128 + n * 16) = acc[ai][bj][m][n];
                }
        } else if (mode == EPI_QKU) {
            const int t = u.pn >> 1; bf16_t* base = (bf16_t*)O + (size_t)t * ((size_t)MT * 512);
            const float sc = (t == 0) ? QSCALE : 1.0f;
            const bool rope = (t < 2) && (u.pm < MX / 256);
            const int cb = (u.pn & 1) * 256 + wc * 32 + 4 * fq;
#pragma unroll
            for (int ai = 0; ai < 2; ++ai)
#pragma unroll
                for (int m = 0; m < 4; ++m) {
                    const int row = u.pm * 256 + ai * 128 + wr * 64 + m * 16 + fr;
                    bf16_t* p = base + (size_t)row * 512 + cb;
                    f32x4 c4 = {1.f, 1.f, 1.f, 1.f}, s4 = {0.f, 0.f, 0.f, 0.f};
                    if (rope) { const int s = row & (SEQ - 1); const int pos = (wc & 1) ? (s & 63) : (s >> 6);
                        c4 = *(const f32x4*)(ropeC + pos * 16 + 4 * fq); s4 = *(const f32x4*)(ropeS + pos * 16 + 4 * fq); }
#pragma unroll
                    for (int bj = 0; bj < 2; ++bj) {
                        const f32x4 x1 = acc[ai][bj][m][0], x2 = acc[ai][bj][m][1];
                        const f32x4 o1 = (x1 * c4 - x2 * s4) * sc, o2 = (x2 * c4 + x1 * s4) * sc;
                        u32x2 w1, w2; w1.x = cvtpk(o1[0], o1[1]); w1.y = cvtpk(o1[2], o1[3]); w2.x = cvtpk(o2[0], o2[1]); w2.y = cvtpk(o2[2], o2[3]);
                        *(u32x2*)(p + bj * 128) = w1; *(u32x2*)(p + bj * 128 + 16) = w2;
                    }
                }
        } else {
            bf16_t* Ob = (bf16_t*)O;
            const int row0 = u.pm * 256 + wr * 64 + fr, col0 = u.pn * 256 + wc * 32 + 8 * fq;
#pragma unroll
            for (int ai = 0; ai < 2; ++ai)
#pragma unroll
                for (int m = 0; m < 4; ++m) {
                    bf16_t* p = Ob + (size_t)(row0 + ai * 128 + m * 16) * ldc + col0;
#pragma unroll
                    for (int bj = 0; bj < 2; ++bj) { const f32x4 v0 = acc[ai][bj][m][0], v1 = acc[ai][bj][m][1];
                        u32x4 w; w.x = cvtpk(v0[0], v0[1]); w.y = cvtpk(v0[2], v0[3]); w.z = cvtpk(v1[0], v1[1]); w.w = cvtpk(v1[2], v1[3]);
                        *(u32x4*)(p + bj * 128) = w; }
                }
        }
    }
};

__device__ __forceinline__ void p0_transpose_item(const float* W, int ldw, int k0, int n0, bf16_t* WT, int ldt, int dst_row0, LAS unsigned char* scr, int lane) {
    f32x4 v[16];
    const float* src = W + (size_t)(k0 + (lane >> 4)) * ldw + n0 + 4 * (lane & 15);
#pragma unroll
    for (int i = 0; i < 16; ++i) v[i] = *(const f32x4*)(src + (size_t)(4 * i) * ldw);
#pragma unroll
    for (int i = 0; i < 16; ++i) { LAS unsigned* p = (LAS unsigned*)(scr + (4 * i + (lane >> 4)) * 132 + 8 * (lane & 15)); p[0] = cvtpk(v[i][0], v[i][1]); p[1] = cvtpk(v[i][2], v[i][3]); }
    asm volatile("s_waitcnt lgkmcnt(0)" ::: "memory");
    const int c = lane & 7;
#pragma unroll
    for (int j = 0; j < 4; ++j) { const int np = (lane >> 3) + 8 * j; unsigned w[8];
#pragma unroll
        for (int i = 0; i < 8; ++i) w[i] = *(const LAS unsigned*)(scr + (8 * c + i) * 132 + 4 * np);
        u32x4 lo, hi;
        lo.x = (w[0] & 0xffffu) | (w[1] << 16); lo.y = (w[2] & 0xffffu) | (w[3] << 16); lo.z = (w[4] & 0xffffu) | (w[5] << 16); lo.w = (w[6] & 0xffffu) | (w[7] << 16);
        hi.x = (w[0] >> 16) | (w[1] & 0xffff0000u); hi.y = (w[2] >> 16) | (w[3] & 0xffff0000u); hi.z = (w[4] >> 16) | (w[5] & 0xffff0000u); hi.w = (w[6] >> 16) | (w[7] & 0xffff0000u);
        *(u32x4*)(WT + (size_t)(dst_row0 + 2 * np) * ldt + k0 + 8 * c) = lo;
        *(u32x4*)(WT + (size_t)(dst_row0 + 2 * np + 1) * ldt + k0 + 8 * c) = hi; }
    asm volatile("s_waitcnt lgkmcnt(0)" ::: "memory");
}

__device__ __forceinline__ void phase_p0(KParams P, LAS unsigned char* lds, int tid, int wave, int lane, int bx, int G) {
    unsigned char* ws = P->ws;
    float* MOD = (float*)(ws + WS_MOD);
    const int gt = bx * NTHREADS + tid;
    if (gt < 2048) {
        const int pos = gt >> 4, i = gt & 15;
        const float inv = exp2f(-(float)i * 0.83048202372184058696f);
        const float angf = (float)pos * inv;
        const double a = (double)angf; const double kq = rint(a * 0.63661977236758134308); const double r = a - kq * 1.57079632679489661923; const double r2 = r * r;
        double sr = r, cr = 1.0, ts = r, tc = 1.0;
#pragma unroll 1
        for (int k = 1; k <= 8; ++k) { const double k2 = (double)(2 * k); tc *= -r2 / (k2 * (k2 - 1.0)); ts *= -r2 / (k2 * (k2 + 1.0)); cr += tc; sr += ts; }
        const int q = ((int)kq) & 3;
        const double cv = (q == 0) ? cr : (q == 1) ? -sr : (q == 2) ? -cr : sr;
        const double sv = (q == 0) ? sr : (q == 1) ? cr : (q == 2) ? -sr : -cr;
        ((float*)(ws + WS_ROPEC))[gt] = (float)cv; ((float*)(ws + WS_ROPES))[gt] = (float)sv;
    }
    constexpr int J_MOD = 72, J_FOLD = 128, J_TR = 1216, NJOBS = J_MOD + J_FOLD + J_TR;
    unsigned* jq = (unsigned*)(ws + WS_BAR + 32768);
    LAS int* jb = (LAS int*)(lds + 131072 + 128);
    for (;;) {
        if (tid == 0) *jb = (int)__hip_atomic_fetch_add(jq, 1u, __ATOMIC_RELAXED, __HIP_MEMORY_SCOPE_AGENT);
        __syncthreads();
        const int job = *jb;
        __syncthreads();
        if (job >= NJOBS) break;
        if (job < J_MOD) {
            LAS float* sc = (LAS float*)lds;
            LAS float* red = sc + 3072;
            for (int i = tid; i < 3072; i += NTHREADS) { const int who = i >> 10, k = i & 1023; const float v = (who < 2) ? P->c[who * 1024 + k] : P->cctx[k]; sc[i] = v / (1.0f + __expf(-v)); }
            __syncthreads();
            const int l = job / 36, cc = job % 36, col = cc * 256 + 4 * lane;
            const float* W = P->wmod + ((size_t)l * 1024 + wave * 128) * NMODW + col;
            f32x4 a0 = {0.f, 0.f, 0.f, 0.f}, a1 = a0, a2 = a0;
#pragma unroll 16
            for (int k = 0; k < 128; ++k) { const f32x4 w = *(const f32x4*)(W + (size_t)k * NMODW); const int kk = wave * 128 + k; a0 += w * sc[kk]; a1 += w * sc[1024 + kk]; a2 += w * sc[2048 + kk]; }
            *(LAS f32x4*)(red + (wave * 3 + 0) * 256 + 4 * lane) = a0; *(LAS f32x4*)(red + (wave * 3 + 1) * 256 + 4 * lane) = a1; *(LAS f32x4*)(red + (wave * 3 + 2) * 256 + 4 * lane) = a2;
            __syncthreads();
            for (int o = tid; o < 768; o += NTHREADS) { const int who = o >> 8, cl = o & 255; float s = 0.f;
#pragma unroll
                for (int w = 0; w < 8; ++w) s += red[(w * 3 + who) * 256 + cl];
                MOD[(size_t)(l * 3 + who) * NMODW + cc * 256 + cl] = s + P->bmod[l * NMODW + cc * 256 + cl]; }
            __syncthreads();
        } else if (job < J_MOD + J_FOLD) {
            const int r = job - J_MOD, nb = r & 15, g = (r >> 4) & 3, l = r >> 6;
            LAS float* A = (LAS float*)lds;
            LAS float* B = (LAS float*)(lds + 128 * 132 * 4);
            LAS bf16_t* OT = (LAS bf16_t*)(lds + 128 * 132 * 4 + 128 * 64 * 4);
            const float* wp = P->wpool + (size_t)(l * 4 + g) * 128 * 128; const float* ps = P->pscale + l * 512 + g * 128;
            const float* wo = P->wout + ((size_t)l * 1024 + 512 + g * 128) * 1024 + nb * 64;
#pragma unroll 8
            for (int i = 0; i < 32; ++i) { const int idx = tid + NTHREADS * i, c = idx >> 7, d = idx & 127; A[c * 132 + d] = wp[idx] * ps[d]; }
#pragma unroll 8
            for (int i = 0; i < 16; ++i) { const int idx = tid + NTHREADS * i, d = idx >> 6, n = idx & 63; B[idx] = wo[(size_t)d * 1024 + n]; }
            __syncthreads();
            const int c = tid >> 2, nq = tid & 3;
            f32x4 acc[4];
#pragma unroll
            for (int j = 0; j < 4; ++j) acc[j] = (f32x4){0.f, 0.f, 0.f, 0.f};
#pragma unroll 4
            for (int d = 0; d < 128; ++d) { const float a = A[c * 132 + d];
#pragma unroll
                for (int j = 0; j < 4; ++j) acc[j] += *(const LAS f32x4*)(B + d * 64 + 16 * nq + 4 * j) * a; }
#pragma unroll
            for (int j = 0; j < 4; ++j)
#pragma unroll
                for (int e = 0; e < 4; ++e) OT[(16 * nq + 4 * j + e) * 128 + c] = (bf16_t)(cvtpk(acc[j][e], 0.f) & 0xffffu);
            __syncthreads();
            bf16_t* dst = (bf16_t*)(ws + WS_WOUT) + ((size_t)l * 1024 + nb * 64) * 1024 + 512 + g * 128;
#pragma unroll
            for (int i = 0; i < 2; ++i) { const int ch = tid + NTHREADS * i, n = ch >> 4, cc8 = ch & 15; *(u32x4*)(dst + (size_t)n * 1024 + cc8 * 8) = *(const LAS u32x4*)(OT + n * 128 + cc8 * 8); }
            __syncthreads();
        } else {
            LAS unsigned char* scr = lds + wave * 8448;
            int tj = job - J_MOD - J_FOLD; const int wk = wave >> 2, wn = wave & 3;
            if (tj < 704) { const int ls = tj / 176, r = tj % 176, kb = r / 22, nb = r % 22, k0 = kb * 128 + wk * 64, n0 = nb * 256 + wn * 64;
                const int cidx = (n0 < DFF) ? n0 : n0 - DFF; const int drow = 256 * (cidx >> 7) + (cidx & 127) + ((n0 < DFF) ? 0 : 128);
                p0_transpose_item(P->wgu + (size_t)ls * 1024 * 5632, 5632, k0, n0, (bf16_t*)(ws + WS_WGU) + (size_t)ls * 5632 * 1024, 1024, drow, scr, lane); }
            else if ((tj -= 704) < 352) { const int ls = tj / 88, r = tj % 88, kb = r / 4, nb = r % 4, k0 = kb * 128 + wk * 64, n0 = nb * 256 + wn * 64;
                p0_transpose_item(P->wd + (size_t)ls * DFF * 1024, 1024, k0, n0, (bf16_t*)(ws + WS_WD) + (size_t)ls * 1024 * DFF, DFF, n0, scr, lane); }
            else if ((tj -= 352) < 128) { const int l = tj / 64, r = tj % 64, kb = r / 8, nb = r % 8, k0 = kb * 128 + wk * 64, n0 = nb * 256 + wn * 64;
                const int drow = (n0 < 1024) ? n0 : (n0 < 1536) ? n0 + 512 : n0 - 512;
                p0_transpose_item(P->win + (size_t)l * 1024 * INW, INW, k0, n0, (bf16_t*)(ws + WS_WIN) + (size_t)l * INW * 1024, 1024, drow, scr, lane); }
            else { tj -= 128; const int l = tj / 16, r = tj % 16, kb = r / 4, nb = r % 4, k0 = kb * 128 + wk * 64, n0 = nb * 256 + wn * 64;
                p0_transpose_item(P->wout + (size_t)l * 1024 * 1024, 1024, k0, n0, (bf16_t*)(ws + WS_WOUT) + (size_t)l * 1024 * 1024, 1024, n0, scr, lane); }
        }
    }
}

struct RowPass {
    const float *srcX, *srcC; float *dstX, *dstC; const bf16_t* srcXb; bf16_t* dstXb;
    const bf16_t* Yb; const float *gate, *gpost; float coef;
    const float *shift, *scale, *gpre; bf16_t* XN;
    int M; bool hasY, hasXN; const float* YP; int nparts;
};
template <int RPT> __device__ __forceinline__ void row_range(const RowPass& R, int lane, int gw, int NGW, int mlo, int mhi) {
    for (int m0 = mlo + RPT * gw; m0 < mhi; m0 += RPT * NGW) {
        const int who = (m0 < SEQ) ? 0 : (m0 < MX) ? 1 : 2;
        const bool isx = m0 < MX;
        f32x4 v[RPT][4];
#pragma unroll
        for (int rr = 0; rr < RPT; ++rr) { const int m = m0 + rr;
            if (isx && R.srcXb) {
#pragma unroll
                for (int j = 0; j < 4; ++j) { const u32x2 w = *(const u32x2*)(R.srcXb + (size_t)m * DM + 4 * lane + 256 * j);
                    v[rr][j] = (f32x4){__uint_as_float(w.x << 16), __uint_as_float(w.x & 0xffff0000u), __uint_as_float(w.y << 16), __uint_as_float(w.y & 0xffff0000u)}; }
            } else { const float* xin = isx ? R.srcX + (size_t)m * DM : R.srcC + (size_t)(m - MX) * DM;
#pragma unroll
                for (int j = 0; j < 4; ++j) v[rr][j] = *(const f32x4*)(xin + 4 * lane + 256 * j); } }
        if (R.hasY) {
            f32x4 y[RPT][4]; float ss[RPT];
#pragma unroll
            for (int rr = 0; rr < RPT; ++rr) ss[rr] = 0.f;
#pragma unroll
            for (int rr = 0; rr < RPT; ++rr) { const int m = m0 + rr;
#pragma unroll
                for (int j = 0; j < 4; ++j) {
                    if (isx) { const u32x2 w = *(const u32x2*)(R.Yb + (size_t)m * DM + 4 * lane + 256 * j);
                        y[rr][j] = (f32x4){__uint_as_float(w.x << 16), __uint_as_float(w.x & 0xffff0000u), __uint_as_float(w.y << 16), __uint_as_float(w.y & 0xffff0000u)}; }
                    else { f32x4 tp[11];
#pragma unroll
                        for (int p = 0; p < 11; ++p) tp[p] = *(const f32x4*)(R.YP + ((size_t)min(p, R.nparts - 1) * MC + (m - MX)) * DM + 4 * lane + 256 * j);
                        f32x4 t = tp[0];
#pragma unroll
                        for (int p = 1; p < 11; ++p) t += tp[p] * ((p < R.nparts) ? 1.0f : 0.0f);
                        y[rr][j] = t; }
                    ss[rr] += (y[rr][j].x * y[rr][j].x + y[rr][j].y * y[rr][j].y) + (y[rr][j].z * y[rr][j].z + y[rr][j].w * y[rr][j].w); } }
#pragma unroll
            for (int rr = 0; rr < RPT; ++rr) ss[rr] = wave_sum(ss[rr]);
#pragma unroll
            for (int rr = 0; rr < RPT; ++rr) { const int m = m0 + rr;
                const float rs = rsqrtf(ss[rr] * (1.0f / DM) + RMS_EPS) * R.coef;
#pragma unroll
                for (int j = 0; j < 4; ++j) { const int col = 4 * lane + 256 * j; const f32x4 gt = *(const f32x4*)(R.gate + who * NMODW + col), gp = *(const f32x4*)(R.gpost + col);
                    v[rr][j] = v[rr][j] + gt * (y[rr][j] * rs * gp); }
                if (isx && R.dstXb) {
#pragma unroll
                    for (int j = 0; j < 4; ++j) { u32x2 w; w.x = cvtpk(v[rr][j][0], v[rr][j][1]); w.y = cvtpk(v[rr][j][2], v[rr][j][3]); *(u32x2*)(R.dstXb + (size_t)m * DM + 4 * lane + 256 * j) = w;
                        v[rr][j] = (f32x4){__uint_as_float(w.x << 16), __uint_as_float(w.x & 0xffff0000u), __uint_as_float(w.y << 16), __uint_as_float(w.y & 0xffff0000u)}; }
                } else { float* xo = isx ? R.dstX + (size_t)m * DM : R.dstC + (size_t)(m - MX) * DM;
#pragma unroll
                    for (int j = 0; j < 4; ++j) *(f32x4*)(xo + 4 * lane + 256 * j) = v[rr][j]; } }
        }
        if (R.hasXN) {
            float ss[RPT];
#pragma unroll
            for (int rr = 0; rr < RPT; ++rr) ss[rr] = 0.f;
#pragma unroll
            for (int rr = 0; rr < RPT; ++rr)
#pragma unroll
                for (int j = 0; j < 4; ++j) ss[rr] += (v[rr][j].x * v[rr][j].x + v[rr][j].y * v[rr][j].y) + (v[rr][j].z * v[rr][j].z + v[rr][j].w * v[rr][j].w);
#pragma unroll
            for (int rr = 0; rr < RPT; ++rr) ss[rr] = wave_sum(ss[rr]);
#pragma unroll
            for (int rr = 0; rr < RPT; ++rr) { const int m = m0 + rr;
                const float rs = rsqrtf(ss[rr] * (1.0f / DM) + RMS_EPS);
#pragma unroll
                for (int j = 0; j < 4; ++j) { const int col = 4 * lane + 256 * j;
                    const f32x4 gp = *(const f32x4*)(R.gpre + col), sh = *(const f32x4*)(R.shift + who * NMODW + col), sc = *(const f32x4*)(R.scale + who * NMODW + col);
                    const f32x4 o = (v[rr][j] * rs * gp) * (sc + 1.0f) + sh;
                    u32x2 w; w.x = cvtpk(o[0], o[1]); w.y = cvtpk(o[2], o[3]);
                    *(u32x2*)(R.XN + (size_t)m * DM + col) = w; } }
        }
    }
}

__device__ __forceinline__ void phase_row(const RowPass& R, int wave, int lane, int bx, int G) {
    const int gw = bx * NWAVES + wave, NGW = G * NWAVES;
    row_range<4>(R, lane, gw, NGW, 0, (R.M < MX) ? R.M : MX);
    if (R.M > MX) row_range<2>(R, lane, NGW - 1 - gw, NGW, MX, R.M);
}

#define MFMA32(a, b, c) __builtin_amdgcn_mfma_f32_32x32x16_bf16((a), (b), (c), 0, 0, 0)
struct KFrag { bf16x8 k[4]; };
struct VFrag { bf16x8 v[4]; };
__device__ __forceinline__ void attn_loadk(KFrag& f, const bf16_t* kbase, int krow0) {
    const bf16_t* kp = kbase + (size_t)krow0 * 512;
#pragma unroll
    for (int dk = 0; dk < 4; ++dk) f.k[dk] = *(const bf16x8*)(kp + dk * 16);
}
__device__ __forceinline__ void attn_loadv(VFrag& f, const bf16_t* vbase, int krow0) {
    const bf16_t* vp = vbase + krow0;
    f.v[0] = *(const bf16x8*)(vp); f.v[1] = *(const bf16x8*)(vp + 16); f.v[2] = *(const bf16x8*)(vp + (size_t)32 * MT); f.v[3] = *(const bf16x8*)(vp + (size_t)32 * MT + 16);
}
__device__ __forceinline__ void attn_soft(f32x16& S, f32x16& o0, f32x16& o1, float& mrun, float& lrun, bool masked, const LAS float* bt, int relb, int idxb, bf16x8& pb0, bf16x8& pb1) {
    if (masked) {
        const LAS float* bp = bt + idxb;
        float bv[16];
#pragma unroll
        for (int r = 0; r < 16; ++r) bv[r] = bp[16 * (r >> 3) + (r & 7)];
#pragma unroll
        for (int r = 0; r < 16; ++r) {
            const int off = 16 * (r >> 3) + (r & 7);
            const bool valid = (unsigned)(relb + off) < 16u;
            S[r] = valid ? S[r] + bv[r] : -1e30f;
        }
    }
    float tm = S[0];
#pragma unroll
    for (int r = 1; r < 16; ++r) tm = fmaxf(tm, S[r]);
    tm = fmaxf(tm, __shfl_xor(tm, 32));
    if (__any(tm > mrun)) {
        const float mn = fmaxf(mrun, tm);
        const float fs = __builtin_amdgcn_exp2f(mrun - mn);
        mrun = mn; lrun *= fs;
#pragma unroll
        for (int r = 0; r < 16; ++r) { o0[r] *= fs; o1[r] *= fs; }
    }
    float ps = 0.f;
#pragma unroll
    for (int r = 0; r < 16; ++r) { S[r] = __builtin_amdgcn_exp2f(S[r] - mrun); ps += S[r]; }
    lrun += ps;
    u32x4 w0, w1;
    w0.x = cvtpk(S[0], S[1]); w0.y = cvtpk(S[2], S[3]); w0.z = cvtpk(S[4], S[5]); w0.w = cvtpk(S[6], S[7]);
    w1.x = cvtpk(S[8], S[9]); w1.y = cvtpk(S[10], S[11]); w1.z = cvtpk(S[12], S[13]); w1.w = cvtpk(S[14], S[15]);
    pb0 = __builtin_bit_cast(bf16x8, w0); pb1 = __builtin_bit_cast(bf16x8, w1);
}
struct AttnState { f32x16 o0, o1; float m, l; };
__device__ __forceinline__ void attn_comp2(KFrag& fk, const VFrag& f, const bf16x8 (&qa)[4], const bf16x8 (&qb)[4], AttnState& A, AttnState& B,
                                           bool masked, const LAS float* bt, int relA, int idxA, int relB, int idxB, const bf16_t* kbase, int nextrow) {
    f32x16 SA, SB;
#pragma unroll
    for (int r = 0; r < 16; ++r) { SA[r] = 0.f; SB[r] = 0.f; }
#pragma unroll
    for (int dk = 0; dk < 4; ++dk) { SA = MFMA32(fk.k[dk], qa[dk], SA); SB = MFMA32(fk.k[dk], qb[dk], SB); }
    if (nextrow >= 0) attn_loadk(fk, kbase, nextrow);
    bf16x8 p0, p1;
    attn_soft(SA, A.o0, A.o1, A.m, A.l, masked, bt, relA, idxA, p0, p1);
    A.o0 = MFMA32(f.v[0], p0, A.o0); A.o0 = MFMA32(f.v[1], p1, A.o0); A.o1 = MFMA32(f.v[2], p0, A.o1); A.o1 = MFMA32(f.v[3], p1, A.o1);
    attn_soft(SB, B.o0, B.o1, B.m, B.l, masked, bt, relB, idxB, p0, p1);
    B.o0 = MFMA32(f.v[0], p0, B.o0); B.o0 = MFMA32(f.v[1], p1, B.o0); B.o1 = MFMA32(f.v[2], p0, B.o1); B.o1 = MFMA32(f.v[3], p1, B.o1);
}
__device__ __forceinline__ void attn_store(const AttnState& A, bf16_t* op) {
    const float lt = A.l + __shfl_xor(A.l, 32);
    const float inv = 1.0f / lt;
#pragma unroll
    for (int g4 = 0; g4 < 4; ++g4) {
        u32x2 w; w.x = cvtpk(A.o0[4 * g4] * inv, A.o0[4 * g4 + 1] * inv); w.y = cvtpk(A.o0[4 * g4 + 2] * inv, A.o0[4 * g4 + 3] * inv); *(u32x2*)(op + 8 * g4) = w;
        u32x2 z; z.x = cvtpk(A.o1[4 * g4] * inv, A.o1[4 * g4 + 1] * inv); z.y = cvtpk(A.o1[4 * g4 + 2] * inv, A.o1[4 * g4 + 3] * inv); *(u32x2*)(op + 32 + 8 * g4) = z;
    }
}

__device__ __forceinline__ void phase_mix(KParams P, int layer, LAS unsigned char* lds, int tid, int wave, int lane, int bx, int G) {
    unsigned char* ws = P->ws;
    const bf16_t* Qb = (const bf16_t*)(ws + WS_Q); const bf16_t* Kb = (const bf16_t*)(ws + WS_K); const bf16_t* Ub = (const bf16_t*)(ws + WS_U);
    const bf16_t* Vt = (const bf16_t*)(ws + WS_VT); bf16_t* MIXb = (bf16_t*)(ws + WS_MIX);
    LAS float* bt = (LAS float*)(lds + wave * 2560) + 64;
    const int vb = (G % 8 == 0) ? (bx % 8) * (G / 8) + bx / 8 : bx;
    const int gw = vb * NWAVES + wave, NGW = G * NWAVES;
    const int q = lane & 31, hi = lane >> 5, pi = (q & 0x13) | ((q & 4) << 1) | ((q & 8) >> 1);
    const int nunits = 2048 + ((layer == 0) ? 64 : 0);
    for (int un = gw; un < nunits; un += NGW) {
        int b, h, qrow0, r = 0; const bool local = un < 2048;
        if (local) { r = un & 127; h = (un >> 7) & 7; b = un >> 10; qrow0 = b * SEQ + r * 64; }
        else { const int v = un - 2048; const int qb = v & 3; h = (v >> 2) & 7; b = v >> 5; qrow0 = MX + b * CTXL + qb * 64; }
        if (local) {
            const float* rp = P->rpb + (size_t)(layer * NH + h) * 465;
            for (int i = lane; i < 465; i += 64) bt[i] = rp[i] * LOG2E;
        }
        bf16x8 qa[4], qb4[4];
#pragma unroll
        for (int dk = 0; dk < 4; ++dk) { qa[dk] = *(const bf16x8*)(Qb + (size_t)(qrow0 + q) * 512 + h * 64 + dk * 16 + hi * 8);
                                         qb4[dk] = *(const bf16x8*)(Qb + (size_t)(qrow0 + 32 + q) * 512 + h * 64 + dk * 16 + hi * 8); }
        AttnState A, B;
#pragma unroll
        for (int i = 0; i < 16; ++i) { A.o0[i] = 0.f; A.o1[i] = 0.f; B.o0[i] = 0.f; B.o1[i] = 0.f; }
        A.m = -1e30f; A.l = 0.f; B.m = -1e30f; B.l = 0.f;
        const int crow0 = MX + b * CTXL;
        const int rs = min(max(r - 4, 0), 120);
        const int jA = q, jB = 32 + q, csA = min(max(jA - 8, 0), 48), csB = min(max(jB - 8, 0), 48);
        const int lrow0 = b * SEQ + rs * 64;
        const bf16_t* kbase = Kb + (size_t)pi * 512 + h * 64 + hi * 8;
        const bf16_t* vbase = Vt + (size_t)(h * 64 + q) * MT + hi * 8;
        const int ntiles = local ? 24 : 8;
#define TROW(t) (((t) < 8) ? crow0 + 32 * (t) : lrow0 + 32 * ((t) - 8))
#define TCOMP(FK, FV, t, NXT) do { const int t_ = (t); const int kr_ = (t_ - 8) >> 1, ct_ = (t_ - 8) & 1; const int br_ = (rs + kr_ - r + 7) * 31 + ct_ * 32 + 8 * hi + 15; \
            int ra_ = ct_ * 32 + 8 * hi - csA, rb_ = ct_ * 32 + 8 * hi - csB; asm volatile("" : "+v"(ra_), "+v"(rb_));     \
            attn_comp2(FK, FV, qa, qb4, A, B, t_ >= 8, bt, ra_, br_ - jA, rb_, br_ - jB, kbase, (NXT)); } while (0)
        KFrag k0; VFrag fv;
        attn_loadk(k0, kbase, TROW(0));
        asm volatile("s_waitcnt lgkmcnt(0)" ::: "memory");
        for (int t = 0; t < ntiles; ++t) {
            attn_loadv(fv, vbase, TROW(t));
            TCOMP(k0, fv, t, (t + 1 < ntiles) ? TROW(t + 1) : -1);
        }
#undef TROW
#undef TCOMP
        attn_store(A, MIXb + (size_t)(qrow0 + q) * 1024 + h * 64 + 4 * hi);
        attn_store(B, MIXb + (size_t)(qrow0 + 32 + q) * 1024 + h * 64 + 4 * hi);
        asm volatile("s_waitcnt lgkmcnt(0)" ::: "memory");
    }
    const int mrows = (layer == 0) ? MT : MX;
    const int nskip = (layer == 0) ? 64 : 0;
    if (gw < nskip) return;
    for (int wi = gw - nskip; wi < mrows; wi += NGW - nskip) {
        const int g = wi & 3, m = (wi & ~3) + (lane >> 4), ch = g * 16 + (lane & 15);
        int jj, len;
        if (m < MX) { jj = m & 63; len = 64; } else { jj = (m - MX) & 255; len = 256; }
        const int base = m - jj;
        float a[8];
#pragma unroll
        for (int e = 0; e < 8; ++e) a[e] = 0.f;
        const bf16_t* up = Ub + (size_t)base * 512 + ch * 8;
#define POOLW(W2) do { const int lo = max(jj - (W2), 0), hi2 = min(jj + (W2), len); u32x4 uv[2 * (W2)]; \
            _Pragma("unroll") for (int t = 0; t < 2 * (W2); ++t) uv[t] = *(const u32x4*)(up + (size_t)min(lo + t, hi2 - 1) * 512); \
            _Pragma("unroll") for (int t = 0; t < 2 * (W2); ++t) { const float wgt = (lo + t < hi2) ? 1.0f : 0.0f; \
                _Pragma("unroll") for (int e = 0; e < 4; ++e) { a[2 * e] += wgt * __uint_as_float(uv[t][e] << 16); a[2 * e + 1] += wgt * __uint_as_float(uv[t][e] & 0xffff0000u); } } \
            const float ic = 1.0f / (float)(hi2 - lo); _Pragma("unroll") for (int e = 0; e < 8; ++e) a[e] *= ic; } while (0)
        if (g == 0) POOLW(1); else if (g == 1) POOLW(2); else if (g == 2) POOLW(4); else POOLW(8);
#undef POOLW
        const u32x4 us = *(const u32x4*)(Ub + (size_t)m * 512 + ch * 8);
        u32x4 o;
#pragma unroll
        for (int e = 0; e < 4; ++e) o[e] = cvtpk(a[2 * e] - __uint_as_float(us[e] << 16), a[2 * e + 1] - __uint_as_float(us[e] & 0xffff0000u));
        *(u32x4*)(MIXb + (size_t)m * 1024 + 512 + ch * 8) = o;
    }
}

__device__ __forceinline__ void run_phase(KParams P, int ph, LAS unsigned char* lds, int tid, int wave, int lane, int bx, int G) {
    unsigned char* ws = P->ws;
    float* MOD = (float*)(ws + WS_MOD);
    bf16_t* XN = (bf16_t*)(ws + WS_XN); bf16_t* Yb = (bf16_t*)(ws + WS_Y); bf16_t* H = (bf16_t*)(ws + WS_H);
    float* CTXS = (float*)(ws + WS_CTXS);
    if (ph == 0) { phase_p0(P, lds, tid, wave, lane, bx, G); return; }
    const int l = (ph == NPHASE - 1) ? 2 : (ph - 1) / 10, s = (ph == NPHASE - 1) ? 0 : (ph - 1) % 10;
    const int Mlate = (l == 1) ? MX : MT;
    if (s == 0 || s == 3 || s == 7) {
        int yl = l, gidx = 5, gpi = 3, nl = l, npre = 4, nsh = 6, M = Mlate; bool hasY = true, hasXN = true, useIn = false; float coef = 1.0f;
        if (s == 0) { yl = (l > 0) ? l - 1 : 0; gidx = 8; gpi = 5; npre = 0; nsh = 0; M = MT; coef = 0.5f; hasY = (l > 0); useIn = (l == 0);
                      if (l == 2) { hasXN = false; M = MX; nl = 1; } }
        else if (s == 3) { gidx = 2; gpi = 1; npre = 2; nsh = 3; M = MT; coef = 0.5f; useIn = (l == 0); }
        RowPass R;
        R.srcX = P->x; R.srcXb = useIn ? (const bf16_t*)nullptr : (const bf16_t*)(ws + WS_XS); R.srcC = useIn ? P->ctx : (const float*)CTXS;
        R.dstX = P->out; R.dstXb = (l == 2) ? (bf16_t*)nullptr : (bf16_t*)(ws + WS_XS); R.dstC = CTXS;
        R.YP = (const float*)(ws + WS_YP); R.nparts = (s == 7) ? 4 : 11;
        R.Yb = Yb; R.XN = XN; R.hasY = hasY; R.hasXN = hasXN; R.M = M; R.coef = coef;
        R.gate = MOD + (size_t)yl * 3 * NMODW + gidx * DM; R.gpost = P->normg + (yl * 6 + gpi) * DM;
        R.gpre = P->normg + (nl * 6 + npre) * DM; R.shift = MOD + (size_t)nl * 3 * NMODW + nsh * DM; R.scale = R.shift + DM;
        phase_row(R, wave, lane, bx, G);
        return;
    }
    if (s == 5) { phase_mix(P, l, lds, tid, wave, lane, bx, G); return; }
    const bool split = (s == 2 || s == 9 || s == 6) && (Mlate == MT || s == 2);
    const int npass = (s == 4 || split) ? 2 : 1;
    for (int pass = 0; pass < npass; ++pass) {
        pg8::Gemm g; EpiAny E; E.ropeC = (const float*)(ws + WS_ROPEC); E.ropeS = (const float*)(ws + WS_ROPES); E.pstride = 0; E.ntp = 0; int cu = bx, pm0 = 0, ksplit = 1, ntp = 0;
        if (s == 1 || s == 8) {
            const int sub = (s == 1) ? 0 : 1; const int M = (s == 1) ? MT : Mlate;
            g = pg8::Gemm{XN, (const bf16_t*)(ws + WS_WGU) + (size_t)(l * 2 + sub) * 5632 * 1024, M, 5632, 1024, 1024};
            E.mode = EPI_SWIGLU; E.perm = true; E.O = H; E.ldc = DFF;
        } else if (s == 6 || s == 2 || s == 9) {
            const bf16_t* A; const bf16_t* Bt; int K;
            if (s == 6) { A = (const bf16_t*)(ws + WS_MIX); Bt = (const bf16_t*)(ws + WS_WOUT) + (size_t)l * 1024 * 1024; K = 1024; }
            else { const int sub = (s == 2) ? 0 : 1; A = H; Bt = (const bf16_t*)(ws + WS_WD) + (size_t)(l * 2 + sub) * 1024 * DFF; K = DFF; }
            E.mode = EPI_F32; E.perm = false; E.ldc = 1024;
            if (pass == 0) { g = pg8::Gemm{A, Bt, MX, 1024, K, K}; E.mode = EPI_BF16; E.perm = true; E.O = Yb; }
            else { ntp = 4; ksplit = K / 256; pm0 = MX / 256; g = pg8::Gemm{A, Bt, MC, 1024, 256, K};
                   E.O = (float*)(ws + WS_YP) - (size_t)MX * 1024; E.pstride = MC * 1024; E.ntp = 4; }
        } else {
            const bf16_t* Wt = (const bf16_t*)(ws + WS_WIN) + (size_t)l * INW * 1024;
            if (pass == 0) { g = pg8::Gemm{XN, Wt, MT, 1536, 1024, 1024}; E.mode = EPI_QKU; E.perm = false; E.O = ws + WS_Q; E.ldc = 512; }
            else { g = pg8::Gemm{Wt + (size_t)1536 * 1024, XN, 512, MT, 1024, 1024}; E.mode = EPI_BF16; E.perm = true; E.O = ws + WS_VT; E.ldc = MT; cu = G - 1 - bx; }
        }
        pg8::StaticOrder S; S.init(g.M, g.N, G, cu, pm0, ksplit, ntp);
        pg8::gemm_phase<EpiAny, pg8::StaticOrder, true, true>(lds, g, S, E);
    }
}

__global__ void __launch_bounds__(NTHREADS, 2) mega(Params P, int ph_lo, int ph_hi) {
    extern __shared__ __attribute__((aligned(16))) unsigned char lds_raw[];
    LAS unsigned char* lds = (LAS unsigned char*)lds_raw;
    cg::grid_group grid = cg::this_grid();
    volatile LAS unsigned* bst = (volatile LAS unsigned*)(lds + 131072 + 64);
    if (threadIdx.x < 2) bst[threadIdx.x] = 0u;
    __syncthreads();
    XcdBarrier bar;
    { KParams kp0 = (KParams)__builtin_amdgcn_kernarg_segment_ptr(); bar = xcd_barrier_post((unsigned*)(kp0->ws + WS_BAR), bst); }
    KParams kp = (KParams)__builtin_amdgcn_kernarg_segment_ptr();
#if defined(PROBE_REP_PH)
    const int nextra = PROBE_REPS - 1;
#else
    const int nextra = 0;
#endif
    const int nsteps = ph_hi - ph_lo + nextra;
    for (int step = 0; step < nsteps; ++step) {
        int ph = ph_lo + step;
#if defined(PROBE_REP_PH)
        if (ph > PROBE_REP_PH) ph = (ph <= PROBE_REP_PH + nextra) ? PROBE_REP_PH : ph - nextra;
#endif
        asm volatile("" : "+s"(kp));
        int tid = threadIdx.x; asm volatile("" : "+v"(tid));
        const int lane = tid & 63, wave = __builtin_amdgcn_readfirstlane(tid >> 6);
        int bx = blockIdx.x, G = gridDim.x; asm volatile("" : "+s"(bx), "+s"(G));
        run_phase(kp, ph, lds, tid, wave, lane, bx, G);
        if (step + 1 < nsteps) { if (ph_lo < 0) grid.sync(); else xcd_barrier(bar); }
    }
}

extern "C" void kernel_launch(void* const* d_in, const int* in_sizes, int n_in, void* d_out, int out_size, void* d_ws, size_t ws_size, hipStream_t stream) {
    static int grid = 0;
    if (grid == 0) {
        if (n_in != 14 || in_sizes[0] != MX * DM || out_size != MX * DM || ws_size < WS_END) {
            fprintf(stderr, "kernel_launch: unexpected shapes (n_in %d, in0 %d, out %d, ws %zu < %zu)\n", n_in, n_in > 0 ? in_sizes[0] : -1, out_size, ws_size, (size_t)WS_END); grid = -1; return; }
        int dev = 0, cus = 0, per_cu = 0;
        (void)hipGetDevice(&dev); (void)hipDeviceGetAttribute(&cus, hipDeviceAttributeMultiprocessorCount, dev);
        if (hipFuncSetAttribute((const void*)mega, hipFuncAttributeMaxDynamicSharedMemorySize, LDS_BYTES) != hipSuccess) { fprintf(stderr, "kernel_launch: hipFuncSetAttribute failed\n"); grid = -1; return; }
        if (hipOccupancyMaxActiveBlocksPerMultiprocessor(&per_cu, (const void*)mega, NTHREADS, LDS_BYTES) != hipSuccess || per_cu < 1) { fprintf(stderr, "kernel_launch: occupancy query gave %d\n", per_cu); per_cu = 1; }
        (void)hipGetLastError();
        grid = cus * 1;
        if (grid <= 0) grid = 256;
    }
    if (grid < 0) return;
    if (hipMemsetAsync((char*)d_ws + WS_BAR, 0, 65536, stream) != hipSuccess) { fprintf(stderr, "kernel_launch: memset failed\n"); return; }
    Params p{};
    p.x = (const float*)d_in[0]; p.c = (const float*)d_in[1]; p.ctx = (const float*)d_in[2]; p.cctx = (const float*)d_in[3];
    p.wmod = (const float*)d_in[4]; p.bmod = (const float*)d_in[5]; p.normg = (const float*)d_in[6]; p.wgu = (const float*)d_in[7];
    p.wd = (const float*)d_in[8]; p.win = (const float*)d_in[9]; p.wout = (const float*)d_in[10]; p.rpb = (const float*)d_in[11];
    p.wpool = (const float*)d_in[12]; p.pscale = (const float*)d_in[13];
    p.out = (float*)d_out; p.ws = (unsigned char*)d_ws;
#if MK_MULTI
    for (int ph = 0; ph < NPHASE; ++ph) {
        int lo = ph, hi = ph + 1; void* args[] = {&p, &lo, &hi};
        hipError_t e = hipLaunchCooperativeKernel((const void*)mega, dim3(grid), dim3(NTHREADS), args, LDS_BYTES, stream);
        if (e != hipSuccess) { fprintf(stderr, "launch %d failed: %s\n", ph, hipGetErrorString(e)); break; }
    }
#else
#ifndef MK_PH_HI
#define MK_PH_HI NPHASE
#endif
#ifndef MK_PH_LO
#define MK_PH_LO 0
#endif
    int lo = MK_PH_LO, hi = MK_PH_HI; void* args[] = {&p, &lo, &hi};
    hipError_t e = hipLaunchCooperativeKernel((const void*)mega, dim3(grid), dim3(NTHREADS), args, LDS_BYTES, stream);
    if (e != hipSuccess) fprintf(stderr, "cooperative launch failed: %s (grid %d)\n", hipGetErrorString(e), grid);
#endif
}
```

```cpp
#include <hip/hip_runtime.h>
#include <hip/hip_cooperative_groups.h>
#include <cstdio>
#include <cstdint>
namespace cg = cooperative_groups;
namespace pg8 {
#define PG8_LAS __attribute__((address_space(3)))
typedef unsigned short bf16_t;
typedef short bf16x8 __attribute__((ext_vector_type(8)));
typedef float f32x4 __attribute__((ext_vector_type(4)));
typedef unsigned u32x4 __attribute__((ext_vector_type(4)));
constexpr int BM = 256, BK = 64, HALF = 128, HTB = HALF * BK * 2  , STAGE_BYTES = 8 * HTB, NXCD = 8, WGM = 8;

__host__ __device__ __forceinline__ int lds_byte(int r, int c) { const int st = (r >> 4) * 2 + (c >> 5), rr = r & 15, cc = c & 31, ob = rr * 64 + cc * 2; return st * 1024 + (ob ^ (((ob >> 9) & 1) << 5)); }
__host__ __device__ __forceinline__ void stage_rc(int b, int& R, int& C) { const int st = b / 1024, sb = b % 1024, swz = sb ^ (((sb >> 9) & 1) << 5); R = (st >> 1) * 16 + swz / 64; C = (st & 1) * 32 + (swz % 64) / 2; }
__host__ __device__ __forceinline__ int perm32(int rho) { const int n = rho >> 4, i = rho & 15; return 8 * (i >> 2) + 4 * n + (i & 3); }

struct Unit { int pm, pn, kb; };
struct Gemm { const bf16_t* A; const bf16_t* Bt; int M, N, K, ld; };

struct StaticOrder {
    int nM, nN, nwg, G, c, pm0, ksplit, ntp;
    __host__ __device__ void init(int M, int N, int G_, int c_, int pm0_ = 0, int ksplit_ = 1, int ntp_ = 0) { nM = M / BM; nN = N / BM; nwg = nM * nN * ksplit_; G = G_; c = c_; pm0 = pm0_; ksplit = ksplit_; ntp = ntp_; }
    __host__ __device__ bool next(int i, Unit& u) const {
        const long L = (long)i * G + c; if (L >= nwg) return false;
        int wgid = (int)L; u.kb = (wgid % ksplit) * ntp; wgid /= ksplit; { const int nwg = nM * nN; const int q = nwg / NXCD, r = nwg % NXCD, xcd = wgid % NXCD, off = wgid / NXCD; wgid = (xcd < r ? xcd * (q + 1) : r * (q + 1) + (xcd - r) * q) + off; }
        const int nig = WGM * nN, gid = wgid / nig, fm = gid * WGM, gsz = (nM - fm) < WGM ? (nM - fm) : WGM;
        u.pm = pm0 + fm + ((wgid % nig) % gsz); u.pn = (wgid % nig) / gsz; return true;
    }
    __device__ __forceinline__ void a_ready(const Unit&) const {}
    __device__ __forceinline__ void done(const Unit&) const {}
};

__device__ __forceinline__ unsigned cvt_pk_bf16(float lo, float hi) { unsigned r; asm volatile("v_cvt_pk_bf16_f32 %0, %1, %2" : "=v"(r) : "v"(lo), "v"(hi)); return r; }
typedef float f32x2 __attribute__((ext_vector_type(2)));
template <class Epi, class Sched, bool ALIGN_EPI = false, bool SP2 = false>
__device__ __forceinline__ void gemm_phase(PG8_LAS unsigned char* lds, const Gemm g, const Sched& S, const Epi& E) {
    int tid_raw = threadIdx.x; asm volatile("" : "+v"(tid_raw));
    const int tid = tid_raw, wid = __builtin_amdgcn_readfirstlane(tid >> 6), lane = tid & 63, wr = wid >> 2, wc = wid & 3, fr = lane & 15, fq = lane >> 4;
    const int K = g.ld, nt = g.K / BK;
    unsigned voffA[2], voffB[2];
#pragma unroll
    for (int i = 0; i < 2; ++i) { int R, C; stage_rc(tid * 16 + i * 8192, R, C); const int Rb = E.perm ? ((R & ~31) + perm32(R & 31)) : R;
        voffA[i] = (unsigned)(R * K + C) * 2u; voffB[i] = (unsigned)(Rb * K + C) * 2u; }
    const size_t kstep = (size_t)(BK * 2);
    const size_t hstep = (size_t)HALF * K * 2;
    const size_t tstep = 2 * hstep;
    const unsigned ldsw = (unsigned)wid * 1024u;
    const int aoff = lds_byte(wr * 64 + fr, fq * 8), boff = lds_byte(wc * 32 + fr, fq * 8);
#define PG8_SA(b, h) (((b) * 2 + (h)) * HTB)
#define PG8_SB(b, h) ((4 + (b) * 2 + (h)) * HTB)
#define PG8_STAGE(bufoff, gbase, voff) do { _Pragma("unroll") for (int _i = 0; _i < 2; ++_i) \
        __builtin_amdgcn_global_load_lds((const unsigned*)((const char*)(gbase) + (voff)[_i]), (PG8_LAS unsigned*)(lds + (bufoff) + ldsw + _i * 8192), 16, 0, 0); } while (0)
#define PG8_LDA(dst, b, h) do { _Pragma("unroll") for (int m = 0; m < 4; ++m) _Pragma("unroll") for (int k = 0; k < 2; ++k) dst[m][k] = *(const PG8_LAS bf16x8*)(lds + PG8_SA(b, h) + aoff + m * 2048 + k * 1024); } while (0)
#define PG8_LDB(dst, b, h) do { _Pragma("unroll") for (int n = 0; n < 2; ++n) _Pragma("unroll") for (int k = 0; k < 2; ++k) dst[n][k] = *(const PG8_LAS bf16x8*)(lds + PG8_SB(b, h) + boff + n * 2048 + k * 1024); } while (0)
#define PG8_MMA(ai, bj, At, Bt) do { __builtin_amdgcn_s_setprio(1); _Pragma("unroll") for (int m = 0; m < 4; ++m) _Pragma("unroll") for (int n = 0; n < 2; ++n) _Pragma("unroll") for (int k = 0; k < 2; ++k) \
        acc[ai][bj][m][n] = __builtin_amdgcn_mfma_f32_16x16x32_bf16(Bt[n][k], At[m][k], acc[ai][bj][m][n], 0, 0, 0); __builtin_amdgcn_s_setprio(0); } while (0)
#define PG8_WAIT_V(n) asm volatile("s_waitcnt vmcnt(" #n ")" ::: "memory")
#define PG8_WAIT_L(n) asm volatile("s_waitcnt lgkmcnt(" #n ")" ::: "memory")
#define PG8_BAR __builtin_amdgcn_s_barrier()
#define PG8_SCHED __builtin_amdgcn_sched_barrier(0)
    Unit cur, nxt; int ui = 0;
    if (!S.next(0, cur)) return;
    f32x4 acc[2][2][4][2];
#pragma unroll
    for (int a = 0; a < 2; ++a)
#pragma unroll
        for (int b = 0; b < 2; ++b)
#pragma unroll
            for (int m = 0; m < 4; ++m)
#pragma unroll
                for (int n = 0; n < 2; ++n) acc[a][b][m][n] = (f32x4){0.f, 0.f, 0.f, 0.f};
    bf16x8 At[4][2], B0[2][2], B1[2][2];
    const char* cA = (const char*)g.A + (size_t)cur.pm * tstep + (size_t)cur.kb * (BK * 2); const char* cB = (const char*)g.Bt + (size_t)cur.pn * tstep + (size_t)cur.kb * (BK * 2);
    S.a_ready(cur);
    if constexpr (SP2) {
        PG8_STAGE(PG8_SB(0, 0), cB, voffB); PG8_STAGE(PG8_SB(0, 1), cB + hstep, voffB); PG8_STAGE(PG8_SA(0, 0), cA, voffA); PG8_STAGE(PG8_SA(0, 1), cA + hstep, voffA);
        if (wr == 1) PG8_BAR;
        PG8_WAIT_V(2); PG8_BAR;
        PG8_STAGE(PG8_SB(1, 0), cB + kstep, voffB); PG8_STAGE(PG8_SA(1, 0), cA + kstep, voffA); PG8_STAGE(PG8_SB(1, 1), cB + hstep + kstep, voffB);
        PG8_WAIT_V(6); PG8_BAR;
    } else {
        PG8_STAGE(PG8_SB(0, 0), cB, voffB); PG8_STAGE(PG8_SA(0, 0), cA, voffA); PG8_STAGE(PG8_SB(0, 1), cB + hstep, voffB); PG8_STAGE(PG8_SA(0, 1), cA + hstep, voffA);
        if (wr == 1) PG8_BAR;
        PG8_WAIT_V(4); PG8_BAR;
        PG8_STAGE(PG8_SB(1, 0), cB + kstep, voffB); PG8_STAGE(PG8_SA(1, 0), cA + kstep, voffA); PG8_STAGE(PG8_SB(1, 1), cB + hstep + kstep, voffB);
        PG8_WAIT_V(6); PG8_BAR;
    }
    for (;;) {
        const bool has_next = S.next(ui + 1, nxt);
        const char* nA = has_next ? (const char*)g.A + (size_t)nxt.pm * tstep + (size_t)nxt.kb * (BK * 2) : cA; const char* nB = has_next ? (const char*)g.Bt + (size_t)nxt.pn * tstep + (size_t)nxt.kb * (BK * 2) : cB;
        for (int t = 0; t < nt; t += 2) {
            const bool last = (t == nt - 2);
            const char* a1 = cA + (size_t)(t + 1) * kstep;
            const char* a2 = last ? nA : cA + (size_t)(t + 2) * kstep; const char* b2 = last ? nB : cB + (size_t)(t + 2) * kstep;
            const char* a3 = a2 + kstep; const char* b3 = b2 + kstep;
            if (last && has_next) S.a_ready(nxt);
            if constexpr (SP2) {
            PG8_LDB(B0, 0, 0); PG8_LDB(B1, 0, 1); PG8_SCHED; PG8_LDA(At, 0, 0); PG8_STAGE(PG8_SA(1, 1), a1 + hstep, voffA);
            PG8_WAIT_V(8); PG8_WAIT_L(0); PG8_BAR; PG8_MMA(0, 0, At, B0); PG8_MMA(0, 1, At, B1); PG8_BAR; PG8_SCHED;
            PG8_LDA(At, 0, 1); PG8_STAGE(PG8_SB(0, 0), b2, voffB); PG8_STAGE(PG8_SB(0, 1), b2 + hstep, voffB); PG8_STAGE(PG8_SA(0, 0), a2, voffA);
            PG8_WAIT_V(8); PG8_WAIT_L(0); PG8_BAR; PG8_MMA(1, 0, At, B0); PG8_MMA(1, 1, At, B1); PG8_BAR; PG8_SCHED;
            PG8_LDB(B0, 1, 0); PG8_LDB(B1, 1, 1); PG8_SCHED; PG8_LDA(At, 1, 0); PG8_STAGE(PG8_SA(0, 1), a2 + hstep, voffA);
            PG8_WAIT_V(8); PG8_WAIT_L(0); PG8_BAR; PG8_MMA(0, 0, At, B0); PG8_MMA(0, 1, At, B1); PG8_BAR; PG8_SCHED;
            PG8_LDA(At, 1, 1); PG8_STAGE(PG8_SB(1, 0), b3, voffB); PG8_STAGE(PG8_SB(1, 1), b3 + hstep, voffB); PG8_STAGE(PG8_SA(1, 0), a3, voffA);
            PG8_WAIT_V(8); PG8_WAIT_L(0); PG8_BAR; PG8_MMA(1, 0, At, B0); PG8_MMA(1, 1, At, B1); PG8_BAR; PG8_SCHED;
            } else {
            PG8_LDB(B0, 0, 0); PG8_SCHED; PG8_LDA(At, 0, 0); PG8_STAGE(PG8_SA(1, 1), a1 + hstep, voffA);
            PG8_WAIT_L(8); PG8_BAR; PG8_WAIT_L(0); PG8_MMA(0, 0, At, B0); PG8_BAR; PG8_SCHED;
            PG8_LDB(B1, 0, 1); PG8_STAGE(PG8_SB(0, 0), b2, voffB);
            PG8_BAR; PG8_WAIT_L(0); PG8_MMA(0, 1, At, B1); PG8_BAR;
            PG8_LDA(At, 0, 1); PG8_STAGE(PG8_SA(0, 0), a2, voffA);
            PG8_BAR; PG8_WAIT_L(0); PG8_MMA(1, 0, At, B0); PG8_BAR; PG8_SCHED;
            PG8_STAGE(PG8_SB(0, 1), b2 + hstep, voffB);
            PG8_WAIT_V(6); PG8_BAR; PG8_MMA(1, 1, At, B1); PG8_BAR;
            PG8_LDB(B0, 1, 0); PG8_SCHED; PG8_LDA(At, 1, 0); PG8_STAGE(PG8_SA(0, 1), a2 + hstep, voffA);
            PG8_WAIT_L(8); PG8_BAR; PG8_WAIT_L(0); PG8_MMA(0, 0, At, B0); PG8_BAR; PG8_SCHED;
            PG8_LDB(B1, 1, 1); PG8_STAGE(PG8_SB(1, 0), b3, voffB);
            PG8_BAR; PG8_WAIT_L(0); PG8_MMA(0, 1, At, B1); PG8_BAR;
            PG8_LDA(At, 1, 1); PG8_STAGE(PG8_SA(1, 0), a3, voffA);
            PG8_BAR; PG8_WAIT_L(0); PG8_MMA(1, 0, At, B0); PG8_BAR; PG8_SCHED;
            PG8_STAGE(PG8_SB(1, 1), b3 + hstep, voffB);
            PG8_WAIT_V(6); PG8_BAR; PG8_MMA(1, 1, At, B1); PG8_BAR;
            }
        }
        if constexpr (ALIGN_EPI) { if (wr == 0) PG8_BAR; }
        if constexpr (!Epi::AFTER_DRAIN) { E(acc, cur, wr, wc, fr, fq); S.done(cur); }
        if (!has_next) break;
#pragma unroll
        for (int a = 0; a < 2; ++a)
#pragma unroll
            for (int b = 0; b < 2; ++b)
#pragma unroll
                for (int m = 0; m < 4; ++m)
#pragma unroll
                    for (int n = 0; n < 2; ++n) acc[a][b][m][n] = (f32x4){0.f, 0.f, 0.f, 0.f};
        cur = nxt; cA = nA; cB = nB; ++ui;
        if constexpr (ALIGN_EPI) { if (wr == 1) PG8_BAR; }
    }
    PG8_WAIT_V(0);
    if constexpr (!ALIGN_EPI) { if (wr == 0) PG8_BAR; }
    PG8_BAR;
    if constexpr (Epi::AFTER_DRAIN) { E.fused(acc, cur, wr, wc, fr, fq, lds, wid, lane); S.done(cur); }
#undef PG8_SA
#undef PG8_SB
#undef PG8_STAGE
#undef PG8_LDA
#undef PG8_LDB
#undef PG8_MMA
#undef PG8_WAIT_V
#undef PG8_WAIT_L
#undef PG8_BAR
#undef PG8_SCHED
}
}

#ifndef MK_MULTI
#define MK_MULTI 0
#endif
typedef unsigned short bf16_t;
typedef short bf16x8 __attribute__((ext_vector_type(8)));
typedef float f32x4 __attribute__((ext_vector_type(4)));
typedef float f32x16 __attribute__((ext_vector_type(16)));
typedef unsigned u32x4 __attribute__((ext_vector_type(4)));
typedef unsigned u32x2 __attribute__((ext_vector_type(2)));
typedef float f32x2_t __attribute__((ext_vector_type(2)));
typedef __bf16 bf16x2_t __attribute__((ext_vector_type(2)));
#define LAS __attribute__((address_space(3)))

constexpr int DM = 1024, SEQ = 8192, NB = 2, CTXL = 256, MX = NB * SEQ, MC = NB * CTXL, MT = MX + MC;
constexpr int DFF = 2816, NH = 8, HD = 64, INW = 2048, NMODW = 9 * DM;
constexpr float RMS_EPS = 1e-6f;
constexpr float LOG2E = 1.4426950408889634f;
constexpr float QSCALE = 0.125f * LOG2E;
constexpr int NPHASE = 22;
constexpr int NTHREADS = 512, NWAVES = 8;
constexpr int LDS_BYTES = 147456;

constexpr size_t MiB = 1u << 20;
constexpr size_t WS_MOD = 0;
constexpr size_t WS_ROPEC = 256 * 1024;
constexpr size_t WS_ROPES = 256 * 1024 + 8192;
constexpr size_t WS_BAR = 3 * MiB;
constexpr size_t WS_CTXS = 512 * 1024;
constexpr size_t WS_WGU = 4 * MiB;
constexpr size_t WS_WD = 48 * MiB;
constexpr size_t WS_WIN = 70 * MiB;
constexpr size_t WS_WOUT = 78 * MiB;
constexpr size_t WS_XN = 82 * MiB;
constexpr size_t WS_Y = 115 * MiB;
constexpr size_t WS_XS = 147 * MiB;
constexpr size_t WS_H = 211 * MiB;
constexpr size_t SZ_QK = (size_t)MT * 512 * 2;
constexpr size_t WS_Q = WS_H, WS_K = WS_Q + SZ_QK, WS_U = WS_K + SZ_QK, WS_VT = WS_U + SZ_QK, WS_MIX = WS_VT + SZ_QK;
constexpr size_t WS_YP = WS_MIX + (size_t)MT * 1024 * 2;
constexpr size_t WS_END = WS_YP + (size_t)11 * MC * 1024 * 4;
static_assert(WS_XN + (size_t)MT * 1024 * 2 <= WS_Y && WS_Y + (size_t)MX * 1024 * 2 <= WS_XS && WS_XS + (size_t)MX * 1024 * 4 <= WS_H && WS_H + (size_t)MT * DFF * 2 <= WS_YP, "ws map");

struct Params {
    const float *x, *c, *ctx, *cctx, *wmod, *bmod, *normg, *wgu, *wd, *win, *wout, *rpb, *wpool, *pscale;
    float* out; unsigned char* ws;
};
typedef const __attribute__((address_space(4))) Params* KParams;

__device__ __forceinline__ unsigned cvtpk(float lo, float hi) { f32x2_t v = {lo, hi}; bf16x2_t b = __builtin_convertvector(v, bf16x2_t); return __builtin_bit_cast(unsigned, b); }
__device__ __forceinline__ float bf2f(unsigned short h) { return __uint_as_float(((unsigned)h) << 16); }
__device__ __forceinline__ float wave_sum(float v) {
#pragma unroll
    for (int o = 1; o < 64; o <<= 1) v += __shfl_xor(v, o);
    return v;
}

#define XB_TMO      128
#define XB_XCNT(j)  (256  + 64 * (j))
#define XB_XSUB(j)  (1280 + 64 * (j))
#define XB_XGEN(j)  (2304 + 64 * (j))
#define XB_TOP      3328
#define XB_TOPGEN   3392
#define XCD_BAR_WORDS 3456
#define XB_SPIN_CAP (1u << 18)

__device__ __forceinline__ unsigned xb_ld(unsigned* p)              { return __hip_atomic_load(p, __ATOMIC_RELAXED, __HIP_MEMORY_SCOPE_AGENT); }
__device__ __forceinline__ unsigned xb_add(unsigned* p, unsigned v) { return __hip_atomic_fetch_add(p, v, __ATOMIC_RELAXED, __HIP_MEMORY_SCOPE_AGENT); }
__device__ __forceinline__ unsigned xb_xcc_id() { return (unsigned)__builtin_amdgcn_s_getreg((3 << 11) | 20) & 0xFu; }
#define XB_SPIN(cond, bar) do { unsigned _sp = 0; while (cond) { __builtin_amdgcn_s_sleep(1); \
    if ((++_sp & 255u) == 0u) { if (xb_ld(&(bar)[XB_TMO])) break; if (_sp > XB_SPIN_CAP) { atomicAdd(&(bar)[XB_TMO], 1u); break; } } } } while (0)

struct XcdBarrier {
    unsigned* bar; unsigned x;
    volatile LAS unsigned* st;
};

__device__ __forceinline__ XcdBarrier xcd_barrier_post(unsigned* bar, volatile LAS unsigned* st) {
    XcdBarrier b; b.bar = bar; b.x = xb_xcc_id(); b.st = st;
    if (threadIdx.x == 0) (void)xb_add(&bar[XB_XCNT(b.x)], 1u);
    return b;
}
__device__ __forceinline__ void xcd_barrier_complete(unsigned* bar, unsigned x, unsigned& nloc, unsigned& nx) {
    const unsigned G = gridDim.x * gridDim.y * gridDim.z;
    unsigned sum, cnt, mine, sp = 0u;
    for (;;) {
        sum = 0u; cnt = 0u; mine = 0u;
#pragma unroll
        for (unsigned j = 0; j < 16; ++j) { const unsigned c = xb_ld(&bar[XB_XCNT(j)]); sum += c; cnt += (c > 0u) ? 1u : 0u; mine = (j == x) ? c : mine; }
        if (sum == G) break;
        __builtin_amdgcn_s_sleep(1);
        if ((++sp & 255u) == 0u) { if (xb_ld(&bar[XB_TMO])) break; if (sp > XB_SPIN_CAP) { atomicAdd(&bar[XB_TMO], 1u); break; } }
    }
    nloc = mine > 0u ? mine : 1u; nx = cnt > 0u ? cnt : 1u;
}

__device__ __forceinline__ void xcd_barrier(const XcdBarrier& b) {
    asm volatile("s_waitcnt vmcnt(0)" ::: "memory");
    __syncthreads();
    if (threadIdx.x == 0) {
        unsigned* bar = b.bar;
        __builtin_amdgcn_s_waitcnt(0);
        unsigned nloc = b.st[0], nx = b.st[1];
        if (nloc == 0u) { xcd_barrier_complete(bar, b.x, nloc, nx); b.st[0] = nloc; b.st[1] = nx; }
        const unsigned old = xb_add(&bar[XB_XSUB(b.x)], 1u);
        const unsigned gen = old / nloc;
        if (old + 1u == (gen + 1u) * nloc) {
            __builtin_amdgcn_fence(__ATOMIC_RELEASE, "agent");
            asm volatile("s_waitcnt vmcnt(0)" ::: "memory");
            const unsigned og = xb_add(&bar[XB_TOP], 1u);
            const unsigned tg = og / nx;
            if (og + 1u == (tg + 1u) * nx) xb_add(&bar[XB_TOPGEN], 1u);
            else XB_SPIN(xb_ld(&bar[XB_TOPGEN]) == tg, bar);
            __builtin_amdgcn_fence(__ATOMIC_ACQUIRE, "agent");
            xb_add(&bar[XB_XGEN(b.x)], 1u);
            asm volatile("s_waitcnt vmcnt(0)" ::: "memory");
        } else {
            XB_SPIN(xb_ld(&bar[XB_XGEN(b.x)]) == gen, bar);
            __builtin_amdgcn_fence(__ATOMIC_ACQUIRE, "agent");
            asm volatile("s_waitcnt vmcnt(0)" ::: "memory");
        }
    }
    __syncthreads();
}

using pg8::Unit;
enum { EPI_SWIGLU = 0, EPI_F32 = 1, EPI_QKU = 2, EPI_BF16 = 3 };
struct EpiAny {
    static constexpr bool AFTER_DRAIN = false;
    int mode; bool perm; void* O; int ldc; const float *ropeC, *ropeS; int pstride, ntp;
    __device__ __forceinline__ static float sw(float g, float u) { return g * u * __builtin_amdgcn_rcpf(1.0f + __builtin_amdgcn_exp2f(-g * LOG2E)); }
    __device__ __forceinline__ void operator()(const f32x4 (&acc)[2][2][4][2], const Unit& u, int wr, int wc, int fr, int fq) const {
        if (mode == EPI_SWIGLU) {
            bf16_t* H = (bf16_t*)O;
            const int row0 = u.pm * 256 + wr * 64 + fr, col0 = u.pn * 128 + wc * 32 + 8 * fq;
#pragma unroll
            for (int ai = 0; ai < 2; ++ai)
#pragma unroll
                for (int m = 0; m < 4; ++m) {
                    bf16_t* p = H + (size_t)(row0 + ai * 128 + m * 16) * DFF + col0;
                    const f32x4 g0 = acc[ai][0][m][0], g1 = acc[ai][0][m][1], u0 = acc[ai][1][m][0], u1 = acc[ai][1][m][1];
                    f32x4 e0 = g0 * (-LOG2E), e1 = g1 * (-LOG2E);
#pragma unroll
                    for (int i = 0; i < 4; ++i) { e0[i] = __builtin_amdgcn_exp2f(e0[i]); e1[i] = __builtin_amdgcn_exp2f(e1[i]); }
                    e0 = e0 + 1.0f; e1 = e1 + 1.0f;
#pragma unroll
                    for (int i = 0; i < 4; ++i) { e0[i] = __builtin_amdgcn_rcpf(e0[i]); e1[i] = __builtin_amdgcn_rcpf(e1[i]); }
                    const f32x4 o0 = (g0 * u0) * e0, o1 = (g1 * u1) * e1;
                    u32x4 w; w.x = cvtpk(o0[0], o0[1]); w.y = cvtpk(o0[2], o0[3]); w.z = cvtpk(o1[0], o1[1]); w.w = cvtpk(o1[2], o1[3]);
                    *(u32x4*)p = w;
                }
        } else if (mode == EPI_F32) {
            float* Y = (float*)O + ((ntp > 0) ? (size_t)(u.kb / ntp) * (size_t)pstride : (size_t)0);
            const int row0 = u.pm * 256 + wr * 64 + fr, col0 = u.pn * 256 + wc * 32 + 4 * fq;
#pragma unroll
            for (int ai = 0; ai < 2; ++ai)
#pragma unroll
                for (int m = 0; m < 4; ++m) {
                    float* p = Y + (size_t)(row0 + ai * 128 + m * 16) * ldc + col0;
#pragma unroll
                    for (int bj = 0; bj < 2; ++bj)
#pragma unroll
                        for (int n = 0; n < 2; ++n) *(f32x4*)(p + bj * 128 + n * 16) = acc[ai][bj][m][n];
                }
        } else if (mode == EPI_QKU) {
            const int t = u.pn >> 1; bf16_t* base = (bf16_t*)O + (size_t)t * ((size_t)MT * 512);
            const float sc = (t == 0) ? QSCALE : 1.0f;
            const bool rope = (t < 2) && (u.pm < MX / 256);
            const int cb = (u.pn & 1) * 256 + wc * 32 + 4 * fq;
#pragma unroll
            for (int ai = 0; ai < 2; ++ai)
#pragma unroll
                for (int m = 0; m < 4; ++m) {
                    const int row = u.pm * 256 + ai * 128 + wr * 64 + m * 16 + fr;
                    bf16_t* p = base + (size_t)row * 512 + cb;
                    f32x4 c4 = {1.f, 1.f, 1.f, 1.f}, s4 = {0.f, 0.f, 0.f, 0.f};
                    if (rope) { const int s = row & (SEQ - 1); const int pos = (wc & 1) ? (s & 63) : (s >> 6);
                        c4 = *(const f32x4*)(ropeC + pos * 16 + 4 * fq); s4 = *(const f32x4*)(ropeS + pos * 16 + 4 * fq); }
#pragma unroll
                    for (int bj = 0; bj < 2; ++bj) {
                        const f32x4 x1 = acc[ai][bj][m][0], x2 = acc[ai][bj][m][1];
                        const f32x4 o1 = (x1 * c4 - x2 * s4) * sc, o2 = (x2 * c4 + x1 * s4) * sc;
                        u32x2 w1, w2; w1.x = cvtpk(o1[0], o1[1]); w1.y = cvtpk(o1[2], o1[3]); w2.x = cvtpk(o2[0], o2[1]); w2.y = cvtpk(o2[2], o2[3]);
                        *(u32x2*)(p + bj * 128) = w1; *(u32x2*)(p + bj * 128 + 16) = w2;
                    }
                }
        } else {
            bf16_t* Ob = (bf16_t*)O;
            const int row0 = u.pm * 256 + wr * 64 + fr, col0 = u.pn * 256 + wc * 32 + 8 * fq;
#pragma unroll
            for (int ai = 0; ai < 2; ++ai)
#pragma unroll
                for (int m = 0; m < 4; ++m) {
                    bf16_t* p = Ob + (size_t)(row0 + ai * 128 + m * 16) * ldc + col0;
#pragma unroll
                    for (int bj = 0; bj < 2; ++bj) { const f32x4 v0 = acc[ai][bj][m][0], v1 = acc[ai][bj][m][1];
                        u32x4 w; w.x = cvtpk(v0[0], v0[1]); w.y = cvtpk(v0[2], v0[3]); w.z = cvtpk(v1[0], v1[1]); w.w = cvtpk(v1[2], v1[3]);
                        *(u32x4*)(p + bj * 128) = w; }
                }
        }
    }
};

__device__ __forceinline__ void p0_transpose_item(const float* W, int ldw, int k0, int n0, bf16_t* WT, int ldt, int dst_row0, LAS unsigned char* scr, int lane) {
    f32x4 v[16];
    const float* src = W + (size_t)(k0 + (lane >> 4)) * ldw + n0 + 4 * (lane & 15);
#pragma unroll
    for (int i = 0; i < 16; ++i) v[i] = *(const f32x4*)(src + (size_t)(4 * i) * ldw);
#pragma unroll
    for (int i = 0; i < 16; ++i) { LAS unsigned* p = (LAS unsigned*)(scr + (4 * i + (lane >> 4)) * 132 + 8 * (lane & 15)); p[0] = cvtpk(v[i][0], v[i][1]); p[1] = cvtpk(v[i][2], v[i][3]); }
    asm volatile("s_waitcnt lgkmcnt(0)" ::: "memory");
    const int c = lane & 7;
#pragma unroll
    for (int j = 0; j < 4; ++j) { const int np = (lane >> 3) + 8 * j; unsigned w[8];
#pragma unroll
        for (int i = 0; i < 8; ++i) w[i] = *(const LAS unsigned*)(scr + (8 * c + i) * 132 + 4 * np);
        u32x4 lo, hi;
        lo.x = (w[0] & 0xffffu) | (w[1] << 16); lo.y = (w[2] & 0xffffu) | (w[3] << 16); lo.z = (w[4] & 0xffffu) | (w[5] << 16); lo.w = (w[6] & 0xffffu) | (w[7] << 16);
        hi.x = (w[0] >> 16) | (w[1] & 0xffff0000u); hi.y = (w[2] >> 16) | (w[3] & 0xffff0000u); hi.z = (w[4] >> 16) | (w[5] & 0xffff0000u); hi.w = (w[6] >> 16) | (w[7] & 0xffff0000u);
        *(u32x4*)(WT + (size_t)(dst_row0 + 2 * np) * ldt + k0 + 8 * c) = lo;
        *(u32x4*)(WT + (size_t)(dst_row0 + 2 * np + 1) * ldt + k0 + 8 * c) = hi; }
    asm volatile("s_waitcnt lgkmcnt(0)" ::: "memory");
}

__device__ __forceinline__ void phase_p0(KParams P, LAS unsigned char* lds, int tid, int wave, int lane, int bx, int G) {
    unsigned char* ws = P->ws;
    float* MOD = (float*)(ws + WS_MOD);
    const int gt = bx * NTHREADS + tid;
    if (gt < 2048) {
        const int pos = gt >> 4, i = gt & 15;
        const float inv = exp2f(-(float)i * 0.83048202372184058696f);
        const float angf = (float)pos * inv;
        const double a = (double)angf; const double kq = rint(a * 0.63661977236758134308); const double r = a - kq * 1.57079632679489661923; const double r2 = r * r;
        double sr = r, cr = 1.0, ts = r, tc = 1.0;
#pragma unroll 1
        for (int k = 1; k <= 8; ++k) { const double k2 = (double)(2 * k); tc *= -r2 / (k2 * (k2 - 1.0)); ts *= -r2 / (k2 * (k2 + 1.0)); cr += tc; sr += ts; }
        const int q = ((int)kq) & 3;
        const double cv = (q == 0) ? cr : (q == 1) ? -sr : (q == 2) ? -cr : sr;
        const double sv = (q == 0) ? sr : (q == 1) ? cr : (q == 2) ? -sr : -cr;
        ((float*)(ws + WS_ROPEC))[gt] = (float)cv; ((float*)(ws + WS_ROPES))[gt] = (float)sv;
    }
    constexpr int J_MOD = 72, J_FOLD = 128, J_TR = 1216, NJOBS = J_MOD + J_FOLD + J_TR;
    unsigned* jq = (unsigned*)(ws + WS_BAR + 32768);
    LAS int* jb = (LAS int*)(lds + 131072 + 128);
    for (;;) {
        if (tid == 0) *jb = (int)__hip_atomic_fetch_add(jq, 1u, __ATOMIC_RELAXED, __HIP_MEMORY_SCOPE_AGENT);
        __syncthreads();
        const int job = *jb;
        __syncthreads();
        if (job >= NJOBS) break;
        if (job < J_MOD) {
            LAS float* sc = (LAS float*)lds;
            LAS float* red = sc + 3072;
            for (int i = tid; i < 3072; i += NTHREADS) { const int who = i >> 10, k = i & 1023; const float v = (who < 2) ? P->c[who * 1024 + k] : P->cctx[k]; sc[i] = v / (1.0f + __expf(-v)); }
            __syncthreads();
            const int l = job / 36, cc = job % 36, col = cc * 256 + 4 * lane;
            const float* W = P->wmod + ((size_t)l * 1024 + wave * 128) * NMODW + col;
            f32x4 a0 = {0.f, 0.f, 0.f, 0.f}, a1 = a0, a2 = a0;
#pragma unroll 16
            for (int k = 0; k < 128; ++k) { const f32x4 w = *(const f32x4*)(W + (size_t)k * NMODW); const int kk = wave * 128 + k; a0 += w * sc[kk]; a1 += w * sc[1024 + kk]; a2 += w * sc[2048 + kk]; }
            *(LAS f32x4*)(red + (wave * 3 + 0) * 256 + 4 * lane) = a0; *(LAS f32x4*)(red + (wave * 3 + 1) * 256 + 4 * lane) = a1; *(LAS f32x4*)(red + (wave * 3 + 2) * 256 + 4 * lane) = a2;
            __syncthreads();
            for (int o = tid; o < 768; o += NTHREADS) { const int who = o >> 8, cl = o & 255; float s = 0.f;
#pragma unroll
                for (int w = 0; w < 8; ++w) s += red[(w * 3 + who) * 256 + cl];
                MOD[(size_t)(l * 3 + who) * NMODW + cc * 256 + cl] = s + P->bmod[l * NMODW + cc * 256 + cl]; }
            __syncthreads();
        } else if (job < J_MOD + J_FOLD) {
            const int r = job - J_MOD, nb = r & 15, g = (r >> 4) & 3, l = r >> 6;
            LAS float* A = (LAS float*)lds;
            LAS float* B = (LAS float*)(lds + 128 * 132 * 4);
            LAS bf16_t* OT = (LAS bf16_t*)(lds + 128 * 132 * 4 + 128 * 64 * 4);
            const float* wp = P->wpool + (size_t)(l * 4 + g) * 128 * 128; const float* ps = P->pscale + l * 512 + g * 128;
            const float* wo = P->wout + ((size_t)l * 1024 + 512 + g * 128) * 1024 + nb * 64;
#pragma unroll 8
            for (int i = 0; i < 32; ++i) { const int idx = tid + NTHREADS * i, c = idx >> 7, d = idx & 127; A[c * 132 + d] = wp[idx] * ps[d]; }
#pragma unroll 8
            for (int i = 0; i < 16; ++i) { const int idx = tid + NTHREADS * i, d = idx >> 6, n = idx & 63; B[idx] = wo[(size_t)d * 1024 + n]; }
            __syncthreads();
            const int c = tid >> 2, nq = tid & 3;
            f32x4 acc[4];
#pragma unroll
            for (int j = 0; j < 4; ++j) acc[j] = (f32x4){0.f, 0.f, 0.f, 0.f};
#pragma unroll 4
            for (int d = 0; d < 128; ++d) { const float a = A[c * 132 + d];
#pragma unroll
                for (int j = 0; j < 4; ++j) acc[j] += *(const LAS f32x4*)(B + d * 64 + 16 * nq + 4 * j) * a; }
#pragma unroll
            for (int j = 0; j < 4; ++j)
#pragma unroll
                for (int e = 0; e < 4; ++e) OT[(16 * nq + 4 * j + e) * 128 + c] = (bf16_t)(cvtpk(acc[j][e], 0.f) & 0xffffu);
            __syncthreads();
            bf16_t* dst = (bf16_t*)(ws + WS_WOUT) + ((size_t)l * 1024 + nb * 64) * 1024 + 512 + g * 128;
#pragma unroll
            for (int i = 0; i < 2; ++i) { const int ch = tid + NTHREADS * i, n = ch >> 4, cc8 = ch & 15; *(u32x4*)(dst + (size_t)n * 1024 + cc8 * 8) = *(const LAS u32x4*)(OT + n * 128 + cc8 * 8); }
            __syncthreads();
        } else {
            LAS unsigned char* scr = lds + wave * 8448;
            int tj = job - J_MOD - J_FOLD; const int wk = wave >> 2, wn = wave & 3;
            if (tj < 704) { const int ls = tj / 176, r = tj % 176, kb = r / 22, nb = r % 22, k0 = kb * 128 + wk * 64, n0 = nb * 256 + wn * 64;
                const int cidx = (n0 < DFF) ? n0 : n0 - DFF; const int drow = 256 * (cidx >> 7) + (cidx & 127) + ((n0 < DFF) ? 0 : 128);
                p0_transpose_item(P->wgu + (size_t)ls * 1024 * 5632, 5632, k0, n0, (bf16_t*)(ws + WS_WGU) + (size_t)ls * 5632 * 1024, 1024, drow, scr, lane); }
            else if ((tj -= 704) < 352) { const int ls = tj / 88, r = tj % 88, kb = r / 4, nb = r % 4, k0 = kb * 128 + wk * 64, n0 = nb * 256 + wn * 64;
                p0_transpose_item(P->wd + (size_t)ls * DFF * 1024, 1024, k0, n0, (bf16_t*)(ws + WS_WD) + (size_t)ls * 1024 * DFF, DFF, n0, scr, lane); }
            else if ((tj -= 352) < 128) { const int l = tj / 64, r = tj % 64, kb = r / 8, nb = r % 8, k0 = kb * 128 + wk * 64, n0 = nb * 256 + wn * 64;
                const int drow = (n0 < 1024) ? n0 : (n0 < 1536) ? n0 + 512 : n0 - 512;
                p0_transpose_item(P->win + (size_t)l * 1024 * INW, INW, k0, n0, (bf16_t*)(ws + WS_WIN) + (size_t)l * INW * 1024, 1024, drow, scr, lane); }
            else { tj -= 128; const int l = tj / 16, r = tj % 16, kb = r / 4, nb = r % 4, k0 = kb * 128 + wk * 64, n0 = nb * 256 + wn * 64;
                p0_transpose_item(P->wout + (size_t)l * 1024 * 1024, 1024, k0, n0, (bf16_t*)(ws + WS_WOUT) + (size_t)l * 1024 * 1024, 1024, n0, scr, lane); }
        }
    }
}

struct RowPass {
    const float *srcX, *srcC; float *dstX, *dstC; const bf16_t* srcXb; bf16_t* dstXb;
    const bf16_t* Yb; const float *gate, *gpost; float coef;
    const float *shift, *scale, *gpre; bf16_t* XN;
    int M; bool hasY, hasXN; const float* YP; int nparts;
};
template <int RPT> __device__ __forceinline__ void row_range(const RowPass& R, int lane, int gw, int NGW, int mlo, int mhi) {
    for (int m0 = mlo + RPT * gw; m0 < mhi; m0 += RPT * NGW) {
        const int who = (m0 < SEQ) ? 0 : (m0 < MX) ? 1 : 2;
        const bool isx = m0 < MX;
        f32x4 v[RPT][4];
#pragma unroll
        for (int rr = 0; rr < RPT; ++rr) { const int m = m0 + rr;
            if (isx && R.srcXb) {
#pragma unroll
                for (int j = 0; j < 4; ++j) { const u32x2 w = *(const u32x2*)(R.srcXb + (size_t)m * DM + 4 * lane + 256 * j);
                    v[rr][j] = (f32x4){__uint_as_float(w.x << 16), __uint_as_float(w.x & 0xffff0000u), __uint_as_float(w.y << 16), __uint_as_float(w.y & 0xffff0000u)}; }
            } else { const float* xin = isx ? R.srcX + (size_t)m * DM : R.srcC + (size_t)(m - MX) * DM;
#pragma unroll
                for (int j = 0; j < 4; ++j) v[rr][j] = *(const f32x4*)(xin + 4 * lane + 256 * j); } }
        if (R.hasY) {
            f32x4 y[RPT][4]; float ss[RPT];
#pragma unroll
            for (int rr = 0; rr < RPT; ++rr) ss[rr] = 0.f;
#pragma unroll
            for (int rr = 0; rr < RPT; ++rr) { const int m = m0 + rr;
#pragma unroll
                for (int j = 0; j < 4; ++j) {
                    if (isx) { const u32x2 w = *(const u32x2*)(R.Yb + (size_t)m * DM + 4 * lane + 256 * j);
                        y[rr][j] = (f32x4){__uint_as_float(w.x << 16), __uint_as_float(w.x & 0xffff0000u), __uint_as_float(w.y << 16), __uint_as_float(w.y & 0xffff0000u)}; }
                    else { f32x4 tp[11];
#pragma unroll
                        for (int p = 0; p < 11; ++p) tp[p] = *(const f32x4*)(R.YP + ((size_t)min(p, R.nparts - 1) * MC + (m - MX)) * DM + 4 * lane + 256 * j);
                        f32x4 t = tp[0];
#pragma unroll
                        for (int p = 1; p < 11; ++p) t += tp[p] * ((p < R.nparts) ? 1.0f : 0.0f);
                        y[rr][j] = t; }
                    ss[rr] += (y[rr][j].x * y[rr][j].x + y[rr][j].y * y[rr][j].y) + (y[rr][j].z * y[rr][j].z + y[rr][j].w * y[rr][j].w); } }
#pragma unroll
            for (int rr = 0; rr < RPT; ++rr) ss[rr] = wave_sum(ss[rr]);
#pragma unroll
            for (int rr = 0; rr < RPT; ++rr) { const int m = m0 + rr;
                const float rs = rsqrtf(ss[rr] * (1.0f / DM) + RMS_EPS) * R.coef;
#pragma unroll
                for (int j = 0; j < 4; ++j) { const int col = 4 * lane + 256 * j; const f32x4 gt = *(const f32x4*)(R.gate + who * NMODW + col), gp = *(const f32x4*)(R.gpost + col);
                    v[rr][j] = v[rr][j] + gt * (y[rr][j] * rs * gp); }
                if (isx && R.dstXb) {
#pragma unroll
                    for (int j = 0; j < 4; ++j) { u32x2 w; w.x = cvtpk(v[rr][j][0], v[rr][j][1]); w.y = cvtpk(v[rr][j][2], v[rr][j][3]); *(u32x2*)(R.dstXb + (size_t)m * DM + 4 * lane + 256 * j) = w;
                        v[rr][j] = (f32x4){__uint_as_float(w.x << 16), __uint_as_float(w.x & 0xffff0000u), __uint_as_float(w.y << 16), __uint_as_float(w.y & 0xffff0000u)}; }
                } else { float* xo = isx ? R.dstX + (size_t)m * DM : R.dstC + (size_t)(m - MX) * DM;
#pragma unroll
                    for (int j = 0; j < 4; ++j) *(f32x4*)(xo + 4 * lane + 256 * j) = v[rr][j]; } }
        }
        if (R.hasXN) {
            float ss[RPT];
#pragma unroll
            for (int rr = 0; rr < RPT; ++rr) ss[rr] = 0.f;
#pragma unroll
            for (int rr = 0; rr < RPT; ++rr)
#pragma unroll
                for (int j = 0; j < 4; ++j) ss[rr] += (v[rr][j].x * v[rr][j].x + v[rr][j].y * v[rr][j].y) + (v[rr][j].z * v[rr][j].z + v[rr][j].w * v[rr][j].w);
#pragma unroll
            for (int rr = 0; rr < RPT; ++rr) ss[rr] = wave_sum(ss[rr]);
#pragma unroll
            for (int rr = 0; rr < RPT; ++rr) { const int m = m0 + rr;
                const float rs = rsqrtf(ss[rr] * (1.0f / DM) + RMS_EPS);
#pragma unroll
                for (int j = 0; j < 4; ++j) { const int col = 4 * lane + 256 * j;
                    const f32x4 gp = *(const f32x4*)(R.gpre + col), sh = *(const f32x4*)(R.shift + who * NMODW + col), sc = *(const f32x4*)(R.scale + who * NMODW + col);
                    const f32x4 o = (v[rr][j] * rs * gp) * (sc + 1.0f) + sh;
                    u32x2 w; w.x = cvtpk(o[0], o[1]); w.y = cvtpk(o[2], o[3]);
                    *(u32x2*)(R.XN + (size_t)m * DM + col) = w; } }
        }
    }
}

__device__ __forceinline__ void phase_row(const RowPass& R, int wave, int lane, int bx, int G) {
    const int gw = bx * NWAVES + wave, NGW = G * NWAVES;
    row_range<4>(R, lane, gw, NGW, 0, (R.M < MX) ? R.M : MX);
    if (R.M > MX) row_range<2>(R, lane, NGW - 1 - gw, NGW, MX, R.M);
}

#define MFMA32(a, b, c) __builtin_amdgcn_mfma_f32_32x32x16_bf16((a), (b), (c), 0, 0, 0)
struct KFrag { bf16x8 k[4]; };
struct VFrag { bf16x8 v[4]; };
__device__ __forceinline__ void attn_loadk(KFrag& f, const bf16_t* kbase, int krow0) {
    const bf16_t* kp = kbase + (size_t)krow0 * 512;
#pragma unroll
    for (int dk = 0; dk < 4; ++dk) f.k[dk] = *(const bf16x8*)(kp + dk * 16);
}
__device__ __forceinline__ void attn_loadv(VFrag& f, const bf16_t* vbase, int krow0) {
    const bf16_t* vp = vbase + krow0;
    f.v[0] = *(const bf16x8*)(vp); f.v[1] = *(const bf16x8*)(vp + 16); f.v[2] = *(const bf16x8*)(vp + (size_t)32 * MT); f.v[3] = *(const bf16x8*)(vp + (size_t)32 * MT + 16);
}
__device__ __forceinline__ void attn_soft(f32x16& S, f32x16& o0, f32x16& o1, float& mrun, float& lrun, bool masked, const LAS float* bt, int relb, int idxb, bf16x8& pb0, bf16x8& pb1) {
    if (masked) {
        const LAS float* bp = bt + idxb;
        float bv[16];
#pragma unroll
        for (int r = 0; r < 16; ++r) bv[r] = bp[16 * (r >> 3) + (r & 7)];
#pragma unroll
        for (int r = 0; r < 16; ++r) {
            const int off = 16 * (r >> 3) + (r & 7);
            const bool valid = (unsigned)(relb + off) < 16u;
            S[r] = valid ? S[r] + bv[r] : -1e30f;
        }
    }
    float tm = S[0];
#pragma unroll
    for (int r = 1; r < 16; ++r) tm = fmaxf(tm, S[r]);
    tm = fmaxf(tm, __shfl_xor(tm, 32));
    if (__any(tm > mrun)) {
        const float mn = fmaxf(mrun, tm);
        const float fs = __builtin_amdgcn_exp2f(mrun - mn);
        mrun = mn; lrun *= fs;
#pragma unroll
        for (int r = 0; r < 16; ++r) { o0[r] *= fs; o1[r] *= fs; }
    }
    float ps = 0.f;
#pragma unroll
    for (int r = 0; r < 16; ++r) { S[r] = __builtin_amdgcn_exp2f(S[r] - mrun); ps += S[r]; }
    lrun += ps;
    u32x4 w0, w1;
    w0.x = cvtpk(S[0], S[1]); w0.y = cvtpk(S[2], S[3]); w0.z = cvtpk(S[4], S[5]); w0.w = cvtpk(S[6], S[7]);
    w1.x = cvtpk(S[8], S[9]); w1.y = cvtpk(S[10], S[11]); w1.z = cvtpk(S[12], S[13]); w1.w = cvtpk(S[14], S[15]);
    pb0 = __builtin_bit_cast(bf16x8, w0); pb1 = __builtin_bit_cast(bf16x8, w1);
}
struct AttnState { f32x16 o0, o1; float m, l; };
__device__ __forceinline__ void attn_comp2(KFrag& fk, const VFrag& f, const bf16x8 (&qa)[4], const bf16x8 (&qb)[4], AttnState& A, AttnState& B,
                                           bool masked, const LAS float* bt, int relA, int idxA, int relB, int idxB, const bf16_t* kbase, int nextrow) {
    f32x16 SA, SB;
#pragma unroll
    for (int r = 0; r < 16; ++r) { SA[r] = 0.f; SB[r] = 0.f; }
#pragma unroll
    for (int dk = 0; dk < 4; ++dk) { SA = MFMA32(fk.k[dk], qa[dk], SA); SB = MFMA32(fk.k[dk], qb[dk], SB); }
    if (nextrow >= 0) attn_loadk(fk, kbase, nextrow);
    bf16x8 p0, p1;
    attn_soft(SA, A.o0, A.o1, A.m, A.l, masked, bt, relA, idxA, p0, p1);
    A.o0 = MFMA32(f.v[0], p0, A.o0); A.o0 = MFMA32(f.v[1], p1, A.o0); A.o1 = MFMA32(f.v[2], p0, A.o1); A.o1 = MFMA32(f.v[3], p1, A.o1);
    attn_soft(SB, B.o0, B.o1, B.m, B.l, masked, bt, relB, idxB, p0, p1);
    B.o0 = MFMA32(f.v[0], p0, B.o0); B.o0 = MFMA32(f.v[1], p1, B.o0); B.o1 = MFMA32(f.v[2], p0, B.o1); B.o1 = MFMA32(f.v[3], p1, B.o1);
}
__device__ __forceinline__ void attn_store(const AttnState& A, bf16_t* op) {
    const float lt = A.l + __shfl_xor(A.l, 32);
    const float inv = 1.0f / lt;
#pragma unroll
    for (int g4 = 0; g4 < 4; ++g4) {
        u32x2 w; w.x = cvtpk(A.o0[4 * g4] * inv, A.o0[4 * g4 + 1] * inv); w.y = cvtpk(A.o0[4 * g4 + 2] * inv, A.o0[4 * g4 + 3] * inv); *(u32x2*)(op + 8 * g4) = w;
        u32x2 z; z.x = cvtpk(A.o1[4 * g4] * inv, A.o1[4 * g4 + 1] * inv); z.y = cvtpk(A.o1[4 * g4 + 2] * inv, A.o1[4 * g4 + 3] * inv); *(u32x2*)(op + 32 + 8 * g4) = z;
    }
}

__device__ __forceinline__ void phase_mix(KParams P, int layer, LAS unsigned char* lds, int tid, int wave, int lane, int bx, int G) {
    unsigned char* ws = P->ws;
    const bf16_t* Qb = (const bf16_t*)(ws + WS_Q); const bf16_t* Kb = (const bf16_t*)(ws + WS_K); const bf16_t* Ub = (const bf16_t*)(ws + WS_U);
    const bf16_t* Vt = (const bf16_t*)(ws + WS_VT); bf16_t* MIXb = (bf16_t*)(ws + WS_MIX);
    LAS float* bt = (LAS float*)(lds + wave * 2560) + 64;
    const int vb = (G % 8 == 0) ? (bx % 8) * (G / 8) + bx / 8 : bx;
    const int gw = vb * NWAVES + wave, NGW = G * NWAVES;
    const int q = lane & 31, hi = lane >> 5, pi = (q & 0x13) | ((q & 4) << 1) | ((q & 8) >> 1);
    const int nunits = 2048 + ((layer == 0) ? 64 : 0);
    for (int un = gw; un < nunits; un += NGW) {
        int b, h, qrow0, r = 0; const bool local = un < 2048;
        if (local) { r = un & 127; h = (un >> 7) & 7; b = un >> 10; qrow0 = b * SEQ + r * 64; }
        else { const int v = un - 2048; const int qb = v & 3; h = (v >> 2) & 7; b = v >> 5; qrow0 = MX + b * CTXL + qb * 64; }
        if (local) {
            const float* rp = P->rpb + (size_t)(layer * NH + h) * 465;
            for (int i = lane; i < 465; i += 64) bt[i] = rp[i] * LOG2E;
        }
        bf16x8 qa[4], qb4[4];
#pragma unroll
        for (int dk = 0; dk < 4; ++dk) { qa[dk] = *(const bf16x8*)(Qb + (size_t)(qrow0 + q) * 512 + h * 64 + dk * 16 + hi * 8);
                                         qb4[dk] = *(const bf16x8*)(Qb + (size_t)(qrow0 + 32 + q) * 512 + h * 64 + dk * 16 + hi * 8); }
        AttnState A, B;
#pragma unroll
        for (int i = 0; i < 16; ++i) { A.o0[i] = 0.f; A.o1[i] = 0.f; B.o0[i] = 0.f; B.o1[i] = 0.f; }
        A.m = -1e30f; A.l = 0.f; B.m = -1e30f; B.l = 0.f;
        const int crow0 = MX + b * CTXL;
        const int rs = min(max(r - 4, 0), 120);
        const int jA = q, jB = 32 + q, csA = min(max(jA - 8, 0), 48), csB = min(max(jB - 8, 0), 48);
        const int lrow0 = b * SEQ + rs * 64;
        const bf16_t* kbase = Kb + (size_t)pi * 512 + h * 64 + hi * 8;
        const bf16_t* vbase = Vt + (size_t)(h * 64 + q) * MT + hi * 8;
        const int ntiles = local ? 24 : 8;
#define TROW(t) (((t) < 8) ? crow0 + 32 * (t) : lrow0 + 32 * ((t) - 8))
#define TCOMP(FK, FV, t, NXT) do { const int t_ = (t); const int kr_ = (t_ - 8) >> 1, ct_ = (t_ - 8) & 1; const int br_ = (rs + kr_ - r + 7) * 31 + ct_ * 32 + 8 * hi + 15; \
            int ra_ = ct_ * 32 + 8 * hi - csA, rb_ = ct_ * 32 + 8 * hi - csB; asm volatile("" : "+v"(ra_), "+v"(rb_));     \
            attn_comp2(FK, FV, qa, qb4, A, B, t_ >= 8, bt, ra_, br_ - jA, rb_, br_ - jB, kbase, (NXT)); } while (0)
        KFrag k0; VFrag fv;
        attn_loadk(k0, kbase, TROW(0));
        asm volatile("s_waitcnt lgkmcnt(0)" ::: "memory");
        for (int t = 0; t < ntiles; ++t) {
            attn_loadv(fv, vbase, TROW(t));
            TCOMP(k0, fv, t, (t + 1 < ntiles) ? TROW(t + 1) : -1);
        }
#undef TROW
#undef TCOMP
        attn_store(A, MIXb + (size_t)(qrow0 + q) * 1024 + h * 64 + 4 * hi);
        attn_store(B, MIXb + (size_t)(qrow0 + 32 + q) * 1024 + h * 64 + 4 * hi);
        asm volatile("s_waitcnt lgkmcnt(0)" ::: "memory");
    }
    const int mrows = (layer == 0) ? MT : MX;
    const int nskip = (layer == 0) ? 64 : 0;
    if (gw < nskip) return;
    for (int wi = gw - nskip; wi < mrows; wi += NGW - nskip) {
        const int g = wi & 3, m = (wi & ~3) + (lane >> 4), ch = g * 16 + (lane & 15);
        int jj, len;
        if (m < MX) { jj = m & 63; len = 64; } else { jj = (m - MX) & 255; len = 256; }
        const int base = m - jj;
        float a[8];
#pragma unroll
        for (int e = 0; e < 8; ++e) a[e] = 0.f;
        const bf16_t* up = Ub + (size_t)base * 512 + ch * 8;
#define POOLW(W2) do { const int lo = max(jj - (W2), 0), hi2 = min(jj + (W2), len); u32x4 uv[2 * (W2)]; \
            _Pragma("unroll") for (int t = 0; t < 2 * (W2); ++t) uv[t] = *(const u32x4*)(up + (size_t)min(lo + t, hi2 - 1) * 512); \
            _Pragma("unroll") for (int t = 0; t < 2 * (W2); ++t) { const float wgt = (lo + t < hi2) ? 1.0f : 0.0f; \
                _Pragma("unroll") for (int e = 0; e < 4; ++e) { a[2 * e] += wgt * __uint_as_float(uv[t][e] << 16); a[2 * e + 1] += wgt * __uint_as_float(uv[t][e] & 0xffff0000u); } } \
            const float ic = 1.0f / (float)(hi2 - lo); _Pragma("unroll") for (int e = 0; e < 8; ++e) a[e] *= ic; } while (0)
        if (g == 0) POOLW(1); else if (g == 1) POOLW(2); else if (g == 2) POOLW(4); else POOLW(8);
#undef POOLW
        const u32x4 us = *(const u32x4*)(Ub + (size_t)m * 512 + ch * 8);
        u32x4 o;
#pragma unroll
        for (int e = 0; e < 4; ++e) o[e] = cvtpk(a[2 * e] - __uint_as_float(us[e] << 16), a[2 * e + 1] - __uint_as_float(us[e] & 0xffff0000u));
        *(u32x4*)(MIXb + (size_t)m * 1024 + 512 + ch * 8) = o;
    }
}

__device__ __forceinline__ void run_phase(KParams P, int ph, LAS unsigned char* lds, int tid, int wave, int lane, int bx, int G) {
    unsigned char* ws = P->ws;
    float* MOD = (float*)(ws + WS_MOD);
    bf16_t* XN = (bf16_t*)(ws + WS_XN); bf16_t* Yb = (bf16_t*)(ws + WS_Y); bf16_t* H = (bf16_t*)(ws + WS_H);
    float* CTXS = (float*)(ws + WS_CTXS);
    if (ph == 0) { phase_p0(P, lds, tid, wave, lane, bx, G); return; }
    const int l = (ph == NPHASE - 1) ? 2 : (ph - 1) / 10, s = (ph == NPHASE - 1) ? 0 : (ph - 1) % 10;
    const int Mlate = (l == 1) ? MX : MT;
    if (s == 0 || s == 3 || s == 7) {
        int yl = l, gidx = 5, gpi = 3, nl = l, npre = 4, nsh = 6, M = Mlate; bool hasY = true, hasXN = true, useIn = false; float coef = 1.0f;
        if (s == 0) { yl = (l > 0) ? l - 1 : 0; gidx = 8; gpi = 5; npre = 0; nsh = 0; M = MT; coef = 0.5f; hasY = (l > 0); useIn = (l == 0);
                      if (l == 2) { hasXN = false; M = MX; nl = 1; } }
        else if (s == 3) { gidx = 2; gpi = 1; npre = 2; nsh = 3; M = MT; coef = 0.5f; useIn = (l == 0); }
        RowPass R;
        R.srcX = P->x; R.srcXb = useIn ? (const bf16_t*)nullptr : (const bf16_t*)(ws + WS_XS); R.srcC = useIn ? P->ctx : (const float*)CTXS;
        R.dstX = P->out; R.dstXb = (l == 2) ? (bf16_t*)nullptr : (bf16_t*)(ws + WS_XS); R.dstC = CTXS;
        R.YP = (const float*)(ws + WS_YP); R.nparts = (s == 7) ? 4 : 11;
        R.Yb = Yb; R.XN = XN; R.hasY = hasY; R.hasXN = hasXN; R.M = M; R.coef = coef;
        R.gate = MOD + (size_t)yl * 3 * NMODW + gidx * DM; R.gpost = P->normg + (yl * 6 + gpi) * DM;
        R.gpre = P->normg + (nl * 6 + npre) * DM; R.shift = MOD + (size_t)nl * 3 * NMODW + nsh * DM; R.scale = R.shift + DM;
        phase_row(R, wave, lane, bx, G);
        return;
    }
    if (s == 5) { phase_mix(P, l, lds, tid, wave, lane, bx, G); return; }
    const bool split = (s == 2 || s == 9 || s == 6) && (Mlate == MT || s == 2);
    const int npass = (s == 4 || split) ? 2 : 1;
    for (int pass = 0; pass < npass; ++pass) {
        pg8::Gemm g; EpiAny E; E.ropeC = (const float*)(ws + WS_ROPEC); E.ropeS = (const float*)(ws + WS_ROPES); E.pstride = 0; E.ntp = 0; int cu = bx, pm0 = 0, ksplit = 1, ntp = 0;
        if (s == 1 || s == 8) {
            const int sub = (s == 1) ? 0 : 1; const int M = (s == 1) ? MT : Mlate;
            g = pg8::Gemm{XN, (const bf16_t*)(ws + WS_WGU) + (size_t)(l * 2 + sub) * 5632 * 1024, M, 5632, 1024, 1024};
            E.mode = EPI_SWIGLU; E.perm = true; E.O = H; E.ldc = DFF;
        } else if (s == 6 || s == 2 || s == 9) {
            const bf16_t* A; const bf16_t* Bt; int K;
            if (s == 6) { A = (const bf16_t*)(ws + WS_MIX); Bt = (const bf16_t*)(ws + WS_WOUT) + (size_t)l * 1024 * 1024; K = 1024; }
            else { const int sub = (s == 2) ? 0 : 1; A = H; Bt = (const bf16_t*)(ws + WS_WD) + (size_t)(l * 2 + sub) * 1024 * DFF; K = DFF; }
            E.mode = EPI_F32; E.perm = false; E.ldc = 1024;
            if (pass == 0) { g = pg8::Gemm{A, Bt, MX, 1024, K, K}; E.mode = EPI_BF16; E.perm = true; E.O = Yb; }
            else { ntp = 4; ksplit = K / 256; pm0 = MX / 256; g = pg8::Gemm{A, Bt, MC, 1024, 256, K};
                   E.O = (float*)(ws + WS_YP) - (size_t)MX * 1024; E.pstride = MC * 1024; E.ntp = 4; }
        } else {
            const bf16_t* Wt = (const bf16_t*)(ws + WS_WIN) + (size_t)l * INW * 1024;
            if (pass == 0) { g = pg8::Gemm{XN, Wt, MT, 1536, 1024, 1024}; E.mode = EPI_QKU; E.perm = false; E.O = ws + WS_Q; E.ldc = 512; }
            else { g = pg8::Gemm{Wt + (size_t)1536 * 1024, XN, 512, MT, 1024, 1024}; E.mode = EPI_BF16; E.perm = true; E.O = ws + WS_VT; E.ldc = MT; cu = G - 1 - bx; }
        }
        pg8::StaticOrder S; S.init(g.M, g.N, G, cu, pm0, ksplit, ntp);
        pg8::gemm_phase<EpiAny, pg8::StaticOrder, true, true>(lds, g, S, E);
    }
}

__global__ void __launch_bounds__(NTHREADS, 2) mega(Params P, int ph_lo, int ph_hi) {
    extern __shared__ __attribute__((aligned(16))) unsigned char lds_raw[];
    LAS unsigned char* lds = (LAS unsigned char*)lds_raw;
    cg::grid_group grid = cg::this_grid();
    volatile LAS unsigned* bst = (volatile LAS unsigned*)(lds + 131072 + 64);
    if (threadIdx.x < 2) bst[threadIdx.x] = 0u;
    __syncthreads();
    XcdBarrier bar;
    { KParams kp0 = (KParams)__builtin_amdgcn_kernarg_segment_ptr(); bar = xcd_barrier_post((unsigned*)(kp0->ws + WS_BAR), bst); }
    KParams kp = (KParams)__builtin_amdgcn_kernarg_segment_ptr();
#if defined(PROBE_REP_PH)
    const int nextra = PROBE_REPS - 1;
#else
    const int nextra = 0;
#endif
    const int nsteps = ph_hi - ph_lo + nextra;
    for (int step = 0; step < nsteps; ++step) {
        int ph = ph_lo + step;
#if defined(PROBE_REP_PH)
        if (ph > PROBE_REP_PH) ph = (ph <= PROBE_REP_PH + nextra) ? PROBE_REP_PH : ph - nextra;
#endif
        asm volatile("" : "+s"(kp));
        int tid = threadIdx.x; asm volatile("" : "+v"(tid));
        const int lane = tid & 63, wave = __builtin_amdgcn_readfirstlane(tid >> 6);
        int bx = blockIdx.x, G = gridDim.x; asm volatile("" : "+s"(bx), "+s"(G));
        run_phase(kp, ph, lds, tid, wave, lane, bx, G);
        if (step + 1 < nsteps) { if (ph_lo < 0) grid.sync(); else xcd_barrier(bar); }
    }
}

extern "C" void kernel_launch(void* const* d_in, const int* in_sizes, int n_in, void* d_out, int out_size, void* d_ws, size_t ws_size, hipStream_t stream) {
    static int grid = 0;
    if (grid == 0) {
        if (n_in != 14 || in_sizes[0] != MX * DM || out_size != MX * DM || ws_size < WS_END) {
            fprintf(stderr, "kernel_launch: unexpected shapes (n_in %d, in0 %d, out %d, ws %zu < %zu)\n", n_in, n_in > 0 ? in_sizes[0] : -1, out_size, ws_size, (size_t)WS_END); grid = -1; return; }
        int dev = 0, cus = 0, per_cu = 0;
        (void)hipGetDevice(&dev); (void)hipDeviceGetAttribute(&cus, hipDeviceAttributeMultiprocessorCount, dev);
        if (hipFuncSetAttribute((const void*)mega, hipFuncAttributeMaxDynamicSharedMemorySize, LDS_BYTES) != hipSuccess) { fprintf(stderr, "kernel_launch: hipFuncSetAttribute failed\n"); grid = -1; return; }
        if (hipOccupancyMaxActiveBlocksPerMultiprocessor(&per_cu, (const void*)mega, NTHREADS, LDS_BYTES) != hipSuccess || per_cu < 1) { fprintf(stderr, "kernel_launch: occupancy query gave %d\n", per_cu); per_cu = 1; }
        (void)hipGetLastError();
        grid = cus * 1;
        if (grid <= 0) grid = 256;
    }
    if (grid < 0) return;
    if (hipMemsetAsync((char*)d_ws + WS_BAR, 0, 65536, stream) != hipSuccess) { fprintf(stderr, "kernel_launch: memset failed\n"); return; }
    Params p{};
    p.x = (const float*)d_in[0]; p.c = (const float*)d_in[1]; p.ctx = (const float*)d_in[2]; p.cctx = (const float*)d_in[3];
    p.wmod = (const float*)d_in[4]; p.bmod = (const float*)d_in[5]; p.normg = (const float*)d_in[6]; p.wgu = (const float*)d_in[7];
    p.wd = (const float*)d_in[8]; p.win = (const float*)d_in[9]; p.wout = (const float*)d_in[10]; p.rpb = (const float*)d_in[11];
    p.wpool = (const float*)d_in[12]; p.pscale = (const float*)d_in[13];
    p.out = (float*)d_out; p.ws = (unsigned char*)d_ws;
#if MK_MULTI
    for (int ph = 0; ph < NPHASE; ++ph) {
        int lo = ph, hi = ph + 1; void* args[] = {&p, &lo, &hi};
        hipError_t e = hipLaunchCooperativeKernel((const void*)mega, dim3(grid), dim3(NTHREADS), args, LDS_BYTES, stream);
        if (e != hipSuccess) { fprintf(stderr, "launch %d failed: %s\n", ph, hipGetErrorString(e)); break; }
    }
#else
#ifndef MK_PH_HI
#define MK_PH_HI NPHASE
#endif
#ifndef MK_PH_LO
#define MK_PH_LO 0
#endif
    int lo = MK_PH_LO, hi = MK_PH_HI; void* args[] = {&p, &lo, &hi};
    hipError_t e = hipLaunchCooperativeKernel((const void*)mega, dim3(grid), dim3(NTHREADS), args, LDS_BYTES, stream);
    if (e != hipSuccess) fprintf(stderr, "cooperative launch failed: %s (grid %d)\n", hipGetErrorString(e), grid);
#endif
}
```

```cpp
#include <hip/hip_runtime.h>
#include <hip/hip_cooperative_groups.h>
#include <cstdio>
#include <cstdint>
namespace cg = cooperative_groups;
namespace pg8 {
#define PG8_LAS __attribute__((address_space(3)))
typedef unsigned short bf16_t;
typedef short bf16x8 __attribute__((ext_vector_type(8)));
typedef float f32x4 __attribute__((ext_vector_type(4)));
typedef unsigned u32x4 __attribute__((ext_vector_type(4)));
constexpr int BM = 256, BK = 64, HALF = 128, HTB = HALF * BK * 2  , STAGE_BYTES = 8 * HTB, NXCD = 8, WGM = 8;

__host__ __device__ __forceinline__ int lds_byte(int r, int c) { const int st = (r >> 4) * 2 + (c >> 5), rr = r & 15, cc = c & 31, ob = rr * 64 + cc * 2; return st * 1024 + (ob ^ (((ob >> 9) & 1) << 5)); }
__host__ __device__ __forceinline__ void stage_rc(int b, int& R, int& C) { const int st = b / 1024, sb = b % 1024, swz = sb ^ (((sb >> 9) & 1) << 5); R = (st >> 1) * 16 + swz / 64; C = (st & 1) * 32 + (swz % 64) / 2; }
__host__ __device__ __forceinline__ int perm32(int rho) { const int n = rho >> 4, i = rho & 15; return 8 * (i >> 2) + 4 * n + (i & 3); }

struct Unit { int pm, pn, kb; };
struct Gemm { const bf16_t* A; const bf16_t* Bt; int M, N, K, ld; };

struct StaticOrder {
    int nM, nN, nwg, G, c, pm0, ksplit, ntp;
    __host__ __device__ void init(int M, int N, int G_, int c_, int pm0_ = 0, int ksplit_ = 1, int ntp_ = 0) { nM = M / BM; nN = N / BM; nwg = nM * nN * ksplit_; G = G_; c = c_; pm0 = pm0_; ksplit = ksplit_; ntp = ntp_; }
    __host__ __device__ bool next(int i, Unit& u) const {
        const long L = (long)i * G + c; if (L >= nwg) return false;
        int wgid = (int)L; u.kb = (wgid % ksplit) * ntp; wgid /= ksplit; { const int nwg = nM * nN; const int q = nwg / NXCD, r = nwg % NXCD, xcd = wgid % NXCD, off = wgid / NXCD; wgid = (xcd < r ? xcd * (q + 1) : r * (q + 1) + (xcd - r) * q) + off; }
        const int nig = WGM * nN, gid = wgid / nig, fm = gid * WGM, gsz = (nM - fm) < WGM ? (nM - fm) : WGM;
        u.pm = pm0 + fm + ((wgid % nig) % gsz); u.pn = (wgid % nig) / gsz; return true;
    }
    __device__ __forceinline__ void a_ready(const Unit&) const {}
    __device__ __forceinline__ void done(const Unit&) const {}
};

__device__ __forceinline__ unsigned cvt_pk_bf16(float lo, float hi) { unsigned r; asm volatile("v_cvt_pk_bf16_f32 %0, %1, %2" : "=v"(r) : "v"(lo), "v"(hi)); return r; }
typedef float f32x2 __attribute__((ext_vector_type(2)));
template <class Epi, class Sched, bool ALIGN_EPI = false, bool SP2 = false>
__device__ __forceinline__ void gemm_phase(PG8_LAS unsigned char* lds, const Gemm g, const Sched& S, const Epi& E) {
    int tid_raw = threadIdx.x; asm volatile("" : "+v"(tid_raw));
    const int tid = tid_raw, wid = __builtin_amdgcn_readfirstlane(tid >> 6), lane = tid & 63, wr = wid >> 2, wc = wid & 3, fr = lane & 15, fq = lane >> 4;
    const int K = g.ld, nt = g.K / BK;
    unsigned voffA[2], voffB[2];
#pragma unroll
    for (int i = 0; i < 2; ++i) { int R, C; stage_rc(tid * 16 + i * 8192, R, C); const int Rb = E.perm ? ((R & ~31) + perm32(R & 31)) : R;
        voffA[i] = (unsigned)(R * K + C) * 2u; voffB[i] = (unsigned)(Rb * K + C) * 2u; }
    const size_t kstep = (size_t)(BK * 2);
    const size_t hstep = (size_t)HALF * K * 2;
    const size_t tstep = 2 * hstep;
    const unsigned ldsw = (unsigned)wid * 1024u;
    const int aoff = lds_byte(wr * 64 + fr, fq * 8), boff = lds_byte(wc * 32 + fr, fq * 8);
#define PG8_SA(b, h) (((b) * 2 + (h)) * HTB)
#define PG8_SB(b, h) ((4 + (b) * 2 + (h)) * HTB)
#define PG8_STAGE(bufoff, gbase, voff) do { _Pragma("unroll") for (int _i = 0; _i < 2; ++_i) \
        __builtin_amdgcn_global_load_lds((const unsigned*)((const char*)(gbase) + (voff)[_i]), (PG8_LAS unsigned*)(lds + (bufoff) + ldsw + _i * 8192), 16, 0, 0); } while (0)
#define PG8_LDA(dst, b, h) do { _Pragma("unroll") for (int m = 0; m < 4; ++m) _Pragma("unroll") for (int k = 0; k < 2; ++k) dst[m][k] = *(const PG8_LAS bf16x8*)(lds + PG8_SA(b, h) + aoff + m * 2048 + k * 1024); } while (0)
#define PG8_LDB(dst, b, h) do { _Pragma("unroll") for (int n = 0; n < 2; ++n) _Pragma("unroll") for (int k = 0; k < 2; ++k) dst[n][k] = *(const PG8_LAS bf16x8*)(lds + PG8_SB(b, h) + boff + n * 2048 + k * 1024); } while (0)
#define PG8_MMA(ai, bj, At, Bt) do { __builtin_amdgcn_s_setprio(1); _Pragma("unroll") for (int m = 0; m < 4; ++m) _Pragma("unroll") for (int n = 0; n < 2; ++n) _Pragma("unroll") for (int k = 0; k < 2; ++k) \
        acc[ai][bj][m][n] = __builtin_amdgcn_mfma_f32_16x16x32_bf16(Bt[n][k], At[m][k], acc[ai][bj][m][n], 0, 0, 0); __builtin_amdgcn_s_setprio(0); } while (0)
#define PG8_WAIT_V(n) asm volatile("s_waitcnt vmcnt(" #n ")" ::: "memory")
#define PG8_WAIT_L(n) asm volatile("s_waitcnt lgkmcnt(" #n ")" ::: "memory")
#define PG8_BAR __builtin_amdgcn_s_barrier()
#define PG8_SCHED __builtin_amdgcn_sched_barrier(0)
    Unit cur, nxt; int ui = 0;
    if (!S.next(0, cur)) return;
    f32x4 acc[2][2][4][2];
#pragma unroll
    for (int a = 0; a < 2; ++a)
#pragma unroll
        for (int b = 0; b < 2; ++b)
#pragma unroll
            for (int m = 0; m < 4; ++m)
#pragma unroll
                for (int n = 0; n < 2; ++n) acc[a][b][m][n] = (f32x4){0.f, 0.f, 0.f, 0.f};
    bf16x8 At[4][2], B0[2][2], B1[2][2];
    const char* cA = (const char*)g.A + (size_t)cur.pm * tstep + (size_t)cur.kb * (BK * 2); const char* cB = (const char*)g.Bt + (size_t)cur.pn * tstep + (size_t)cur.kb * (BK * 2);
    S.a_ready(cur);
    if constexpr (SP2) {
        PG8_STAGE(PG8_SB(0, 0), cB, voffB); PG8_STAGE(PG8_SB(0, 1), cB + hstep, voffB); PG8_STAGE(PG8_SA(0, 0), cA, voffA); PG8_STAGE(PG8_SA(0, 1), cA + hstep, voffA);
        if (wr == 1) PG8_BAR;
        PG8_WAIT_V(2); PG8_BAR;
        PG8_STAGE(PG8_SB(1, 0), cB + kstep, voffB); PG8_STAGE(PG8_SA(1, 0), cA + kstep, voffA); PG8_STAGE(PG8_SB(1, 1), cB + hstep + kstep, voffB);
        PG8_WAIT_V(6); PG8_BAR;
    } else {
        PG8_STAGE(PG8_SB(0, 0), cB, voffB); PG8_STAGE(PG8_SA(0, 0), cA, voffA); PG8_STAGE(PG8_SB(0, 1), cB + hstep, voffB); PG8_STAGE(PG8_SA(0, 1), cA + hstep, voffA);
        if (wr == 1) PG8_BAR;
        PG8_WAIT_V(4); PG8_BAR;
        PG8_STAGE(PG8_SB(1, 0), cB + kstep, voffB); PG8_STAGE(PG8_SA(1, 0), cA + kstep, voffA); PG8_STAGE(PG8_SB(1, 1), cB + hstep + kstep, voffB);
        PG8_WAIT_V(6); PG8_BAR;
    }
    for (;;) {
        const bool has_next = S.next(ui + 1, nxt);
        const char* nA = has_next ? (const char*)g.A + (size_t)nxt.pm * tstep + (size_t)nxt.kb * (BK * 2) : cA; const char* nB = has_next ? (const char*)g.Bt + (size_t)nxt.pn * tstep + (size_t)nxt.kb * (BK * 2) : cB;
        for (int t = 0; t < nt; t += 2) {
            const bool last = (t == nt - 2);
            const char* a1 = cA + (size_t)(t + 1) * kstep;
            const char* a2 = last ? nA : cA + (size_t)(t + 2) * kstep; const char* b2 = last ? nB : cB + (size_t)(t + 2) * kstep;
            const char* a3 = a2 + kstep; const char* b3 = b2 + kstep;
            if (last && has_next) S.a_ready(nxt);
            if constexpr (SP2) {
            PG8_LDB(B0, 0, 0); PG8_LDB(B1, 0, 1); PG8_SCHED; PG8_LDA(At, 0, 0); PG8_STAGE(PG8_SA(1, 1), a1 + hstep, voffA);
            PG8_WAIT_V(8); PG8_WAIT_L(0); PG8_BAR; PG8_MMA(0, 0, At, B0); PG8_MMA(0, 1, At, B1); PG8_BAR; PG8_SCHED;
            PG8_LDA(At, 0, 1); PG8_STAGE(PG8_SB(0, 0), b2, voffB); PG8_STAGE(PG8_SB(0, 1), b2 + hstep, voffB); PG8_STAGE(PG8_SA(0, 0), a2, voffA);
            PG8_WAIT_V(8); PG8_WAIT_L(0); PG8_BAR; PG8_MMA(1, 0, At, B0); PG8_MMA(1, 1, At, B1); PG8_BAR; PG8_SCHED;
            PG8_LDB(B0, 1, 0); PG8_LDB(B1, 1, 1); PG8_SCHED; PG8_LDA(At, 1, 0); PG8_STAGE(PG8_SA(0, 1), a2 + hstep, voffA);
            PG8_WAIT_V(8); PG8_WAIT_L(0); PG8_BAR; PG8_MMA(0, 0, At, B0); PG8_MMA(0, 1, At, B1); PG8_BAR; PG8_SCHED;
            PG8_LDA(At, 1, 1); PG8_STAGE(PG8_SB(1, 0), b3, voffB); PG8_STAGE(PG8_SB(1, 1), b3 + hstep, voffB); PG8_STAGE(PG8_SA(1, 0), a3, voffA);
            PG8_WAIT_V(8); PG8_WAIT_L(0); PG8_BAR; PG8_MMA(1, 0, At, B0); PG8_MMA(1, 1, At, B1); PG8_BAR; PG8_SCHED;
            } else {
            PG8_LDB(B0, 0, 0); PG8_SCHED; PG8_LDA(At, 0, 0); PG8_STAGE(PG8_SA(1, 1), a1 + hstep, voffA);
            PG8_WAIT_L(8); PG8_BAR; PG8_WAIT_L(0); PG8_MMA(0, 0, At, B0); PG8_BAR; PG8_SCHED;
            PG8_LDB(B1, 0, 1); PG8_STAGE(PG8_SB(0, 0), b2, voffB);
            PG8_BAR; PG8_WAIT_L(0); PG8_MMA(0, 1, At, B1); PG8_BAR;
            PG8_LDA(At, 0, 1); PG8_STAGE(PG8_SA(0, 0), a2, voffA);
            PG8_BAR; PG8_WAIT_L(0); PG8_MMA(1, 0, At, B0); PG8_BAR; PG8_SCHED;
            PG8_STAGE(PG8_SB(0, 1), b2 + hstep, voffB);
            PG8_WAIT_V(6); PG8_BAR; PG8_MMA(1, 1, At, B1); PG8_BAR;
            PG8_LDB(B0, 1, 0); PG8_SCHED; PG8_LDA(At, 1, 0); PG8_STAGE(PG8_SA(0, 1), a2 + hstep, voffA);
            PG8_WAIT_L(8); PG8_BAR; PG8_WAIT_L(0); PG8_MMA(0, 0, At, B0); PG8_BAR; PG8_SCHED;
            PG8_LDB(B1, 1, 1); PG8_STAGE(PG8_SB(1, 0), b3, voffB);
            PG8_BAR; PG8_WAIT_L(0); PG8_MMA(0, 1, At, B1); PG8_BAR;
            PG8_LDA(At, 1, 1); PG8_STAGE(PG8_SA(1, 0), a3, voffA);
            PG8_BAR; PG8_WAIT_L(0); PG8_MMA(1, 0, At, B0); PG8_BAR; PG8_SCHED;
            PG8_STAGE(PG8_SB(1, 1), b3 + hstep, voffB);
            PG8_WAIT_V(6); PG8_BAR; PG8_MMA(1, 1, At, B1); PG8_BAR;
            }
        }
        if constexpr (ALIGN_EPI) { if (wr == 0) PG8_BAR; }
        if constexpr (!Epi::AFTER_DRAIN) { E(acc, cur, wr, wc, fr, fq); S.done(cur); }
        if (!has_next) break;
#pragma unroll
        for (int a = 0; a < 2; ++a)
#pragma unroll
            for (int b = 0; b < 2; ++b)
#pragma unroll
                for (int m = 0; m < 4; ++m)
#pragma unroll
                    for (int n = 0; n < 2; ++n) acc[a][b][m][n] = (f32x4){0.f, 0.f, 0.f, 0.f};
        cur = nxt; cA = nA; cB = nB; ++ui;
        if constexpr (ALIGN_EPI) { if (wr == 1) PG8_BAR; }
    }
    PG8_WAIT_V(0);
    if constexpr (!ALIGN_EPI) { if (wr == 0) PG8_BAR; }
    PG8_BAR;
    if constexpr (Epi::AFTER_DRAIN) { E.fused(acc, cur, wr, wc, fr, fq, lds, wid, lane); S.done(cur); }
#undef PG8_SA
#undef PG8_SB
#undef PG8_STAGE
#undef PG8_LDA
#undef PG8_LDB
#undef PG8_MMA
#undef PG8_WAIT_V
#undef PG8_WAIT_L
#undef PG8_BAR
#undef PG8_SCHED
}
}

#ifndef MK_MULTI
#define MK_MULTI 0
#endif
typedef unsigned short bf16_t;
typedef short bf16x8 __attribute__((ext_vector_type(8)));
typedef float f32x4 __attribute__((ext_vector_type(4)));
typedef float f32x16 __attribute__((ext_vector_type(16)));
typedef unsigned u32x4 __attribute__((ext_vector_type(4)));
typedef unsigned u32x2 __attribute__((ext_vector_type(2)));
typedef float f32x2_t __attribute__((ext_vector_type(2)));
typedef __bf16 bf16x2_t __attribute__((ext_vector_type(2)));
#define LAS __attribute__((address_space(3)))

constexpr int DM = 1024, SEQ = 8192, NB = 2, CTXL = 256, MX = NB * SEQ, MC = NB * CTXL, MT = MX + MC;
constexpr int DFF = 2816, NH = 8, HD = 64, INW = 2048, NMODW = 9 * DM;
constexpr float RMS_EPS = 1e-6f;
constexpr float LOG2E = 1.4426950408889634f;
constexpr float QSCALE = 0.125f * LOG2E;
constexpr int NPHASE = 22;
constexpr int NTHREADS = 512, NWAVES = 8;
constexpr int LDS_BYTES = 147456;

constexpr size_t MiB = 1u << 20;
constexpr size_t WS_MOD = 0;
constexpr size_t WS_ROPEC = 256 * 1024;
constexpr size_t WS_ROPES = 256 * 1024 + 8192;
constexpr size_t WS_BAR = 3 * MiB;
constexpr size_t WS_CTXS = 512 * 1024;
constexpr size_t WS_WGU = 4 * MiB;
constexpr size_t WS_WD = 48 * MiB;
constexpr size_t WS_WIN = 70 * MiB;
constexpr size_t WS_WOUT = 78 * MiB;
constexpr size_t WS_XN = 82 * MiB;
constexpr size_t WS_Y = 115 * MiB;
constexpr size_t WS_XS = 147 * MiB;
constexpr size_t WS_H = 211 * MiB;
constexpr size_t SZ_QK = (size_t)MT * 512 * 2;
constexpr size_t WS_Q = WS_H, WS_K = WS_Q + SZ_QK, WS_U = WS_K + SZ_QK, WS_VT = WS_U + SZ_QK, WS_MIX = WS_VT + SZ_QK;
constexpr size_t WS_YP = WS_MIX + (size_t)MT * 1024 * 2;
constexpr size_t WS_END = WS_YP + (size_t)11 * MC * 1024 * 4;
static_assert(WS_XN + (size_t)MT * 1024 * 2 <= WS_Y && WS_Y + (size_t)MX * 1024 * 2 <= WS_XS && WS_XS + (size_t)MX * 1024 * 4 <= WS_H && WS_H + (size_t)MT * DFF * 2 <= WS_YP, "ws map");

struct Params {
    const float *x, *c, *ctx, *cctx, *wmod, *bmod, *normg, *wgu, *wd, *win, *wout, *rpb, *wpool, *pscale;
    float* out; unsigned char* ws;
};
typedef const __attribute__((address_space(4))) Params* KParams;

__device__ __forceinline__ unsigned cvtpk(float lo, float hi) { f32x2_t v = {lo, hi}; bf16x2_t b = __builtin_convertvector(v, bf16x2_t); return __builtin_bit_cast(unsigned, b); }
__device__ __forceinline__ float bf2f(unsigned short h) { return __uint_as_float(((unsigned)h) << 16); }
__device__ __forceinline__ float wave_sum(float v) {
#pragma unroll
    for (int o = 1; o < 64; o <<= 1) v += __shfl_xor(v, o);
    return v;
}

#define XB_TMO      128
#define XB_XCNT(j)  (256  + 64 * (j))
#define XB_XSUB(j)  (1280 + 64 * (j))
#define XB_XGEN(j)  (2304 + 64 * (j))
#define XB_TOP      3328
#define XB_TOPGEN   3392
#define XCD_BAR_WORDS 3456
#define XB_SPIN_CAP (1u << 18)

__device__ __forceinline__ unsigned xb_ld(unsigned* p)              { return __hip_atomic_load(p, __ATOMIC_RELAXED, __HIP_MEMORY_SCOPE_AGENT); }
__device__ __forceinline__ unsigned xb_add(unsigned* p, unsigned v) { return __hip_atomic_fetch_add(p, v, __ATOMIC_RELAXED, __HIP_MEMORY_SCOPE_AGENT); }
__device__ __forceinline__ unsigned xb_xcc_id() { return (unsigned)__builtin_amdgcn_s_getreg((3 << 11) | 20) & 0xFu; }
#define XB_SPIN(cond, bar) do { unsigned _sp = 0; while (cond) { __builtin_amdgcn_s_sleep(1); \
    if ((++_sp & 255u) == 0u) { if (xb_ld(&(bar)[XB_TMO])) break; if (_sp > XB_SPIN_CAP) { atomicAdd(&(bar)[XB_TMO], 1u); break; } } } } while (0)

struct XcdBarrier {
    unsigned* bar; unsigned x;
    volatile LAS unsigned* st;
};

__device__ __forceinline__ XcdBarrier xcd_barrier_post(unsigned* bar, volatile LAS unsigned* st) {
    XcdBarrier b; b.bar = bar; b.x = xb_xcc_id(); b.st = st;
    if (threadIdx.x == 0) (void)xb_add(&bar[XB_XCNT(b.x)], 1u);
    return b;
}
__device__ __forceinline__ void xcd_barrier_complete(unsigned* bar, unsigned x, unsigned& nloc, unsigned& nx) {
    const unsigned G = gridDim.x * gridDim.y * gridDim.z;
    unsigned sum, cnt, mine, sp = 0u;
    for (;;) {
        sum = 0u; cnt = 0u; mine = 0u;
#pragma unroll
        for (unsigned j = 0; j < 16; ++j) { const unsigned c = xb_ld(&bar[XB_XCNT(j)]); sum += c; cnt += (c > 0u) ? 1u : 0u; mine = (j == x) ? c : mine; }
        if (sum == G) break;
        __builtin_amdgcn_s_sleep(1);
        if ((++sp & 255u) == 0u) { if (xb_ld(&bar[XB_TMO])) break; if (sp > XB_SPIN_CAP) { atomicAdd(&bar[XB_TMO], 1u); break; } }
    }
    nloc = mine > 0u ? mine : 1u; nx = cnt > 0u ? cnt : 1u;
}

__device__ __forceinline__ void xcd_barrier(const XcdBarrier& b) {
    asm volatile("s_waitcnt vmcnt(0)" ::: "memory");
    __syncthreads();
    if (threadIdx.x == 0) {
        unsigned* bar = b.bar;
        __builtin_amdgcn_s_waitcnt(0);
        unsigned nloc = b.st[0], nx = b.st[1];
        if (nloc == 0u) { xcd_barrier_complete(bar, b.x, nloc, nx); b.st[0] = nloc; b.st[1] = nx; }
        const unsigned old = xb_add(&bar[XB_XSUB(b.x)], 1u);
        const unsigned gen = old / nloc;
        if (old + 1u == (gen + 1u) * nloc) {
            __builtin_amdgcn_fence(__ATOMIC_RELEASE, "agent");
            asm volatile("s_waitcnt vmcnt(0)" ::: "memory");
            const unsigned og = xb_add(&bar[XB_TOP], 1u);
            const unsigned tg = og / nx;
            if (og + 1u == (tg + 1u) * nx) xb_add(&bar[XB_TOPGEN], 1u);
            else XB_SPIN(xb_ld(&bar[XB_TOPGEN]) == tg, bar);
            __builtin_amdgcn_fence(__ATOMIC_ACQUIRE, "agent");
            xb_add(&bar[XB_XGEN(b.x)], 1u);
            asm volatile("s_waitcnt vmcnt(0)" ::: "memory");
        } else {
            XB_SPIN(xb_ld(&bar[XB_XGEN(b.x)]) == gen, bar);
            __builtin_amdgcn_fence(__ATOMIC_ACQUIRE, "agent");
            asm volatile("s_waitcnt vmcnt(0)" ::: "memory");
        }
    }
    __syncthreads();
}

using pg8::Unit;
enum { EPI_SWIGLU = 0, EPI_F32 = 1, EPI_QKU = 2, EPI_BF16 = 3 };
struct EpiAny {
    static constexpr bool AFTER_DRAIN = false;
    int mode; bool perm; void* O; int ldc; const float *ropeC, *ropeS; int pstride, ntp;
    __device__ __forceinline__ static float sw(float g, float u) { return g * u * __builtin_amdgcn_rcpf(1.0f + __builtin_amdgcn_exp2f(-g * LOG2E)); }
    __device__ __forceinline__ void operator()(const f32x4 (&acc)[2][2][4][2], const Unit& u, int wr, int wc, int fr, int fq) const {
        if (mode == EPI_SWIGLU) {
            bf16_t* H = (bf16_t*)O;
            const int row0 = u.pm * 256 + wr * 64 + fr, col0 = u.pn * 128 + wc * 32 + 8 * fq;
#pragma unroll
            for (int ai = 0; ai < 2; ++ai)
#pragma unroll
                for (int m = 0; m < 4; ++m) {
                    bf16_t* p = H + (size_t)(row0 + ai * 128 + m * 16) * DFF + col0;
                    const f32x4 g0 = acc[ai][0][m][0], g1 = acc[ai][0][m][1], u0 = acc[ai][1][m][0], u1 = acc[ai][1][m][1];
                    f32x4 e0 = g0 * (-LOG2E), e1 = g1 * (-LOG2E);
#pragma unroll
                    for (int i = 0; i < 4; ++i) { e0[i] = __builtin_amdgcn_exp2f(e0[i]); e1[i] = __builtin_amdgcn_exp2f(e1[i]); }
                    e0 = e0 + 1.0f; e1 = e1 + 1.0f;
#pragma unroll
                    for (int i = 0; i < 4; ++i) { e0[i] = __builtin_amdgcn_rcpf(e0[i]); e1[i] = __builtin_amdgcn_rcpf(e1[i]); }
                    const f32x4 o0 = (g0 * u0) * e0, o1 = (g1 * u1) * e1;
                    u32x4 w; w.x = cvtpk(o0[0], o0[1]); w.y = cvtpk(o0[2], o0[3]); w.z = cvtpk(o1[0], o1[1]); w.w = cvtpk(o1[2], o1[3]);
                    *(u32x4*)p = w;
                }
        } else if (mode == EPI_F32) {
            float* Y = (float*)O + ((ntp > 0) ? (size_t)(u.kb / ntp) * (size_t)pstride : (size_t)0);
            const int row0 = u.pm * 256 + wr * 64 + fr, col0 = u.pn * 256 + wc * 32 + 4 * fq;
#pragma unroll
            for (int ai = 0; ai < 2; ++ai)
#pragma unroll
                for (int m = 0; m < 4; ++m) {
                    float* p = Y + (size_t)(row0 + ai * 128 + m * 16) * ldc + col0;
#pragma unroll
                    for (int bj = 0; bj < 2; ++bj)
#pragma unroll
                        for (int n = 0; n < 2; ++n) *(f32x4*)(p + bj * 128 + n * 16) = acc[ai][bj][m][n];
                }
        } else if (mode == EPI_QKU) {
            const int t = u.pn >> 1; bf16_t* base = (bf16_t*)O + (size_t)t * ((size_t)MT * 512);
            const float sc = (t == 0) ? QSCALE : 1.0f;
            const bool rope = (t < 2) && (u.pm < MX / 256);
            const int cb = (u.pn & 1) * 256 + wc * 32 + 4 * fq;
#pragma unroll
            for (int ai = 0; ai < 2; ++ai)
#pragma unroll
                for (int m = 0; m < 4; ++m) {
                    const int row = u.pm * 256 + ai * 128 + wr * 64 + m * 16 + fr;
                    bf16_t* p = base + (size_t)row * 512 + cb;
                    f32x4 c4 = {1.f, 1.f, 1.f, 1.f}, s4 = {0.f, 0.f, 0.f, 0.f};
                    if (rope) { const int s = row & (SEQ - 1); const int pos = (wc & 1) ? (s & 63) : (s >> 6);
                        c4 = *(const f32x4*)(ropeC + pos * 16 + 4 * fq); s4 = *(const f32x4*)(ropeS + pos * 16 + 4 * fq); }
#pragma unroll
                    for (int bj = 0; bj < 2; ++bj) {
                        const f32x4 x1 = acc[ai][bj][m][0], x2 = acc[ai][bj][m][1];
                        const f32x4 o1 = (x1 * c4 - x2 * s4) * sc, o2 = (x2 * c4 + x1 * s4) * sc;
                        u32x2 w1, w2; w1.x = cvtpk(o1[0], o1[1]); w1.y = cvtpk(o1[2], o1[3]); w2.x = cvtpk(o2[0], o2[1]); w2.y = cvtpk(o2[2], o2[3]);
                        *(u32x2*)(p + bj * 128) = w1; *(u32x2*)(p + bj * 128 + 16) = w2;
                    }
                }
        } else {
            bf16_t* Ob = (bf16_t*)O;
            const int row0 = u.pm * 256 + wr * 64 + fr, col0 = u.pn * 256 + wc * 32 + 8 * fq;
#pragma unroll
            for (int ai = 0; ai < 2; ++ai)
#pragma unroll
                for (int m = 0; m < 4; ++m) {
                    bf16_t* p = Ob + (size_t)(row0 + ai * 128 + m * 16) * ldc + col0;
#pragma unroll
                    for (int bj = 0; bj < 2; ++bj) { const f32x4 v0 = acc[ai][bj][m][0], v1 = acc[ai][bj][m][1];
                        u32x4 w; w.x = cvtpk(v0[0], v0[1]); w.y = cvtpk(v0[2], v0[3]); w.z = cvtpk(v1[0], v1[1]); w.w = cvtpk(v1[2], v1[3]);
                        *(u32x4*)(p + bj * 128) = w; }
                }
        }
    }
};

__device__ __forceinline__ void p0_transpose_item(const float* W, int ldw, int k0, int n0, bf16_t* WT, int ldt, int dst_row0, LAS unsigned char* scr, int lane) {
    f32x4 v[16];
    const float* src = W + (size_t)(k0 + (lane >> 4)) * ldw + n0 + 4 * (lane & 15);
#pragma unroll
    for (int i = 0; i < 16; ++i) v[i] = __builtin_nontemporal_load((const f32x4*)(src + (size_t)(4 * i) * ldw));
#pragma unroll
    for (int i = 0; i < 16; ++i) { LAS unsigned* p = (LAS unsigned*)(scr + (4 * i + (lane >> 4)) * 132 + 8 * (lane & 15)); p[0] = cvtpk(v[i][0], v[i][1]); p[1] = cvtpk(v[i][2], v[i][3]); }
    asm volatile("s_waitcnt lgkmcnt(0)" ::: "memory");
    const int c = lane & 7;
#pragma unroll
    for (int j = 0; j < 4; ++j) { const int np = (lane >> 3) + 8 * j; unsigned w[8];
#pragma unroll
        for (int i = 0; i < 8; ++i) w[i] = *(const LAS unsigned*)(scr + (8 * c + i) * 132 + 4 * np);
        u32x4 lo, hi;
        lo.x = (w[0] & 0xffffu) | (w[1] << 16); lo.y = (w[2] & 0xffffu) | (w[3] << 16); lo.z = (w[4] & 0xffffu) | (w[5] << 16); lo.w = (w[6] & 0xffffu) | (w[7] << 16);
        hi.x = (w[0] >> 16) | (w[1] & 0xffff0000u); hi.y = (w[2] >> 16) | (w[3] & 0xffff0000u); hi.z = (w[4] >> 16) | (w[5] & 0xffff0000u); hi.w = (w[6] >> 16) | (w[7] & 0xffff0000u);
        *(u32x4*)(WT + (size_t)(dst_row0 + 2 * np) * ldt + k0 + 8 * c) = lo;
        *(u32x4*)(WT + (size_t)(dst_row0 + 2 * np + 1) * ldt + k0 + 8 * c) = hi; }
    asm volatile("s_waitcnt lgkmcnt(0)" ::: "memory");
}

__device__ __forceinline__ void phase_p0(KParams P, LAS unsigned char* lds, int tid, int wave, int lane, int bx, int G) {
    unsigned char* ws = P->ws;
    float* MOD = (float*)(ws + WS_MOD);
    const int gt = bx * NTHREADS + tid;
    if (gt < 2048) {
        const int pos = gt >> 4, i = gt & 15;
        const float inv = exp2f(-(float)i * 0.83048202372184058696f);
        const float angf = (float)pos * inv;
        const double a = (double)angf; const double kq = rint(a * 0.63661977236758134308); const double r = a - kq * 1.57079632679489661923; const double r2 = r * r;
        double sr = r, cr = 1.0, ts = r, tc = 1.0;
#pragma unroll 1
        for (int k = 1; k <= 8; ++k) { const double k2 = (double)(2 * k); tc *= -r2 / (k2 * (k2 - 1.0)); ts *= -r2 / (k2 * (k2 + 1.0)); cr += tc; sr += ts; }
        const int q = ((int)kq) & 3;
        const double cv = (q == 0) ? cr : (q == 1) ? -sr : (q == 2) ? -cr : sr;
        const double sv = (q == 0) ? sr : (q == 1) ? cr : (q == 2) ? -sr : -cr;
        ((float*)(ws + WS_ROPEC))[gt] = (float)cv; ((float*)(ws + WS_ROPES))[gt] = (float)sv;
    }
    constexpr int J_MOD = 72, J_FOLD = 128, J_TR = 1216, NJOBS = J_MOD + J_FOLD + J_TR;
    unsigned* jq = (unsigned*)(ws + WS_BAR + 32768);
    LAS int* jb = (LAS int*)(lds + 131072 + 128);
    for (;;) {
        if (tid == 0) *jb = (int)__hip_atomic_fetch_add(jq, 1u, __ATOMIC_RELAXED, __HIP_MEMORY_SCOPE_AGENT);
        __syncthreads();
        const int job = *jb;
        __syncthreads();
        if (job >= NJOBS) break;
        if (job < J_MOD) {
            LAS float* sc = (LAS float*)lds;
            LAS float* red = sc + 3072;
            for (int i = tid; i < 3072; i += NTHREADS) { const int who = i >> 10, k = i & 1023; const float v = (who < 2) ? P->c[who * 1024 + k] : P->cctx[k]; sc[i] = v / (1.0f + __expf(-v)); }
            __syncthreads();
            const int l = job / 36, cc = job % 36, col = cc * 256 + 4 * lane;
            const float* W = P->wmod + ((size_t)l * 1024 + wave * 128) * NMODW + col;
            f32x4 a0 = {0.f, 0.f, 0.f, 0.f}, a1 = a0, a2 = a0;
#pragma unroll 16
            for (int k = 0; k < 128; ++k) { const f32x4 w = __builtin_nontemporal_load((const f32x4*)(W + (size_t)k * NMODW)); const int kk = wave * 128 + k; a0 += w * sc[kk]; a1 += w * sc[1024 + kk]; a2 += w * sc[2048 + kk]; }
            *(LAS f32x4*)(red + (wave * 3 + 0) * 256 + 4 * lane) = a0; *(LAS f32x4*)(red + (wave * 3 + 1) * 256 + 4 * lane) = a1; *(LAS f32x4*)(red + (wave * 3 + 2) * 256 + 4 * lane) = a2;
            __syncthreads();
            for (int o = tid; o < 768; o += NTHREADS) { const int who = o >> 8, cl = o & 255; float s = 0.f;
#pragma unroll
                for (int w = 0; w < 8; ++w) s += red[(w * 3 + who) * 256 + cl];
                MOD[(size_t)(l * 3 + who) * NMODW + cc * 256 + cl] = s + P->bmod[l * NMODW + cc * 256 + cl]; }
            __syncthreads();
        } else if (job < J_MOD + J_FOLD) {
            const int r = job - J_MOD, nb = r & 15, g = (r >> 4) & 3, l = r >> 6;
            LAS float* A = (LAS float*)lds;
            LAS float* B = (LAS float*)(lds + 128 * 132 * 4);
            LAS bf16_t* OT = (LAS bf16_t*)(lds + 128 * 132 * 4 + 128 * 64 * 4);
            const float* wp = P->wpool + (size_t)(l * 4 + g) * 128 * 128; const float* ps = P->pscale + l * 512 + g * 128;
            const float* wo = P->wout + ((size_t)l * 1024 + 512 + g * 128) * 1024 + nb * 64;
#pragma unroll 8
            for (int i = 0; i < 32; ++i) { const int idx = tid + NTHREADS * i, c = idx >> 7, d = idx & 127; A[c * 132 + d] = wp[idx] * ps[d]; }
#pragma unroll 8
            for (int i = 0; i < 16; ++i) { const int idx = tid + NTHREADS * i, d = idx >> 6, n = idx & 63; B[idx] = wo[(size_t)d * 1024 + n]; }
            __syncthreads();
            const int c = tid >> 2, nq = tid & 3;
            f32x4 acc[4];
#pragma unroll
            for (int j = 0; j < 4; ++j) acc[j] = (f32x4){0.f, 0.f, 0.f, 0.f};
#pragma unroll 4
            for (int d = 0; d < 128; ++d) { const float a = A[c * 132 + d];
#pragma unroll
                for (int j = 0; j < 4; ++j) acc[j] += *(const LAS f32x4*)(B + d * 64 + 16 * nq + 4 * j) * a; }
#pragma unroll
            for (int j = 0; j < 4; ++j)
#pragma unroll
                for (int e = 0; e < 4; ++e) OT[(16 * nq + 4 * j + e) * 128 + c] = (bf16_t)(cvtpk(acc[j][e], 0.f) & 0xffffu);
            __syncthreads();
            bf16_t* dst = (bf16_t*)(ws + WS_WOUT) + ((size_t)l * 1024 + nb * 64) * 1024 + 512 + g * 128;
#pragma unroll
            for (int i = 0; i < 2; ++i) { const int ch = tid + NTHREADS * i, n = ch >> 4, cc8 = ch & 15; *(u32x4*)(dst + (size_t)n * 1024 + cc8 * 8) = *(const LAS u32x4*)(OT + n * 128 + cc8 * 8); }
            __syncthreads();
        } else {
            LAS unsigned char* scr = lds + wave * 8448;
            int tj = job - J_MOD - J_FOLD; const int wk = wave >> 2, wn = wave & 3;
            if (tj < 704) { const int ls = tj / 176, r = tj % 176, kb = r / 22, nb = r % 22, k0 = kb * 128 + wk * 64, n0 = nb * 256 + wn * 64;
                const int cidx = (n0 < DFF) ? n0 : n0 - DFF; const int drow = 256 * (cidx >> 7) + (cidx & 127) + ((n0 < DFF) ? 0 : 128);
                p0_transpose_item(P->wgu + (size_t)ls * 1024 * 5632, 5632, k0, n0, (bf16_t*)(ws + WS_WGU) + (size_t)ls * 5632 * 1024, 1024, drow, scr, lane); }
            else if ((tj -= 704) < 352) { const int ls = tj / 88, r = tj % 88, kb = r / 4, nb = r % 4, k0 = kb * 128 + wk * 64, n0 = nb * 256 + wn * 64;
                p0_transpose_item(P->wd + (size_t)ls * DFF * 1024, 1024, k0, n0, (bf16_t*)(ws + WS_WD) + (size_t)ls * 1024 * DFF, DFF, n0, scr, lane); }
            else if ((tj -= 352) < 128) { const int l = tj / 64, r = tj % 64, kb = r / 8, nb = r % 8, k0 = kb * 128 + wk * 64, n0 = nb * 256 + wn * 64;
                const int drow = (n0 < 1024) ? n0 : (n0 < 1536) ? n0 + 512 : n0 - 512;
                p0_transpose_item(P->win + (size_t)l * 1024 * INW, INW, k0, n0, (bf16_t*)(ws + WS_WIN) + (size_t)l * INW * 1024, 1024, drow, scr, lane); }
            else { tj -= 128; const int l = tj / 16, r = tj % 16, kb = r / 4, nb = r % 4, k0 = kb * 128 + wk * 64, n0 = nb * 256 + wn * 64;
                p0_transpose_item(P->wout + (size_t)l * 1024 * 1024, 1024, k0, n0, (bf16_t*)(ws + WS_WOUT) + (size_t)l * 1024 * 1024, 1024, n0, scr, lane); }
        }
    }
}

struct RowPass {
    const float *srcX, *srcC; float *dstX, *dstC; const bf16_t* srcXb; bf16_t* dstXb;
    const bf16_t* Yb; const float *gate, *gpost; float coef;
    const float *shift, *scale, *gpre; bf16_t* XN;
    int M; bool hasY, hasXN; const float* YP; int nparts;
};
template <int RPT> __device__ __forceinline__ void row_range(const RowPass& R, int lane, int gw, int NGW, int mlo, int mhi) {
    for (int m0 = mlo + RPT * gw; m0 < mhi; m0 += RPT * NGW) {
        const int who = (m0 < SEQ) ? 0 : (m0 < MX) ? 1 : 2;
        const bool isx = m0 < MX;
        f32x4 v[RPT][4];
#pragma unroll
        for (int rr = 0; rr < RPT; ++rr) { const int m = m0 + rr;
            if (isx && R.srcXb) {
#pragma unroll
                for (int j = 0; j < 4; ++j) { const u32x2 w = __builtin_nontemporal_load((const u32x2*)(R.srcXb + (size_t)m * DM + 4 * lane + 256 * j));
                    v[rr][j] = (f32x4){__uint_as_float(w.x << 16), __uint_as_float(w.x & 0xffff0000u), __uint_as_float(w.y << 16), __uint_as_float(w.y & 0xffff0000u)}; }
            } else { const float* xin = isx ? R.srcX + (size_t)m * DM : R.srcC + (size_t)(m - MX) * DM;
#pragma unroll
                for (int j = 0; j < 4; ++j) v[rr][j] = __builtin_nontemporal_load((const f32x4*)(xin + 4 * lane + 256 * j)); } }
        if (R.hasY) {
            f32x4 y[RPT][4]; float ss[RPT];
#pragma unroll
            for (int rr = 0; rr < RPT; ++rr) ss[rr] = 0.f;
#pragma unroll
            for (int rr = 0; rr < RPT; ++rr) { const int m = m0 + rr;
#pragma unroll
                for (int j = 0; j < 4; ++j) {
                    if (isx) { const u32x2 w = __builtin_nontemporal_load((const u32x2*)(R.Yb + (size_t)m * DM + 4 * lane + 256 * j));
                        y[rr][j] = (f32x4){__uint_as_float(w.x << 16), __uint_as_float(w.x & 0xffff0000u), __uint_as_float(w.y << 16), __uint_as_float(w.y & 0xffff0000u)}; }
                    else { f32x4 tp[11];
#pragma unroll
                        for (int p = 0; p < 11; ++p) tp[p] = *(const f32x4*)(R.YP + ((size_t)min(p, R.nparts - 1) * MC + (m - MX)) * DM + 4 * lane + 256 * j);
                        f32x4 t = tp[0];
#pragma unroll
                        for (int p = 1; p < 11; ++p) t += tp[p] * ((p < R.nparts) ? 1.0f : 0.0f);
                        y[rr][j] = t; }
                    ss[rr] += (y[rr][j].x * y[rr][j].x + y[rr][j].y * y[rr][j].y) + (y[rr][j].z * y[rr][j].z + y[rr][j].w * y[rr][j].w); } }
#pragma unroll
            for (int rr = 0; rr < RPT; ++rr) ss[rr] = wave_sum(ss[rr]);
#pragma unroll
            for (int rr = 0; rr < RPT; ++rr) { const int m = m0 + rr;
                const float rs = rsqrtf(ss[rr] * (1.0f / DM) + RMS_EPS) * R.coef;
#pragma unroll
                for (int j = 0; j < 4; ++j) { const int col = 4 * lane + 256 * j; const f32x4 gt = *(const f32x4*)(R.gate + who * NMODW + col), gp = *(const f32x4*)(R.gpost + col);
                    v[rr][j] = v[rr][j] + gt * (y[rr][j] * rs * gp); }
                if (isx && R.dstXb) {
#pragma unroll
                    for (int j = 0; j < 4; ++j) { u32x2 w; w.x = cvtpk(v[rr][j][0], v[rr][j][1]); w.y = cvtpk(v[rr][j][2], v[rr][j][3]); *(u32x2*)(R.dstXb + (size_t)m * DM + 4 * lane + 256 * j) = w;
                        v[rr][j] = (f32x4){__uint_as_float(w.x << 16), __uint_as_float(w.x & 0xffff0000u), __uint_as_float(w.y << 16), __uint_as_float(w.y & 0xffff0000u)}; }
                } else { float* xo = isx ? R.dstX + (size_t)m * DM : R.dstC + (size_t)(m - MX) * DM;
#pragma unroll
                    for (int j = 0; j < 4; ++j) *(f32x4*)(xo + 4 * lane + 256 * j) = v[rr][j]; } }
        }
        if (R.hasXN) {
            float ss[RPT];
#pragma unroll
            for (int rr = 0; rr < RPT; ++rr) ss[rr] = 0.f;
#pragma unroll
            for (int rr = 0; rr < RPT; ++rr)
#pragma unroll
                for (int j = 0; j < 4; ++j) ss[rr] += (v[rr][j].x * v[rr][j].x + v[rr][j].y * v[rr][j].y) + (v[rr][j].z * v[rr][j].z + v[rr][j].w * v[rr][j].w);
#pragma unroll
            for (int rr = 0; rr < RPT; ++rr) ss[rr] = wave_sum(ss[rr]);
#pragma unroll
            for (int rr = 0; rr < RPT; ++rr) { const int m = m0 + rr;
                const float rs = rsqrtf(ss[rr] * (1.0f / DM) + RMS_EPS);
#pragma unroll
                for (int j = 0; j < 4; ++j) { const int col = 4 * lane + 256 * j;
                    const f32x4 gp = *(const f32x4*)(R.gpre + col), sh = *(const f32x4*)(R.shift + who * NMODW + col), sc = *(const f32x4*)(R.scale + who * NMODW + col);
                    const f32x4 o = (v[rr][j] * rs * gp) * (sc + 1.0f) + sh;
                    u32x2 w; w.x = cvtpk(o[0], o[1]); w.y = cvtpk(o[2], o[3]);
                    *(u32x2*)(R.XN + (size_t)m * DM + col) = w; } }
        }
    }
}

__device__ __forceinline__ void phase_row(const RowPass& R, int wave, int lane, int bx, int G) {
    const int gw = bx * NWAVES + wave, NGW = G * NWAVES;
    row_range<4>(R, lane, gw, NGW, 0, (R.M < MX) ? R.M : MX);
    if (R.M > MX) row_range<2>(R, lane, NGW - 1 - gw, NGW, MX, R.M);
}

#define MFMA32(a, b, c) __builtin_amdgcn_mfma_f32_32x32x16_bf16((a), (b), (c), 0, 0, 0)
struct KFrag { bf16x8 k[4]; };
struct VFrag { bf16x8 v[4]; };
__device__ __forceinline__ void attn_loadk(KFrag& f, const bf16_t* kbase, int krow0) {
    const bf16_t* kp = kbase + (size_t)krow0 * 512;
#pragma unroll
    for (int dk = 0; dk < 4; ++dk) f.k[dk] = *(const bf16x8*)(kp + dk * 16);
}
__device__ __forceinline__ void attn_loadv(VFrag& f, const bf16_t* vbase, int krow0) {
    const bf16_t* vp = vbase + krow0;
    f.v[0] = *(const bf16x8*)(vp); f.v[1] = *(const bf16x8*)(vp + 16); f.v[2] = *(const bf16x8*)(vp + (size_t)32 * MT); f.v[3] = *(const bf16x8*)(vp + (size_t)32 * MT + 16);
}
__device__ __forceinline__ void attn_soft(f32x16& S, f32x16& o0, f32x16& o1, float& mrun, float& lrun, bool masked, const LAS float* bt, int relb, int idxb, bf16x8& pb0, bf16x8& pb1) {
    if (masked) {
        const LAS float* bp = bt + idxb;
        float bv[16];
#pragma unroll
        for (int r = 0; r < 16; ++r) bv[r] = bp[16 * (r >> 3) + (r & 7)];
#pragma unroll
        for (int r = 0; r < 16; ++r) {
            const int off = 16 * (r >> 3) + (r & 7);
            const bool valid = (unsigned)(relb + off) < 16u;
            S[r] = valid ? S[r] + bv[r] : -1e30f;
        }
    }
    float tm = S[0];
#pragma unroll
    for (int r = 1; r < 16; ++r) tm = fmaxf(tm, S[r]);
    tm = fmaxf(tm, __shfl_xor(tm, 32));
    if (__any(tm > mrun)) {
        const float mn = fmaxf(mrun, tm);
        const float fs = __builtin_amdgcn_exp2f(mrun - mn);
        mrun = mn; lrun *= fs;
#pragma unroll
        for (int r = 0; r < 16; ++r) { o0[r] *= fs; o1[r] *= fs; }
    }
    float ps = 0.f;
#pragma unroll
    for (int r = 0; r < 16; ++r) { S[r] = __builtin_amdgcn_exp2f(S[r] - mrun); ps += S[r]; }
    lrun += ps;
    u32x4 w0, w1;
    w0.x = cvtpk(S[0], S[1]); w0.y = cvtpk(S[2], S[3]); w0.z = cvtpk(S[4], S[5]); w0.w = cvtpk(S[6], S[7]);
    w1.x = cvtpk(S[8], S[9]); w1.y = cvtpk(S[10], S[11]); w1.z = cvtpk(S[12], S[13]); w1.w = cvtpk(S[14], S[15]);
    pb0 = __builtin_bit_cast(bf16x8, w0); pb1 = __builtin_bit_cast(bf16x8, w1);
}
struct AttnState { f32x16 o0, o1; float m, l; };
__device__ __forceinline__ void attn_comp2(KFrag& fk, const VFrag& f, const bf16x8 (&qa)[4], const bf16x8 (&qb)[4], AttnState& A, AttnState& B,
                                           bool masked, const LAS float* bt, int relA, int idxA, int relB, int idxB, const bf16_t* kbase, int nextrow) {
    f32x16 SA, SB;
#pragma unroll
    for (int r = 0; r < 16; ++r) { SA[r] = 0.f; SB[r] = 0.f; }
#pragma unroll
    for (int dk = 0; dk < 4; ++dk) { SA = MFMA32(fk.k[dk], qa[dk], SA); SB = MFMA32(fk.k[dk], qb[dk], SB); }
    if (nextrow >= 0) attn_loadk(fk, kbase, nextrow);
    bf16x8 p0, p1;
    attn_soft(SA, A.o0, A.o1, A.m, A.l, masked, bt, relA, idxA, p0, p1);
    A.o0 = MFMA32(f.v[0], p0, A.o0); A.o0 = MFMA32(f.v[1], p1, A.o0); A.o1 = MFMA32(f.v[2], p0, A.o1); A.o1 = MFMA32(f.v[3], p1, A.o1);
    attn_soft(SB, B.o0, B.o1, B.m, B.l, masked, bt, relB, idxB, p0, p1);
    B.o0 = MFMA32(f.v[0], p0, B.o0); B.o0 = MFMA32(f.v[1], p1, B.o0); B.o1 = MFMA32(f.v[2], p0, B.o1); B.o1 = MFMA32(f.v[3], p1, B.o1);
}
__device__ __forceinline__ void attn_store(const AttnState& A, bf16_t* op) {
    const float lt = A.l + __shfl_xor(A.l, 32);
    const float inv = 1.0f / lt;
#pragma unroll
    for (int g4 = 0; g4 < 4; ++g4) {
        u32x2 w; w.x = cvtpk(A.o0[4 * g4] * inv, A.o0[4 * g4 + 1] * inv); w.y = cvtpk(A.o0[4 * g4 + 2] * inv, A.o0[4 * g4 + 3] * inv); *(u32x2*)(op + 8 * g4) = w;
        u32x2 z; z.x = cvtpk(A.o1[4 * g4] * inv, A.o1[4 * g4 + 1] * inv); z.y = cvtpk(A.o1[4 * g4 + 2] * inv, A.o1[4 * g4 + 3] * inv); *(u32x2*)(op + 32 + 8 * g4) = z;
    }
}

__device__ __forceinline__ void phase_mix(KParams P, int layer, LAS unsigned char* lds, int tid, int wave, int lane, int bx, int G) {
    unsigned char* ws = P->ws;
    const bf16_t* Qb = (const bf16_t*)(ws + WS_Q); const bf16_t* Kb = (const bf16_t*)(ws + WS_K); const bf16_t* Ub = (const bf16_t*)(ws + WS_U);
    const bf16_t* Vt = (const bf16_t*)(ws + WS_VT); bf16_t* MIXb = (bf16_t*)(ws + WS_MIX);
    LAS float* bt = (LAS float*)(lds + wave * 2560) + 64;
    const int vb = (G % 8 == 0) ? (bx % 8) * (G / 8) + bx / 8 : bx;
    const int gw = vb * NWAVES + wave, NGW = G * NWAVES;
    const int q = lane & 31, hi = lane >> 5, pi = (q & 0x13) | ((q & 4) << 1) | ((q & 8) >> 1);
    const int nunits = 2048 + ((layer == 0) ? 64 : 0);
    for (int un = gw; un < nunits; un += NGW) {
        int b, h, qrow0, r = 0; const bool local = un < 2048;
        if (local) { r = un & 127; h = (un >> 7) & 7; b = un >> 10; qrow0 = b * SEQ + r * 64; }
        else { const int v = un - 2048; const int qb = v & 3; h = (v >> 2) & 7; b = v >> 5; qrow0 = MX + b * CTXL + qb * 64; }
        if (local) {
            const float* rp = P->rpb + (size_t)(layer * NH + h) * 465;
            for (int i = lane; i < 465; i += 64) bt[i] = rp[i] * LOG2E;
        }
        bf16x8 qa[4], qb4[4];
#pragma unroll
        for (int dk = 0; dk < 4; ++dk) { qa[dk] = *(const bf16x8*)(Qb + (size_t)(qrow0 + q) * 512 + h * 64 + dk * 16 + hi * 8);
                                         qb4[dk] = *(const bf16x8*)(Qb + (size_t)(qrow0 + 32 + q) * 512 + h * 64 + dk * 16 + hi * 8); }
        AttnState A, B;
#pragma unroll
        for (int i = 0; i < 16; ++i) { A.o0[i] = 0.f; A.o1[i] = 0.f; B.o0[i] = 0.f; B.o1[i] = 0.f; }
        A.m = -1e30f; A.l = 0.f; B.m = -1e30f; B.l = 0.f;
        const int crow0 = MX + b * CTXL;
        const int rs = min(max(r - 4, 0), 120);
        const int jA = q, jB = 32 + q, csA = min(max(jA - 8, 0), 48), csB = min(max(jB - 8, 0), 48);
        const int lrow0 = b * SEQ + rs * 64;
        const bf16_t* kbase = Kb + (size_t)pi * 512 + h * 64 + hi * 8;
        const bf16_t* vbase = Vt + (size_t)(h * 64 + q) * MT + hi * 8;
        const int ntiles = local ? 24 : 8;
#define TROW(t) (((t) < 8) ? crow0 + 32 * (t) : lrow0 + 32 * ((t) - 8))
#define TCOMP(FK, FV, t, NXT) do { const int t_ = (t); const int kr_ = (t_ - 8) >> 1, ct_ = (t_ - 8) & 1; const int br_ = (rs + kr_ - r + 7) * 31 + ct_ * 32 + 8 * hi + 15; \
            int ra_ = ct_ * 32 + 8 * hi - csA, rb_ = ct_ * 32 + 8 * hi - csB; asm volatile("" : "+v"(ra_), "+v"(rb_));     \
            attn_comp2(FK, FV, qa, qb4, A, B, t_ >= 8, bt, ra_, br_ - jA, rb_, br_ - jB, kbase, (NXT)); } while (0)
        KFrag k0; VFrag fv;
        attn_loadk(k0, kbase, TROW(0));
        asm volatile("s_waitcnt lgkmcnt(0)" ::: "memory");
        for (int t = 0; t < ntiles; ++t) {
            attn_loadv(fv, vbase, TROW(t));
            TCOMP(k0, fv, t, (t + 1 < ntiles) ? TROW(t + 1) : -1);
        }
#undef TROW
#undef TCOMP
        attn_store(A, MIXb + (size_t)(qrow0 + q) * 1024 + h * 64 + 4 * hi);
        attn_store(B, MIXb + (size_t)(qrow0 + 32 + q) * 1024 + h * 64 + 4 * hi);
        asm volatile("s_waitcnt lgkmcnt(0)" ::: "memory");
    }
    const int mrows = (layer == 0) ? MT : MX;
    const int nskip = (layer == 0) ? 64 : 0;
    if (gw < nskip) return;
    for (int wi = gw - nskip; wi < mrows; wi += NGW - nskip) {
        const int g = wi & 3, m = (wi & ~3) + (lane >> 4), ch = g * 16 + (lane & 15);
        int jj, len;
        if (m < MX) { jj = m & 63; len = 64; } else { jj = (m - MX) & 255; len = 256; }
        const int base = m - jj;
        float a[8];
#pragma unroll
        for (int e = 0; e < 8; ++e) a[e] = 0.f;
        const bf16_t* up = Ub + (size_t)base * 512 + ch * 8;
#define POOLW(W2) do { const int lo = max(jj - (W2), 0), hi2 = min(jj + (W2), len); u32x4 uv[2 * (W2)]; \
            _Pragma("unroll") for (int t = 0; t < 2 * (W2); ++t) uv[t] = *(const u32x4*)(up + (size_t)min(lo + t, hi2 - 1) * 512); \
            _Pragma("unroll") for (int t = 0; t < 2 * (W2); ++t) { const float wgt = (lo + t < hi2) ? 1.0f : 0.0f; \
                _Pragma("unroll") for (int e = 0; e < 4; ++e) { a[2 * e] += wgt * __uint_as_float(uv[t][e] << 16); a[2 * e + 1] += wgt * __uint_as_float(uv[t][e] & 0xffff0000u); } } \
            const float ic = 1.0f / (float)(hi2 - lo); _Pragma("unroll") for (int e = 0; e < 8; ++e) a[e] *= ic; } while (0)
        if (g == 0) POOLW(1); else if (g == 1) POOLW(2); else if (g == 2) POOLW(4); else POOLW(8);
#undef POOLW
        const u32x4 us = *(const u32x4*)(Ub + (size_t)m * 512 + ch * 8);
        u32x4 o;
#pragma unroll
        for (int e = 0; e < 4; ++e) o[e] = cvtpk(a[2 * e] - __uint_as_float(us[e] << 16), a[2 * e + 1] - __uint_as_float(us[e] & 0xffff0000u));
        *(u32x4*)(MIXb + (size_t)m * 1024 + 512 + ch * 8) = o;
    }
}

__device__ __forceinline__ void run_phase(KParams P, int ph, LAS unsigned char* lds, int tid, int wave, int lane, int bx, int G) {
    unsigned char* ws = P->ws;
    float* MOD = (float*)(ws + WS_MOD);
    bf16_t* XN = (bf16_t*)(ws + WS_XN); bf16_t* Yb = (bf16_t*)(ws + WS_Y); bf16_t* H = (bf16_t*)(ws + WS_H);
    float* CTXS = (float*)(ws + WS_CTXS);
    if (ph == 0) { phase_p0(P, lds, tid, wave, lane, bx, G); return; }
    const int l = (ph == NPHASE - 1) ? 2 : (ph - 1) / 10, s = (ph == NPHASE - 1) ? 0 : (ph - 1) % 10;
    const int Mlate = (l == 1) ? MX : MT;
    if (s == 0 || s == 3 || s == 7) {
        int yl = l, gidx = 5, gpi = 3, nl = l, npre = 4, nsh = 6, M = Mlate; bool hasY = true, hasXN = true, useIn = false; float coef = 1.0f;
        if (s == 0) { yl = (l > 0) ? l - 1 : 0; gidx = 8; gpi = 5; npre = 0; nsh = 0; M = MT; coef = 0.5f; hasY = (l > 0); useIn = (l == 0);
                      if (l == 2) { hasXN = false; M = MX; nl = 1; } }
        else if (s == 3) { gidx = 2; gpi = 1; npre = 2; nsh = 3; M = MT; coef = 0.5f; useIn = (l == 0); }
        RowPass R;
        R.srcX = P->x; R.srcXb = useIn ? (const bf16_t*)nullptr : (const bf16_t*)(ws + WS_XS); R.srcC = useIn ? P->ctx : (const float*)CTXS;
        R.dstX = P->out; R.dstXb = (l == 2) ? (bf16_t*)nullptr : (bf16_t*)(ws + WS_XS); R.dstC = CTXS;
        R.YP = (const float*)(ws + WS_YP); R.nparts = (s == 7) ? 4 : 11;
        R.Yb = Yb; R.XN = XN; R.hasY = hasY; R.hasXN = hasXN; R.M = M; R.coef = coef;
        R.gate = MOD + (size_t)yl * 3 * NMODW + gidx * DM; R.gpost = P->normg + (yl * 6 + gpi) * DM;
        R.gpre = P->normg + (nl * 6 + npre) * DM; R.shift = MOD + (size_t)nl * 3 * NMODW + nsh * DM; R.scale = R.shift + DM;
        phase_row(R, wave, lane, bx, G);
        return;
    }
    if (s == 5) { phase_mix(P, l, lds, tid, wave, lane, bx, G); return; }
    const bool split = (s == 2 || s == 9 || s == 6) && (Mlate == MT || s == 2);
    const int npass = (s == 4 || split) ? 2 : 1;
    for (int pass = 0; pass < npass; ++pass) {
        pg8::Gemm g; EpiAny E; E.ropeC = (const float*)(ws + WS_ROPEC); E.ropeS = (const float*)(ws + WS_ROPES); E.pstride = 0; E.ntp = 0; int cu = bx, pm0 = 0, ksplit = 1, ntp = 0;
        if (s == 1 || s == 8) {
            const int sub = (s == 1) ? 0 : 1; const int M = (s == 1) ? MT : Mlate;
            g = pg8::Gemm{XN, (const bf16_t*)(ws + WS_WGU) + (size_t)(l * 2 + sub) * 5632 * 1024, M, 5632, 1024, 1024};
            E.mode = EPI_SWIGLU; E.perm = true; E.O = H; E.ldc = DFF;
        } else if (s == 6 || s == 2 || s == 9) {
            const bf16_t* A; const bf16_t* Bt; int K;
            if (s == 6) { A = (const bf16_t*)(ws + WS_MIX); Bt = (const bf16_t*)(ws + WS_WOUT) + (size_t)l * 1024 * 1024; K = 1024; }
            else { const int sub = (s == 2) ? 0 : 1; A = H; Bt = (const bf16_t*)(ws + WS_WD) + (size_t)(l * 2 + sub) * 1024 * DFF; K = DFF; }
            E.mode = EPI_F32; E.perm = false; E.ldc = 1024;
            if (pass == 0) { g = pg8::Gemm{A, Bt, MX, 1024, K, K}; E.mode = EPI_BF16; E.perm = true; E.O = Yb; }
            else { ntp = 4; ksplit = K / 256; pm0 = MX / 256; g = pg8::Gemm{A, Bt, MC, 1024, 256, K};
                   E.O = (float*)(ws + WS_YP) - (size_t)MX * 1024; E.pstride = MC * 1024; E.ntp = 4; }
        } else {
            const bf16_t* Wt = (const bf16_t*)(ws + WS_WIN) + (size_t)l * INW * 1024;
            if (pass == 0) { g = pg8::Gemm{XN, Wt, MT, 1536, 1024, 1024}; E.mode = EPI_QKU; E.perm = false; E.O = ws + WS_Q; E.ldc = 512; }
            else { g = pg8::Gemm{Wt + (size_t)1536 * 1024, XN, 512, MT, 1024, 1024}; E.mode = EPI_BF16; E.perm = true; E.O = ws + WS_VT; E.ldc = MT; cu = G - 1 - bx; }
        }
        pg8::StaticOrder S; S.init(g.M, g.N, G, cu, pm0, ksplit, ntp);
        pg8::gemm_phase<EpiAny, pg8::StaticOrder, true, true>(lds, g, S, E);
    }
}

__global__ void __launch_bounds__(NTHREADS, 2) mega(Params P, int ph_lo, int ph_hi) {
    extern __shared__ __attribute__((aligned(16))) unsigned char lds_raw[];
    LAS unsigned char* lds = (LAS unsigned char*)lds_raw;
    cg::grid_group grid = cg::this_grid();
    volatile LAS unsigned* bst = (volatile LAS unsigned*)(lds + 131072 + 64);
    if (threadIdx.x < 2) bst[threadIdx.x] = 0u;
    __syncthreads();
    XcdBarrier bar;
    { KParams kp0 = (KParams)__builtin_amdgcn_kernarg_segment_ptr(); bar = xcd_barrier_post((unsigned*)(kp0->ws + WS_BAR), bst); }
    KParams kp = (KParams)__builtin_amdgcn_kernarg_segment_ptr();
#if defined(PROBE_REP_PH)
    const int nextra = PROBE_REPS - 1;
#else
    const int nextra = 0;
#endif
    const int nsteps = ph_hi - ph_lo + nextra;
    for (int step = 0; step < nsteps; ++step) {
        int ph = ph_lo + step;
#if defined(PROBE_REP_PH)
        if (ph > PROBE_REP_PH) ph = (ph <= PROBE_REP_PH + nextra) ? PROBE_REP_PH : ph - nextra;
#endif
        asm volatile("" : "+s"(kp));
        int tid = threadIdx.x; asm volatile("" : "+v"(tid));
        const int lane = tid & 63, wave = __builtin_amdgcn_readfirstlane(tid >> 6);
        int bx = blockIdx.x, G = gridDim.x; asm volatile("" : "+s"(bx), "+s"(G));
        run_phase(kp, ph, lds, tid, wave, lane, bx, G);
        if (step + 1 < nsteps) { if (ph_lo < 0) grid.sync(); else xcd_barrier(bar); }
    }
}

extern "C" void kernel_launch(void* const* d_in, const int* in_sizes, int n_in, void* d_out, int out_size, void* d_ws, size_t ws_size, hipStream_t stream) {
    static int grid = 0;
    if (grid == 0) {
        if (n_in != 14 || in_sizes[0] != MX * DM || out_size != MX * DM || ws_size < WS_END) {
            fprintf(stderr, "kernel_launch: unexpected shapes (n_in %d, in0 %d, out %d, ws %zu < %zu)\n", n_in, n_in > 0 ? in_sizes[0] : -1, out_size, ws_size, (size_t)WS_END); grid = -1; return; }
        int dev = 0, cus = 0, per_cu = 0;
        (void)hipGetDevice(&dev); (void)hipDeviceGetAttribute(&cus, hipDeviceAttributeMultiprocessorCount, dev);
        if (hipFuncSetAttribute((const void*)mega, hipFuncAttributeMaxDynamicSharedMemorySize, LDS_BYTES) != hipSuccess) { fprintf(stderr, "kernel_launch: hipFuncSetAttribute failed\n"); grid = -1; return; }
        if (hipOccupancyMaxActiveBlocksPerMultiprocessor(&per_cu, (const void*)mega, NTHREADS, LDS_BYTES) != hipSuccess || per_cu < 1) { fprintf(stderr, "kernel_launch: occupancy query gave %d\n", per_cu); per_cu = 1; }
        (void)hipGetLastError();
        grid = cus * 1;
        if (grid <= 0) grid = 256;
    }
    if (grid < 0) return;
    if (hipMemsetAsync((char*)d_ws + WS_BAR, 0, 65536, stream) != hipSuccess) { fprintf(stderr, "kernel_launch: memset failed\n"); return; }
    Params p{};
    p.x = (const float*)d_in[0]; p.c = (const float*)d_in[1]; p.ctx = (const float*)d_in[2]; p.cctx = (const float*)d_in[3];
    p.wmod = (const float*)d_in[4]; p.bmod = (const float*)d_in[5]; p.normg = (const float*)d_in[6]; p.wgu = (const float*)d_in[7];
    p.wd = (const float*)d_in[8]; p.win = (const float*)d_in[9]; p.wout = (const float*)d_in[10]; p.rpb = (const float*)d_in[11];
    p.wpool = (const float*)d_in[12]; p.pscale = (const float*)d_in[13];
    p.out = (float*)d_out; p.ws = (unsigned char*)d_ws;
#if MK_MULTI
    for (int ph = 0; ph < NPHASE; ++ph) {
        int lo = ph, hi = ph + 1; void* args[] = {&p, &lo, &hi};
        hipError_t e = hipLaunchCooperativeKernel((const void*)mega, dim3(grid), dim3(NTHREADS), args, LDS_BYTES, stream);
        if (e != hipSuccess) { fprintf(stderr, "launch %d failed: %s\n", ph, hipGetErrorString(e)); break; }
    }
#else
#ifndef MK_PH_HI
#define MK_PH_HI NPHASE
#endif
#ifndef MK_PH_LO
#define MK_PH_LO 0
#endif
    int lo = MK_PH_LO, hi = MK_PH_HI; void* args[] = {&p, &lo, &hi};
    hipError_t e = hipLaunchCooperativeKernel((const void*)mega, dim3(grid), dim3(NTHREADS), args, LDS_BYTES, stream);
    if (e != hipSuccess) fprintf(stderr, "cooperative launch failed: %s (grid %d)\n", hipGetErrorString(e), grid);
#endif
}
```

```cpp
#include <hip/hip_runtime.h>
#include <hip/hip_cooperative_groups.h>
#include <cstdio>
#include <cstdint>
namespace cg = cooperative_groups;
namespace pg8 {
#define PG8_LAS __attribute__((address_space(3)))
typedef unsigned short bf16_t;
typedef short bf16x8 __attribute__((ext_vector_type(8)));
typedef float f32x4 __attribute__((ext_vector_type(4)));
typedef unsigned u32x4 __attribute__((ext_vector_type(4)));
constexpr int BM = 256, BK = 64, HALF = 128, HTB = HALF * BK * 2  , STAGE_BYTES = 8 * HTB, NXCD = 8, WGM = 8;

__host__ __device__ __forceinline__ int lds_byte(int r, int c) { const int st = (r >> 4) * 2 + (c >> 5), rr = r & 15, cc = c & 31, ob = rr * 64 + cc * 2; return st * 1024 + (ob ^ (((ob >> 9) & 1) << 5)); }
__host__ __device__ __forceinline__ void stage_rc(int b, int& R, int& C) { const int st = b / 1024, sb = b % 1024, swz = sb ^ (((sb >> 9) & 1) << 5); R = (st >> 1) * 16 + swz / 64; C = (st & 1) * 32 + (swz % 64) / 2; }
__host__ __device__ __forceinline__ int perm32(int rho) { const int n = rho >> 4, i = rho & 15; return 8 * (i >> 2) + 4 * n + (i & 3); }

struct Unit { int pm, pn, kb; };
struct Gemm { const bf16_t* A; const bf16_t* Bt; int M, N, K, ld; };

struct StaticOrder {
    int nM, nN, nwg, G, c, pm0, ksplit, ntp;
    __host__ __device__ void init(int M, int N, int G_, int c_, int pm0_ = 0, int ksplit_ = 1, int ntp_ = 0) { nM = M / BM; nN = N / BM; nwg = nM * nN * ksplit_; G = G_; c = c_; pm0 = pm0_; ksplit = ksplit_; ntp = ntp_; }
    __host__ __device__ bool next(int i, Unit& u) const {
        const long L = (long)i * G + c; if (L >= nwg) return false;
        int wgid = (int)L; u.kb = (wgid % ksplit) * ntp; wgid /= ksplit; { const int nwg = nM * nN; const int q = nwg / NXCD, r = nwg % NXCD, xcd = wgid % NXCD, off = wgid / NXCD; wgid = (xcd < r ? xcd * (q + 1) : r * (q + 1) + (xcd - r) * q) + off; }
        const int nig = WGM * nN, gid = wgid / nig, fm = gid * WGM, gsz = (nM - fm) < WGM ? (nM - fm) : WGM;
        u.pm = pm0 + fm + ((wgid % nig) % gsz); u.pn = (wgid % nig) / gsz; return true;
    }
    __device__ __forceinline__ void a_ready(const Unit&) const {}
    __device__ __forceinline__ void done(const Unit&) const {}
};

__device__ __forceinline__ unsigned cvt_pk_bf16(float lo, float hi) { unsigned r; asm volatile("v_cvt_pk_bf16_f32 %0, %1, %2" : "=v"(r) : "v"(lo), "v"(hi)); return r; }
typedef float f32x2 __attribute__((ext_vector_type(2)));
template <class Epi, class Sched, bool ALIGN_EPI = false, bool SP2 = false>
__device__ __forceinline__ void gemm_phase(PG8_LAS unsigned char* lds, const Gemm g, const Sched& S, const Epi& E) {
    int tid_raw = threadIdx.x; asm volatile("" : "+v"(tid_raw));
    const int tid = tid_raw, wid = __builtin_amdgcn_readfirstlane(tid >> 6), lane = tid & 63, wr = wid >> 2, wc = wid & 3, fr = lane & 15, fq = lane >> 4;
    const int K = g.ld, nt = g.K / BK;
    unsigned voffA[2], voffB[2];
#pragma unroll
    for (int i = 0; i < 2; ++i) { int R, C; stage_rc(tid * 16 + i * 8192, R, C); const int Rb = E.perm ? ((R & ~31) + perm32(R & 31)) : R;
        voffA[i] = (unsigned)(R * K + C) * 2u; voffB[i] = (unsigned)(Rb * K + C) * 2u; }
    const size_t kstep = (size_t)(BK * 2);
    const size_t hstep = (size_t)HALF * K * 2;
    const size_t tstep = 2 * hstep;
    const unsigned ldsw = (unsigned)wid * 1024u;
    const int aoff = lds_byte(wr * 64 + fr, fq * 8), boff = lds_byte(wc * 32 + fr, fq * 8);
#define PG8_SA(b, h) (((b) * 2 + (h)) * HTB)
#define PG8_SB(b, h) ((4 + (b) * 2 + (h)) * HTB)
#define PG8_STAGE(bufoff, gbase, voff) do { _Pragma("unroll") for (int _i = 0; _i < 2; ++_i) \
        __builtin_amdgcn_global_load_lds((const unsigned*)((const char*)(gbase) + (voff)[_i]), (PG8_LAS unsigned*)(lds + (bufoff) + ldsw + _i * 8192), 16, 0, 0); } while (0)
#define PG8_LDA(dst, b, h) do { _Pragma("unroll") for (int m = 0; m < 4; ++m) _Pragma("unroll") for (int k = 0; k < 2; ++k) dst[m][k] = *(const PG8_LAS bf16x8*)(lds + PG8_SA(b, h) + aoff + m * 2048 + k * 1024); } while (0)
#define PG8_LDB(dst, b, h) do { _Pragma("unroll") for (int n = 0; n < 2; ++n) _Pragma("unroll") for (int k = 0; k < 2; ++k) dst[n][k] = *(const PG8_LAS bf16x8*)(lds + PG8_SB(b, h) + boff + n * 2048 + k * 1024); } while (0)
#define PG8_MMA(ai, bj, At, Bt) do { __builtin_amdgcn_s_setprio(1); _Pragma("unroll") for (int m = 0; m < 4; ++m) _Pragma("unroll") for (int n = 0; n < 2; ++n) _Pragma("unroll") for (int k = 0; k < 2; ++k) \
        acc[ai][bj][m][n] = __builtin_amdgcn_mfma_f32_16x16x32_bf16(Bt[n][k], At[m][k], acc[ai][bj][m][n], 0, 0, 0); __builtin_amdgcn_s_setprio(0); } while (0)
#define PG8_WAIT_V(n) asm volatile("s_waitcnt vmcnt(" #n ")" ::: "memory")
#define PG8_WAIT_L(n) asm volatile("s_waitcnt lgkmcnt(" #n ")" ::: "memory")
#define PG8_BAR __builtin_amdgcn_s_barrier()
#define PG8_SCHED __builtin_amdgcn_sched_barrier(0)
    Unit cur, nxt; int ui = 0;
    if (!S.next(0, cur)) return;
    f32x4 acc[2][2][4][2];
#pragma unroll
    for (int a = 0; a < 2; ++a)
#pragma unroll
        for (int b = 0; b < 2; ++b)
#pragma unroll
            for (int m = 0; m < 4; ++m)
#pragma unroll
                for (int n = 0; n < 2; ++n) acc[a][b][m][n] = (f32x4){0.f, 0.f, 0.f, 0.f};
    bf16x8 At[4][2], B0[2][2], B1[2][2];
    const char* cA = (const char*)g.A + (size_t)cur.pm * tstep + (size_t)cur.kb * (BK * 2); const char* cB = (const char*)g.Bt + (size_t)cur.pn * tstep + (size_t)cur.kb * (BK * 2);
    S.a_ready(cur);
    if constexpr (SP2) {
        PG8_STAGE(PG8_SB(0, 0), cB, voffB); PG8_STAGE(PG8_SB(0, 1), cB + hstep, voffB); PG8_STAGE(PG8_SA(0, 0), cA, voffA); PG8_STAGE(PG8_SA(0, 1), cA + hstep, voffA);
        if (wr == 1) PG8_BAR;
        PG8_WAIT_V(2); PG8_BAR;
        PG8_STAGE(PG8_SB(1, 0), cB + kstep, voffB); PG8_STAGE(PG8_SA(1, 0), cA + kstep, voffA); PG8_STAGE(PG8_SB(1, 1), cB + hstep + kstep, voffB);
        PG8_WAIT_V(6); PG8_BAR;
    } else {
        PG8_STAGE(PG8_SB(0, 0), cB, voffB); PG8_STAGE(PG8_SA(0, 0), cA, voffA); PG8_STAGE(PG8_SB(0, 1), cB + hstep, voffB); PG8_STAGE(PG8_SA(0, 1), cA + hstep, voffA);
        if (wr == 1) PG8_BAR;
        PG8_WAIT_V(4); PG8_BAR;
        PG8_STAGE(PG8_SB(1, 0), cB + kstep, voffB); PG8_STAGE(PG8_SA(1, 0), cA + kstep, voffA); PG8_STAGE(PG8_SB(1, 1), cB + hstep + kstep, voffB);
        PG8_WAIT_V(6); PG8_BAR;
    }
    for (;;) {
        const bool has_next = S.next(ui + 1, nxt);
        const char* nA = has_next ? (const char*)g.A + (size_t)nxt.pm * tstep + (size_t)nxt.kb * (BK * 2) : cA; const char* nB = has_next ? (const char*)g.Bt + (size_t)nxt.pn * tstep + (size_t)nxt.kb * (BK * 2) : cB;
        for (int t = 0; t < nt; t += 2) {
            const bool last = (t == nt - 2);
            const char* a1 = cA + (size_t)(t + 1) * kstep;
            const char* a2 = last ? nA : cA + (size_t)(t + 2) * kstep; const char* b2 = last ? nB : cB + (size_t)(t + 2) * kstep;
            const char* a3 = a2 + kstep; const char* b3 = b2 + kstep;
            if (last && has_next) S.a_ready(nxt);
            if constexpr (SP2) {
            PG8_LDB(B0, 0, 0); PG8_LDB(B1, 0, 1); PG8_SCHED; PG8_LDA(At, 0, 0); PG8_STAGE(PG8_SA(1, 1), a1 + hstep, voffA);
            PG8_WAIT_V(8); PG8_WAIT_L(0); PG8_BAR; PG8_MMA(0, 0, At, B0); PG8_MMA(0, 1, At, B1); PG8_BAR; PG8_SCHED;
            PG8_LDA(At, 0, 1); PG8_STAGE(PG8_SB(0, 0), b2, voffB); PG8_STAGE(PG8_SB(0, 1), b2 + hstep, voffB); PG8_STAGE(PG8_SA(0, 0), a2, voffA);
            PG8_WAIT_V(8); PG8_WAIT_L(0); PG8_BAR; PG8_MMA(1, 0, At, B0); PG8_MMA(1, 1, At, B1); PG8_BAR; PG8_SCHED;
            PG8_LDB(B0, 1, 0); PG8_LDB(B1, 1, 1); PG8_SCHED; PG8_LDA(At, 1, 0); PG8_STAGE(PG8_SA(0, 1), a2 + hstep, voffA);
            PG8_WAIT_V(8); PG8_WAIT_L(0); PG8_BAR; PG8_MMA(0, 0, At, B0); PG8_MMA(0, 1, At, B1); PG8_BAR; PG8_SCHED;
            PG8_LDA(At, 1, 1); PG8_STAGE(PG8_SB(1, 0), b3, voffB); PG8_STAGE(PG8_SB(1, 1), b3 + hstep, voffB); PG8_STAGE(PG8_SA(1, 0), a3, voffA);
            PG8_WAIT_V(8); PG8_WAIT_L(0); PG8_BAR; PG8_MMA(1, 0, At, B0); PG8_MMA(1, 1, At, B1); PG8_BAR; PG8_SCHED;
            } else {
            PG8_LDB(B0, 0, 0); PG8_SCHED; PG8_LDA(At, 0, 0); PG8_STAGE(PG8_SA(1, 1), a1 + hstep, voffA);
            PG8_WAIT_L(8); PG8_BAR; PG8_WAIT_L(0); PG8_MMA(0, 0, At, B0); PG8_BAR; PG8_SCHED;
            PG8_LDB(B1, 0, 1); PG8_STAGE(PG8_SB(0, 0), b2, voffB);
            PG8_BAR; PG8_WAIT_L(0); PG8_MMA(0, 1, At, B1); PG8_BAR;
            PG8_LDA(At, 0, 1); PG8_STAGE(PG8_SA(0, 0), a2, voffA);
            PG8_BAR; PG8_WAIT_L(0); PG8_MMA(1, 0, At, B0); PG8_BAR; PG8_SCHED;
            PG8_STAGE(PG8_SB(0, 1), b2 + hstep, voffB);
            PG8_WAIT_V(6); PG8_BAR; PG8_MMA(1, 1, At, B1); PG8_BAR;
            PG8_LDB(B0, 1, 0); PG8_SCHED; PG8_LDA(At, 1, 0); PG8_STAGE(PG8_SA(0, 1), a2 + hstep, voffA);
            PG8_WAIT_L(8); PG8_BAR; PG8_WAIT_L(0); PG8_MMA(0, 0, At, B0); PG8_BAR; PG8_SCHED;
            PG8_LDB(B1, 1, 1); PG8_STAGE(PG8_SB(1, 0), b3, voffB);
            PG8_BAR; PG8_WAIT_L(0); PG8_MMA(0, 1, At, B1); PG8_BAR;
            PG8_LDA(At, 1, 1); PG8_STAGE(PG8_SA(1, 0), a3, voffA);
            PG8_BAR; PG8_WAIT_L(0); PG8_MMA(1, 0, At, B0); PG8_BAR; PG8_SCHED;
            PG8_STAGE(PG8_SB(1, 1), b3 + hstep, voffB);
            PG8_WAIT_V(6); PG8_BAR; PG8_MMA(1, 1, At, B1); PG8_BAR;
            }
        }
        if constexpr (ALIGN_EPI) { if (wr == 0) PG8_BAR; }
        if constexpr (!Epi::AFTER_DRAIN) { E(acc, cur, wr, wc, fr, fq); S.done(cur); }
        if (!has_next) break;
#pragma unroll
        for (int a = 0; a < 2; ++a)
#pragma unroll
            for (int b = 0; b < 2; ++b)
#pragma unroll
                for (int m = 0; m < 4; ++m)
#pragma unroll
                    for (int n = 0; n < 2; ++n) acc[a][b][m][n] = (f32x4){0.f, 0.f, 0.f, 0.f};
        cur = nxt; cA = nA; cB = nB; ++ui;
        if constexpr (ALIGN_EPI) { if (wr == 1) PG8_BAR; }
    }
    PG8_WAIT_V(0);
    if constexpr (!ALIGN_EPI) { if (wr == 0) PG8_BAR; }
    PG8_BAR;
    if constexpr (Epi::AFTER_DRAIN) { E.fused(acc, cur, wr, wc, fr, fq, lds, wid, lane); S.done(cur); }
#undef PG8_SA
#undef PG8_SB
#undef PG8_STAGE
#undef PG8_LDA
#undef PG8_LDB
#undef PG8_MMA
#undef PG8_WAIT_V
#undef PG8_WAIT_L
#undef PG8_BAR
#undef PG8_SCHED
}
}

#ifndef MK_MULTI
#define MK_MULTI 0
#endif
typedef unsigned short bf16_t;
typedef short bf16x8 __attribute__((ext_vector_type(8)));
typedef float f32x4 __attribute__((ext_vector_type(4)));
typedef float f32x16 __attribute__((ext_vector_type(16)));
typedef unsigned u32x4 __attribute__((ext_vector_type(4)));
typedef unsigned u32x2 __attribute__((ext_vector_type(2)));
typedef float f32x2_t __attribute__((ext_vector_type(2)));
typedef __bf16 bf16x2_t __attribute__((ext_vector_type(2)));
#define LAS __attribute__((address_space(3)))

constexpr int DM = 1024, SEQ = 8192, NB = 2, CTXL = 256, MX = NB * SEQ, MC = NB * CTXL, MT = MX + MC;
constexpr int DFF = 2816, NH = 8, HD = 64, INW = 2048, NMODW = 9 * DM;
constexpr float RMS_EPS = 1e-6f;
constexpr float LOG2E = 1.4426950408889634f;
constexpr float QSCALE = 0.125f * LOG2E;
constexpr int NPHASE = 22;
constexpr int NTHREADS = 512, NWAVES = 8;
constexpr int LDS_BYTES = 147456;

constexpr size_t MiB = 1u << 20;
constexpr size_t WS_MOD = 0;
constexpr size_t WS_ROPEC = 256 * 1024;
constexpr size_t WS_ROPES = 256 * 1024 + 8192;
constexpr size_t WS_BAR = 3 * MiB;
constexpr size_t WS_CTXS = 512 * 1024;
constexpr size_t WS_WGU = 4 * MiB;
constexpr size_t WS_WD = 48 * MiB;
constexpr size_t WS_WIN = 70 * MiB;
constexpr size_t WS_WOUT = 78 * MiB;
constexpr size_t WS_XN = 82 * MiB;
constexpr size_t WS_Y = 115 * MiB;
constexpr size_t WS_XS = 147 * MiB;
constexpr size_t WS_H = 211 * MiB;
constexpr size_t SZ_QK = (size_t)MT * 512 * 2;
constexpr size_t WS_Q = WS_H, WS_K = WS_Q + SZ_QK, WS_U = WS_K + SZ_QK, WS_VT = WS_U + SZ_QK, WS_MIX = WS_VT + SZ_QK;
constexpr size_t WS_YP = WS_MIX + (size_t)MT * 1024 * 2;
constexpr size_t WS_END = WS_YP + (size_t)11 * MC * 1024 * 4;
static_assert(WS_XN + (size_t)MT * 1024 * 2 <= WS_Y && WS_Y + (size_t)MX * 1024 * 2 <= WS_XS && WS_XS + (size_t)MX * 1024 * 4 <= WS_H && WS_H + (size_t)MT * DFF * 2 <= WS_YP, "ws map");

struct Params {
    const float *x, *c, *ctx, *cctx, *wmod, *bmod, *normg, *wgu, *wd, *win, *wout, *rpb, *wpool, *pscale;
    float* out; unsigned char* ws;
};
typedef const __attribute__((address_space(4))) Params* KParams;

__device__ __forceinline__ unsigned cvtpk(float lo, float hi) { f32x2_t v = {lo, hi}; bf16x2_t b = __builtin_convertvector(v, bf16x2_t); return __builtin_bit_cast(unsigned, b); }
__device__ __forceinline__ float bf2f(unsigned short h) { return __uint_as_float(((unsigned)h) << 16); }
__device__ __forceinline__ float wave_sum(float v) {
#pragma unroll
    for (int o = 1; o < 64; o <<= 1) v += __shfl_xor(v, o);
    return v;
}

#define XB_TMO      128
#define XB_XCNT(j)  (256  + 64 * (j))
#define XB_XSUB(j)  (1280 + 64 * (j))
#define XB_XGEN(j)  (2304 + 64 * (j))
#define XB_TOP      3328
#define XB_TOPGEN   3392
#define XCD_BAR_WORDS 3456
#define XB_SPIN_CAP (1u << 18)

__device__ __forceinline__ unsigned xb_ld(unsigned* p)              { return __hip_atomic_load(p, __ATOMIC_RELAXED, __HIP_MEMORY_SCOPE_AGENT); }
__device__ __forceinline__ unsigned xb_add(unsigned* p, unsigned v) { return __hip_atomic_fetch_add(p, v, __ATOMIC_RELAXED, __HIP_MEMORY_SCOPE_AGENT); }
__device__ __forceinline__ unsigned xb_xcc_id() { return (unsigned)__builtin_amdgcn_s_getreg((3 << 11) | 20) & 0xFu; }
#define XB_SPIN(cond, bar) do { unsigned _sp = 0; while (cond) { __builtin_amdgcn_s_sleep(1); \
    if ((++_sp & 255u) == 0u) { if (xb_ld(&(bar)[XB_TMO])) break; if (_sp > XB_SPIN_CAP) { atomicAdd(&(bar)[XB_TMO], 1u); break; } } } } while (0)

struct XcdBarrier {
    unsigned* bar; unsigned x;
    volatile LAS unsigned* st;
};

__device__ __forceinline__ XcdBarrier xcd_barrier_post(unsigned* bar, volatile LAS unsigned* st) {
    XcdBarrier b; b.bar = bar; b.x = xb_xcc_id(); b.st = st;
    if (threadIdx.x == 0) (void)xb_add(&bar[XB_XCNT(b.x)], 1u);
    return b;
}
__device__ __forceinline__ void xcd_barrier_complete(unsigned* bar, unsigned x, unsigned& nloc, unsigned& nx) {
    const unsigned G = gridDim.x * gridDim.y * gridDim.z;
    unsigned sum, cnt, mine, sp = 0u;
    for (;;) {
        sum = 0u; cnt = 0u; mine = 0u;
#pragma unroll
        for (unsigned j = 0; j < 16; ++j) { const unsigned c = xb_ld(&bar[XB_XCNT(j)]); sum += c; cnt += (c > 0u) ? 1u : 0u; mine = (j == x) ? c : mine; }
        if (sum == G) break;
        __builtin_amdgcn_s_sleep(1);
        if ((++sp & 255u) == 0u) { if (xb_ld(&bar[XB_TMO])) break; if (sp > XB_SPIN_CAP) { atomicAdd(&bar[XB_TMO], 1u); break; } }
    }
    nloc = mine > 0u ? mine : 1u; nx = cnt > 0u ? cnt : 1u;
}

__device__ __forceinline__ void xcd_barrier(const XcdBarrier& b) {
    asm volatile("s_waitcnt vmcnt(0)" ::: "memory");
    __syncthreads();
    if (threadIdx.x == 0) {
        unsigned* bar = b.bar;
        __builtin_amdgcn_s_waitcnt(0);
        unsigned nloc = b.st[0], nx = b.st[1];
        if (nloc == 0u) { xcd_barrier_complete(bar, b.x, nloc, nx); b.st[0] = nloc; b.st[1] = nx; }
        const unsigned old = xb_add(&bar[XB_XSUB(b.x)], 1u);
        const unsigned gen = old / nloc;
        if (old + 1u == (gen + 1u) * nloc) {
            __builtin_amdgcn_fence(__ATOMIC_RELEASE, "agent");
            asm volatile("s_waitcnt vmcnt(0)" ::: "memory");
            const unsigned og = xb_add(&bar[XB_TOP], 1u);
            const unsigned tg = og / nx;
            if (og + 1u == (tg + 1u) * nx) xb_add(&bar[XB_TOPGEN], 1u);
            else XB_SPIN(xb_ld(&bar[XB_TOPGEN]) == tg, bar);
            __builtin_amdgcn_fence(__ATOMIC_ACQUIRE, "agent");
            xb_add(&bar[XB_XGEN(b.x)], 1u);
            asm volatile("s_waitcnt vmcnt(0)" ::: "memory");
        } else {
            XB_SPIN(xb_ld(&bar[XB_XGEN(b.x)]) == gen, bar);
            __builtin_amdgcn_fence(__ATOMIC_ACQUIRE, "agent");
            asm volatile("s_waitcnt vmcnt(0)" ::: "memory");
        }
    }
    __syncthreads();
}

using pg8::Unit;
enum { EPI_SWIGLU = 0, EPI_F32 = 1, EPI_QKU = 2, EPI_BF16 = 3 };
struct EpiAny {
    static constexpr bool AFTER_DRAIN = false;
    int mode; bool perm; void* O; int ldc; const float *ropeC, *ropeS; int pstride, ntp;
    __device__ __forceinline__ static float sw(float g, float u) { return g * u * __builtin_amdgcn_rcpf(1.0f + __builtin_amdgcn_exp2f(-g * LOG2E)); }
    __device__ __forceinline__ void operator()(const f32x4 (&acc)[2][2][4][2], const Unit& u, int wr, int wc, int fr, int fq) const {
        if (mode == EPI_SWIGLU) {
            bf16_t* H = (bf16_t*)O;
            const int row0 = u.pm * 256 + wr * 64 + fr, col0 = u.pn * 128 + wc * 32 + 8 * fq;
#pragma unroll
            for (int ai = 0; ai < 2; ++ai)
#pragma unroll
                for (int m = 0; m < 4; ++m) {
                    bf16_t* p = H + (size_t)(row0 + ai * 128 + m * 16) * DFF + col0;
                    const f32x4 g0 = acc[ai][0][m][0], g1 = acc[ai][0][m][1], u0 = acc[ai][1][m][0], u1 = acc[ai][1][m][1];
                    f32x4 e0 = g0 * (-LOG2E), e1 = g1 * (-LOG2E);
#pragma unroll
                    for (int i = 0; i < 4; ++i) { e0[i] = __builtin_amdgcn_exp2f(e0[i]); e1[i] = __builtin_amdgcn_exp2f(e1[i]); }
                    e0 = e0 + 1.0f; e1 = e1 + 1.0f;
#pragma unroll
                    for (int i = 0; i < 4; ++i) { e0[i] = __builtin_amdgcn_rcpf(e0[i]); e1[i] = __builtin_amdgcn_rcpf(e1[i]); }
                    const f32x4 o0 = (g0 * u0) * e0, o1 = (g1 * u1) * e1;
                    u32x4 w; w.x = cvtpk(o0[0], o0[1]); w.y = cvtpk(o0[2], o0[3]); w.z = cvtpk(o1[0], o1[1]); w.w = cvtpk(o1[2], o1[3]);
                    *(u32x4*)p = w;
                }
        } else if (mode == EPI_F32) {
            float* Y = (float*)O + ((ntp > 0) ? (size_t)(u.kb / ntp) * (size_t)pstride : (size_t)0);
            const int row0 = u.pm * 256 + wr * 64 + fr, col0 = u.pn * 256 + wc * 32 + 4 * fq;
#pragma unroll
            for (int ai = 0; ai < 2; ++ai)
#pragma unroll
                for (int m = 0; m < 4; ++m) {
                    float* p = Y + (size_t)(row0 + ai * 128 + m * 16) * ldc + col0;
#pragma unroll
                    for (int bj = 0; bj < 2; ++bj)
#pragma unroll
                        for (int n = 0; n < 2; ++n) *(f32x4*)(p + bj * 128 + n * 16) = acc[ai][bj][m][n];
                }
        } else if (mode == EPI_QKU) {
            const int t = u.pn >> 1; bf16_t* base = (bf16_t*)O + (size_t)t * ((size_t)MT * 512);
            const float sc = (t == 0) ? QSCALE : 1.0f;
            const bool rope = (t < 2) && (u.pm < MX / 256);
            const int cb = (u.pn & 1) * 256 + wc * 32 + 4 * fq;
#pragma unroll
            for (int ai = 0; ai < 2; ++ai)
#pragma unroll
                for (int m = 0; m < 4; ++m) {
                    const int row = u.pm * 256 + ai * 128 + wr * 64 + m * 16 + fr;
                    bf16_t* p = base + (size_t)row * 512 + cb;
                    f32x4 c4 = {1.f, 1.f, 1.f, 1.f}, s4 = {0.f, 0.f, 0.f, 0.f};
                    if (rope) { const int s = row & (SEQ - 1); const int pos = (wc & 1) ? (s & 63) : (s >> 6);
                        c4 = *(const f32x4*)(ropeC + pos * 16 + 4 * fq); s4 = *(const f32x4*)(ropeS + pos * 16 + 4 * fq); }
#pragma unroll
                    for (int bj = 0; bj < 2; ++bj) {
                        const f32x4 x1 = acc[ai][bj][m][0], x2 = acc[ai][bj][m][1];
                        const f32x4 o1 = (x1 * c4 - x2 * s4) * sc, o2 = (x2 * c4 + x1 * s4) * sc;
                        u32x2 w1, w2; w1.x = cvtpk(o1[0], o1[1]); w1.y = cvtpk(o1[2], o1[3]); w2.x = cvtpk(o2[0], o2[1]); w2.y = cvtpk(o2[2], o2[3]);
                        *(u32x2*)(p + bj * 128) = w1; *(u32x2*)(p + bj * 128 + 16) = w2;
                    }
                }
        } else {
            bf16_t* Ob = (bf16_t*)O;
            const int row0 = u.pm * 256 + wr * 64 + fr, col0 = u.pn * 256 + wc * 32 + 8 * fq;
#pragma unroll
            for (int ai = 0; ai < 2; ++ai)
#pragma unroll
                for (int m = 0; m < 4; ++m) {
                    bf16_t* p = Ob + (size_t)(row0 + ai * 128 + m * 16) * ldc + col0;
#pragma unroll
                    for (int bj = 0; bj < 2; ++bj) { const f32x4 v0 = acc[ai][bj][m][0], v1 = acc[ai][bj][m][1];
                        u32x4 w; w.x = cvtpk(v0[0], v0[1]); w.y = cvtpk(v0[2], v0[3]); w.z = cvtpk(v1[0], v1[1]); w.w = cvtpk(v1[2], v1[3]);
                        *(u32x4*)(p + bj * 128) = w; }
                }
        }
    }
};

__device__ __forceinline__ void p0_transpose_item(const float* W, int ldw, int k0, int n0, bf16_t* WT, int ldt, int dst_row0, LAS unsigned char* scr, int lane) {
    f32x4 v[16];
    const float* src = W + (size_t)(k0 + (lane >> 4)) * ldw + n0 + 4 * (lane & 15);
#pragma unroll
    for (int i = 0; i < 16; ++i) v[i] = __builtin_nontemporal_load((const f32x4*)(src + (size_t)(4 * i) * ldw));
#pragma unroll
    for (int i = 0; i < 16; ++i) { LAS unsigned* p = (LAS unsigned*)(scr + (4 * i + (lane >> 4)) * 132 + 8 * (lane & 15)); p[0] = cvtpk(v[i][0], v[i][1]); p[1] = cvtpk(v[i][2], v[i][3]); }
    asm volatile("s_waitcnt lgkmcnt(0)" ::: "memory");
    const int c = lane & 7;
#pragma unroll
    for (int j = 0; j < 4; ++j) { const int np = (lane >> 3) + 8 * j; unsigned w[8];
#pragma unroll
        for (int i = 0; i < 8; ++i) w[i] = *(const LAS unsigned*)(scr + (8 * c + i) * 132 + 4 * np);
        u32x4 lo, hi;
        lo.x = (w[0] & 0xffffu) | (w[1] << 16); lo.y = (w[2] & 0xffffu) | (w[3] << 16); lo.z = (w[4] & 0xffffu) | (w[5] << 16); lo.w = (w[6] & 0xffffu) | (w[7] << 16);
        hi.x = (w[0] >> 16) | (w[1] & 0xffff0000u); hi.y = (w[2] >> 16) | (w[3] & 0xffff0000u); hi.z = (w[4] >> 16) | (w[5] & 0xffff0000u); hi.w = (w[6] >> 16) | (w[7] & 0xffff0000u);
        *(u32x4*)(WT + (size_t)(dst_row0 + 2 * np) * ldt + k0 + 8 * c) = lo;
        *(u32x4*)(WT + (size_t)(dst_row0 + 2 * np + 1) * ldt + k0 + 8 * c) = hi; }
    asm volatile("s_waitcnt lgkmcnt(0)" ::: "memory");
}

__device__ __forceinline__ void phase_p0(KParams P, LAS unsigned char* lds, int tid, int wave, int lane, int bx, int G) {
    unsigned char* ws = P->ws;
    float* MOD = (float*)(ws + WS_MOD);
    const int gt = bx * NTHREADS + tid;
    if (gt < 2048) {
        const int pos = gt >> 4, i = gt & 15;
        const float inv = exp2f(-(float)i * 0.83048202372184058696f);
        const float angf = (float)pos * inv;
        const double a = (double)angf; const double kq = rint(a * 0.63661977236758134308); const double r = a - kq * 1.57079632679489661923; const double r2 = r * r;
        double sr = r, cr = 1.0, ts = r, tc = 1.0;
#pragma unroll 1
        for (int k = 1; k <= 8; ++k) { const double k2 = (double)(2 * k); tc *= -r2 / (k2 * (k2 - 1.0)); ts *= -r2 / (k2 * (k2 + 1.0)); cr += tc; sr += ts; }
        const int q = ((int)kq) & 3;
        const double cv = (q == 0) ? cr : (q == 1) ? -sr : (q == 2) ? -cr : sr;
        const double sv = (q == 0) ? sr : (q == 1) ? cr : (q == 2) ? -sr : -cr;
        ((float*)(ws + WS_ROPEC))[gt] = (float)cv; ((float*)(ws + WS_ROPES))[gt] = (float)sv;
    }
    constexpr int J_MOD = 72, J_FOLD = 128, J_TR = 1216, NJOBS = J_MOD + J_FOLD + J_TR;
    unsigned* jq = (unsigned*)(ws + WS_BAR + 32768);
    LAS int* jb = (LAS int*)(lds + 131072 + 128);
    for (;;) {
        if (tid == 0) *jb = (int)__hip_atomic_fetch_add(jq, 1u, __ATOMIC_RELAXED, __HIP_MEMORY_SCOPE_AGENT);
        __syncthreads();
        const int job = *jb;
        __syncthreads();
        if (job >= NJOBS) break;
        if (job < J_MOD) {
            LAS float* sc = (LAS float*)lds;
            LAS float* red = sc + 3072;
            for (int i = tid; i < 3072; i += NTHREADS) { const int who = i >> 10, k = i & 1023; const float v = (who < 2) ? P->c[who * 1024 + k] : P->cctx[k]; sc[i] = v / (1.0f + __expf(-v)); }
            __syncthreads();
            const int l = job / 36, cc = job % 36, col = cc * 256 + 4 * lane;
            const float* W = P->wmod + ((size_t)l * 1024 + wave * 128) * NMODW + col;
            f32x4 a0 = {0.f, 0.f, 0.f, 0.f}, a1 = a0, a2 = a0;
#pragma unroll 16
            for (int k = 0; k < 128; ++k) { const f32x4 w = __builtin_nontemporal_load((const f32x4*)(W + (size_t)k * NMODW)); const int kk = wave * 128 + k; a0 += w * sc[kk]; a1 += w * sc[1024 + kk]; a2 += w * sc[2048 + kk]; }
            *(LAS f32x4*)(red + (wave * 3 + 0) * 256 + 4 * lane) = a0; *(LAS f32x4*)(red + (wave * 3 + 1) * 256 + 4 * lane) = a1; *(LAS f32x4*)(red + (wave * 3 + 2) * 256 + 4 * lane) = a2;
            __syncthreads();
            for (int o = tid; o < 768; o += NTHREADS) { const int who = o >> 8, cl = o & 255; float s = 0.f;
#pragma unroll
                for (int w = 0; w < 8; ++w) s += red[(w * 3 + who) * 256 + cl];
                MOD[(size_t)(l * 3 + who) * NMODW + cc * 256 + cl] = s + P->bmod[l * NMODW + cc * 256 + cl]; }
            __syncthreads();
        } else if (job < J_MOD + J_FOLD) {
            const int r = job - J_MOD, nb = r & 15, g = (r >> 4) & 3, l = r >> 6;
            LAS float* A = (LAS float*)lds;
            LAS float* B = (LAS float*)(lds + 128 * 132 * 4);
            LAS bf16_t* OT = (LAS bf16_t*)(lds + 128 * 132 * 4 + 128 * 64 * 4);
            const float* wp = P->wpool + (size_t)(l * 4 + g) * 128 * 128; const float* ps = P->pscale + l * 512 + g * 128;
            const float* wo = P->wout + ((size_t)l * 1024 + 512 + g * 128) * 1024 + nb * 64;
#pragma unroll 8
            for (int i = 0; i < 32; ++i) { const int idx = tid + NTHREADS * i, c = idx >> 7, d = idx & 127; A[c * 132 + d] = wp[idx] * ps[d]; }
#pragma unroll 8
            for (int i = 0; i < 16; ++i) { const int idx = tid + NTHREADS * i, d = idx >> 6, n = idx & 63; B[idx] = wo[(size_t)d * 1024 + n]; }
            __syncthreads();
            const int c = tid >> 2, nq = tid & 3;
            f32x4 acc[4];
#pragma unroll
            for (int j = 0; j < 4; ++j) acc[j] = (f32x4){0.f, 0.f, 0.f, 0.f};
#pragma unroll 4
            for (int d = 0; d < 128; ++d) { const float a = A[c * 132 + d];
#pragma unroll
                for (int j = 0; j < 4; ++j) acc[j] += *(const LAS f32x4*)(B + d * 64 + 16 * nq + 4 * j) * a; }
#pragma unroll
            for (int j = 0; j < 4; ++j)
#pragma unroll
                for (int e = 0; e < 4; ++e) OT[(16 * nq + 4 * j + e) * 128 + c] = (bf16_t)(cvtpk(acc[j][e], 0.f) & 0xffffu);
            __syncthreads();
            bf16_t* dst = (bf16_t*)(ws + WS_WOUT) + ((size_t)l * 1024 + nb * 64) * 1024 + 512 + g * 128;
#pragma unroll
            for (int i = 0; i < 2; ++i) { const int ch = tid + NTHREADS * i, n = ch >> 4, cc8 = ch & 15; *(u32x4*)(dst + (size_t)n * 1024 + cc8 * 8) = *(const LAS u32x4*)(OT + n * 128 + cc8 * 8); }
            __syncthreads();
        } else {
            LAS unsigned char* scr = lds + wave * 8448;
            int tj = job - J_MOD - J_FOLD; const int wk = wave >> 2, wn = wave & 3;
            if (tj < 704) { const int ls = tj / 176, r = tj % 176, kb = r / 22, nb = r % 22, k0 = kb * 128 + wk * 64, n0 = nb * 256 + wn * 64;
                const int cidx = (n0 < DFF) ? n0 : n0 - DFF; const int drow = 256 * (cidx >> 7) + (cidx & 127) + ((n0 < DFF) ? 0 : 128);
                p0_transpose_item(P->wgu + (size_t)ls * 1024 * 5632, 5632, k0, n0, (bf16_t*)(ws + WS_WGU) + (size_t)ls * 5632 * 1024, 1024, drow, scr, lane); }
            else if ((tj -= 704) < 352) { const int ls = tj / 88, r = tj % 88, kb = r / 4, nb = r % 4, k0 = kb * 128 + wk * 64, n0 = nb * 256 + wn * 64;
                p0_transpose_item(P->wd + (size_t)ls * DFF * 1024, 1024, k0, n0, (bf16_t*)(ws + WS_WD) + (size_t)ls * 1024 * DFF, DFF, n0, scr, lane); }
            else if ((tj -= 352) < 128) { const int l = tj / 64, r = tj % 64, kb = r / 8, nb = r % 8, k0 = kb * 128 + wk * 64, n0 = nb * 256 + wn * 64;
                const int drow = (n0 < 1024) ? n0 : (n0 < 1536) ? n0 + 512 : n0 - 512;
                p0_transpose_item(P->win + (size_t)l * 1024 * INW, INW, k0, n0, (bf16_t*)(ws + WS_WIN) + (size_t)l * INW * 1024, 1024, drow, scr, lane); }
            else { tj -= 128; const int l = tj / 16, r = tj % 16, kb = r / 4, nb = r % 4, k0 = kb * 128 + wk * 64, n0 = nb * 256 + wn * 64;
                p0_transpose_item(P->wout + (size_t)l * 1024 * 1024, 1024, k0, n0, (bf16_t*)(ws + WS_WOUT) + (size_t)l * 1024 * 1024, 1024, n0, scr, lane); }
        }
    }
}

struct RowPass {
    const float *srcX, *srcC; float *dstX, *dstC; const bf16_t* srcXb; bf16_t* dstXb;
    const bf16_t* Yb; const float *gate, *gpost; float coef;
    const float *shift, *scale, *gpre; bf16_t* XN;
    int M; bool hasY, hasXN; const float* YP; int nparts;
};
template <int RPT> __device__ __forceinline__ void row_range(const RowPass& R, int lane, int gw, int NGW, int mlo, int mhi) {
    for (int m0 = mlo + RPT * gw; m0 < mhi; m0 += RPT * NGW) {
        const int who = (m0 < SEQ) ? 0 : (m0 < MX) ? 1 : 2;
        const bool isx = m0 < MX;
        f32x4 v[RPT][4];
#pragma unroll
        for (int rr = 0; rr < RPT; ++rr) { const int m = m0 + rr;
            if (isx && R.srcXb) {
#pragma unroll
                for (int j = 0; j < 4; ++j) { const u32x2 w = __builtin_nontemporal_load((const u32x2*)(R.srcXb + (size_t)m * DM + 4 * lane + 256 * j));
                    v[rr][j] = (f32x4){__uint_as_float(w.x << 16), __uint_as_float(w.x & 0xffff0000u), __uint_as_float(w.y << 16), __uint_as_float(w.y & 0xffff0000u)}; }
            } else { const float* xin = isx ? R.srcX + (size_t)m * DM : R.srcC + (size_t)(m - MX) * DM;
#pragma unroll
                for (int j = 0; j < 4; ++j) v[rr][j] = __builtin_nontemporal_load((const f32x4*)(xin + 4 * lane + 256 * j)); } }
        if (R.hasY) {
            f32x4 y[RPT][4]; float ss[RPT];
#pragma unroll
            for (int rr = 0; rr < RPT; ++rr) ss[rr] = 0.f;
#pragma unroll
            for (int rr = 0; rr < RPT; ++rr) { const int m = m0 + rr;
#pragma unroll
                for (int j = 0; j < 4; ++j) {
                    if (isx) { const u32x2 w = __builtin_nontemporal_load((const u32x2*)(R.Yb + (size_t)m * DM + 4 * lane + 256 * j));
                        y[rr][j] = (f32x4){__uint_as_float(w.x << 16), __uint_as_float(w.x & 0xffff0000u), __uint_as_float(w.y << 16), __uint_as_float(w.y & 0xffff0000u)}; }
                    else { f32x4 tp[11];
#pragma unroll
                        for (int p = 0; p < 11; ++p) tp[p] = *(const f32x4*)(R.YP + ((size_t)min(p, R.nparts - 1) * MC + (m - MX)) * DM + 4 * lane + 256 * j);
                        f32x4 t = tp[0];
#pragma unroll
                        for (int p = 1; p < 11; ++p) t += tp[p] * ((p < R.nparts) ? 1.0f : 0.0f);
                        y[rr][j] = t; }
                    ss[rr] += (y[rr][j].x * y[rr][j].x + y[rr][j].y * y[rr][j].y) + (y[rr][j].z * y[rr][j].z + y[rr][j].w * y[rr][j].w); } }
#pragma unroll
            for (int rr = 0; rr < RPT; ++rr) ss[rr] = wave_sum(ss[rr]);
#pragma unroll
            for (int rr = 0; rr < RPT; ++rr) { const int m = m0 + rr;
                const float rs = rsqrtf(ss[rr] * (1.0f / DM) + RMS_EPS) * R.coef;
#pragma unroll
                for (int j = 0; j < 4; ++j) { const int col = 4 * lane + 256 * j; const f32x4 gt = *(const f32x4*)(R.gate + who * NMODW + col), gp = *(const f32x4*)(R.gpost + col);
                    v[rr][j] = v[rr][j] + gt * (y[rr][j] * rs * gp); }
                if (isx && R.dstXb) {
#pragma unroll
                    for (int j = 0; j < 4; ++j) { u32x2 w; w.x = cvtpk(v[rr][j][0], v[rr][j][1]); w.y = cvtpk(v[rr][j][2], v[rr][j][3]); *(u32x2*)(R.dstXb + (size_t)m * DM + 4 * lane + 256 * j) = w;
                        v[rr][j] = (f32x4){__uint_as_float(w.x << 16), __uint_as_float(w.x & 0xffff0000u), __uint_as_float(w.y << 16), __uint_as_float(w.y & 0xffff0000u)}; }
                } else { float* xo = isx ? R.dstX + (size_t)m * DM : R.dstC + (size_t)(m - MX) * DM;
#pragma unroll
                    for (int j = 0; j < 4; ++j) *(f32x4*)(xo + 4 * lane + 256 * j) = v[rr][j]; } }
        }
        if (R.hasXN) {
            float ss[RPT];
#pragma unroll
            for (int rr = 0; rr < RPT; ++rr) ss[rr] = 0.f;
#pragma unroll
            for (int rr = 0; rr < RPT; ++rr)
#pragma unroll
                for (int j = 0; j < 4; ++j) ss[rr] += (v[rr][j].x * v[rr][j].x + v[rr][j].y * v[rr][j].y) + (v[rr][j].z * v[rr][j].z + v[rr][j].w * v[rr][j].w);
#pragma unroll
            for (int rr = 0; rr < RPT; ++rr) ss[rr] = wave_sum(ss[rr]);
#pragma unroll
            for (int rr = 0; rr < RPT; ++rr) { const int m = m0 + rr;
                const float rs = rsqrtf(ss[rr] * (1.0f / DM) + RMS_EPS);
#pragma unroll
                for (int j = 0; j < 4; ++j) { const int col = 4 * lane + 256 * j;
                    const f32x4 gp = *(const f32x4*)(R.gpre + col), sh = *(const f32x4*)(R.shift + who * NMODW + col), sc = *(const f32x4*)(R.scale + who * NMODW + col);
                    const f32x4 o = (v[rr][j] * rs * gp) * (sc + 1.0f) + sh;
                    u32x2 w; w.x = cvtpk(o[0], o[1]); w.y = cvtpk(o[2], o[3]);
                    *(u32x2*)(R.XN + (size_t)m * DM + col) = w; } }
        }
    }
}

__device__ __forceinline__ void phase_row(const RowPass& R, int wave, int lane, int bx, int G) {
    const int gw = bx * NWAVES + wave, NGW = G * NWAVES;
    row_range<4>(R, lane, gw, NGW, 0, (R.M < MX) ? R.M : MX);
    if (R.M > MX) row_range<2>(R, lane, NGW - 1 - gw, NGW, MX, R.M);
}

#define MFMA32(a, b, c) __builtin_amdgcn_mfma_f32_32x32x16_bf16((a), (b), (c), 0, 0, 0)
struct KFrag { bf16x8 k[4]; };
struct VFrag { bf16x8 v[4]; };
__device__ __forceinline__ void attn_loadk(KFrag& f, const bf16_t* kbase, int krow0) {
    const bf16_t* kp = kbase + (size_t)krow0 * 512;
#pragma unroll
    for (int dk = 0; dk < 4; ++dk) f.k[dk] = *(const bf16x8*)(kp + dk * 16);
}
__device__ __forceinline__ void attn_loadv(VFrag& f, const bf16_t* vbase, int krow0) {
    const bf16_t* vp = vbase + krow0;
    f.v[0] = *(const bf16x8*)(vp); f.v[1] = *(const bf16x8*)(vp + 16); f.v[2] = *(const bf16x8*)(vp + (size_t)32 * MT); f.v[3] = *(const bf16x8*)(vp + (size_t)32 * MT + 16);
}
constexpr int KL_OFF = 32768, KL_PITCH = 144, VL_OFF = KL_OFF + 256 * KL_PITCH, VL_PITCH = 528;
__device__ __forceinline__ void attn_loadk_lds(KFrag& f, const LAS unsigned char* kl, int t) {
    const LAS unsigned char* p = kl + t * (32 * KL_PITCH);
#pragma unroll
    for (int dk = 0; dk < 4; ++dk) f.k[dk] = *(const LAS bf16x8*)(p + dk * 32);
}
__device__ __forceinline__ void attn_loadv_lds(VFrag& f, const LAS unsigned char* vl, int t) {
    const LAS unsigned char* p = vl + t * 64;
    f.v[0] = *(const LAS bf16x8*)(p); f.v[1] = *(const LAS bf16x8*)(p + 32); f.v[2] = *(const LAS bf16x8*)(p + 32 * VL_PITCH); f.v[3] = *(const LAS bf16x8*)(p + 32 * VL_PITCH + 32);
}
__device__ __forceinline__ void attn_soft(f32x16& S, f32x16& o0, f32x16& o1, float& mrun, float& lrun, bool masked, const LAS float* bt, int relb, int idxb, bf16x8& pb0, bf16x8& pb1) {
    if (masked) {
        const LAS float* bp = bt + idxb;
        float bv[16];
#pragma unroll
        for (int r = 0; r < 16; ++r) bv[r] = bp[16 * (r >> 3) + (r & 7)];
#pragma unroll
        for (int r = 0; r < 16; ++r) {
            const int off = 16 * (r >> 3) + (r & 7);
            const bool valid = (unsigned)(relb + off) < 16u;
            S[r] = valid ? S[r] + bv[r] : -1e30f;
        }
    }
    float tm = S[0];
#pragma unroll
    for (int r = 1; r < 16; ++r) tm = fmaxf(tm, S[r]);
    tm = fmaxf(tm, __shfl_xor(tm, 32));
    if (__any(tm > mrun)) {
        const float mn = fmaxf(mrun, tm);
        const float fs = __builtin_amdgcn_exp2f(mrun - mn);
        mrun = mn; lrun *= fs;
#pragma unroll
        for (int r = 0; r < 16; ++r) { o0[r] *= fs; o1[r] *= fs; }
    }
    float ps = 0.f;
#pragma unroll
    for (int r = 0; r < 16; ++r) { S[r] = __builtin_amdgcn_exp2f(S[r] - mrun); ps += S[r]; }
    lrun += ps;
    u32x4 w0, w1;
    w0.x = cvtpk(S[0], S[1]); w0.y = cvtpk(S[2], S[3]); w0.z = cvtpk(S[4], S[5]); w0.w = cvtpk(S[6], S[7]);
    w1.x = cvtpk(S[8], S[9]); w1.y = cvtpk(S[10], S[11]); w1.z = cvtpk(S[12], S[13]); w1.w = cvtpk(S[14], S[15]);
    pb0 = __builtin_bit_cast(bf16x8, w0); pb1 = __builtin_bit_cast(bf16x8, w1);
}
struct AttnState { f32x16 o0, o1; float m, l; };
__device__ __forceinline__ void attn_comp2(KFrag& fk, const VFrag& f, const bf16x8 (&qa)[4], const bf16x8 (&qb)[4], AttnState& A, AttnState& B,
                                           bool masked, const LAS float* bt, int relA, int idxA, int relB, int idxB, const bf16_t* kbase, int nextrow, const LAS unsigned char* kl, int nextlds) {
    f32x16 SA, SB;
#pragma unroll
    for (int r = 0; r < 16; ++r) { SA[r] = 0.f; SB[r] = 0.f; }
#pragma unroll
    for (int dk = 0; dk < 4; ++dk) { SA = MFMA32(fk.k[dk], qa[dk], SA); SB = MFMA32(fk.k[dk], qb[dk], SB); }
    if (nextlds >= 0) attn_loadk_lds(fk, kl, nextlds);
    else if (nextrow >= 0) attn_loadk(fk, kbase, nextrow);
    bf16x8 p0, p1;
    attn_soft(SA, A.o0, A.o1, A.m, A.l, masked, bt, relA, idxA, p0, p1);
    A.o0 = MFMA32(f.v[0], p0, A.o0); A.o0 = MFMA32(f.v[1], p1, A.o0); A.o1 = MFMA32(f.v[2], p0, A.o1); A.o1 = MFMA32(f.v[3], p1, A.o1);
    attn_soft(SB, B.o0, B.o1, B.m, B.l, masked, bt, relB, idxB, p0, p1);
    B.o0 = MFMA32(f.v[0], p0, B.o0); B.o0 = MFMA32(f.v[1], p1, B.o0); B.o1 = MFMA32(f.v[2], p0, B.o1); B.o1 = MFMA32(f.v[3], p1, B.o1);
}
__device__ __forceinline__ void attn_store(const AttnState& A, bf16_t* op) {
    const float lt = A.l + __shfl_xor(A.l, 32);
    const float inv = 1.0f / lt;
#pragma unroll
    for (int g4 = 0; g4 < 4; ++g4) {
        u32x2 w; w.x = cvtpk(A.o0[4 * g4] * inv, A.o0[4 * g4 + 1] * inv); w.y = cvtpk(A.o0[4 * g4 + 2] * inv, A.o0[4 * g4 + 3] * inv); *(u32x2*)(op + 8 * g4) = w;
        u32x2 z; z.x = cvtpk(A.o1[4 * g4] * inv, A.o1[4 * g4 + 1] * inv); z.y = cvtpk(A.o1[4 * g4 + 2] * inv, A.o1[4 * g4 + 3] * inv); *(u32x2*)(op + 32 + 8 * g4) = z;
    }
}

__device__ __forceinline__ void phase_mix(KParams P, int layer, LAS unsigned char* lds, int tid, int wave, int lane, int bx, int G) {
    unsigned char* ws = P->ws;
    const bf16_t* Qb = (const bf16_t*)(ws + WS_Q); const bf16_t* Kb = (const bf16_t*)(ws + WS_K); const bf16_t* Ub = (const bf16_t*)(ws + WS_U);
    const bf16_t* Vt = (const bf16_t*)(ws + WS_VT); bf16_t* MIXb = (bf16_t*)(ws + WS_MIX);
    LAS float* bt = (LAS float*)(lds + wave * 2560) + 64;
    const int vb = (G % 8 == 0) ? (bx % 8) * (G / 8) + bx / 8 : bx;
    const int gw = vb * NWAVES + wave, NGW = G * NWAVES;
    const int q = lane & 31, hi = lane >> 5, pi = (q & 0x13) | ((q & 4) << 1) | ((q & 8) >> 1);
    const int nunits = 2048 + ((layer == 0) ? 64 : 0);
    for (int un = gw; un < nunits; un += NGW) {
        int b, h, qrow0, r = 0; const bool local = un < 2048;
        if (local) { r = un & 127; h = (un >> 7) & 7; b = un >> 10; qrow0 = b * SEQ + r * 64; }
        else { const int v = un - 2048; const int qb = v & 3; h = (v >> 2) & 7; b = v >> 5; qrow0 = MX + b * CTXL + qb * 64; }
        if (local) {
            const float* rp = P->rpb + (size_t)(layer * NH + h) * 465;
            for (int i = lane; i < 465; i += 64) bt[i] = rp[i] * LOG2E;
        }
        const int crow0 = MX + b * CTXL;
        if (local) {
            const bf16_t* ksrc = Kb + (size_t)crow0 * 512 + h * 64; const bf16_t* vsrc = Vt + (size_t)(h * 64) * MT + crow0;
#pragma unroll
            for (int i = 0; i < 4; ++i) { const int c = tid + NTHREADS * i;
                *(LAS u32x4*)(lds + KL_OFF + (c >> 3) * KL_PITCH + (c & 7) * 16) = *(const u32x4*)(ksrc + (size_t)(c >> 3) * 512 + (c & 7) * 8);
                *(LAS u32x4*)(lds + VL_OFF + (c >> 5) * VL_PITCH + (c & 31) * 16) = *(const u32x4*)(vsrc + (size_t)(c >> 5) * MT + (c & 31) * 8); }
            __syncthreads();
        }
        const LAS unsigned char* kl = lds + KL_OFF + pi * KL_PITCH + hi * 16; const LAS unsigned char* vl = lds + VL_OFF + q * VL_PITCH + hi * 16;
        bf16x8 qa[4], qb4[4];
#pragma unroll
        for (int dk = 0; dk < 4; ++dk) { qa[dk] = *(const bf16x8*)(Qb + (size_t)(qrow0 + q) * 512 + h * 64 + dk * 16 + hi * 8);
                                         qb4[dk] = *(const bf16x8*)(Qb + (size_t)(qrow0 + 32 + q) * 512 + h * 64 + dk * 16 + hi * 8); }
        AttnState A, B;
#pragma unroll
        for (int i = 0; i < 16; ++i) { A.o0[i] = 0.f; A.o1[i] = 0.f; B.o0[i] = 0.f; B.o1[i] = 0.f; }
        A.m = -1e30f; A.l = 0.f; B.m = -1e30f; B.l = 0.f;
        const int rs = min(max(r - 4, 0), 120);
        const int jA = q, jB = 32 + q, csA = min(max(jA - 8, 0), 48), csB = min(max(jB - 8, 0), 48);
        const int lrow0 = b * SEQ + rs * 64;
        const bf16_t* kbase = Kb + (size_t)pi * 512 + h * 64 + hi * 8;
        const bf16_t* vbase = Vt + (size_t)(h * 64 + q) * MT + hi * 8;
        const int ntiles = local ? 24 : 8;
#define TROW(t) (((t) < 8) ? crow0 + 32 * (t) : lrow0 + 32 * ((t) - 8))
#define TCOMP(FK, FV, t, NXT) do { const int t_ = (t); const int kr_ = (t_ - 8) >> 1, ct_ = (t_ - 8) & 1; const int br_ = (rs + kr_ - r + 7) * 31 + ct_ * 32 + 8 * hi + 15; \
            int ra_ = ct_ * 32 + 8 * hi - csA, rb_ = ct_ * 32 + 8 * hi - csB; asm volatile("" : "+v"(ra_), "+v"(rb_));     \
            attn_comp2(FK, FV, qa, qb4, A, B, t_ >= 8, bt, ra_, br_ - jA, rb_, br_ - jB, kbase, (NXT), kl, (local && t_ + 1 < 8) ? t_ + 1 : -1); } while (0)
        KFrag k0; VFrag fv;
        if (local) attn_loadk_lds(k0, kl, 0); else attn_loadk(k0, kbase, TROW(0));
        asm volatile("s_waitcnt lgkmcnt(0)" ::: "memory");
        for (int t = 0; t < ntiles; ++t) {
            if (local && t < 8) attn_loadv_lds(fv, vl, t); else attn_loadv(fv, vbase, TROW(t));
            TCOMP(k0, fv, t, (t + 1 < ntiles) ? TROW(t + 1) : -1);
        }
#undef TROW
#undef TCOMP
        attn_store(A, MIXb + (size_t)(qrow0 + q) * 1024 + h * 64 + 4 * hi);
        attn_store(B, MIXb + (size_t)(qrow0 + 32 + q) * 1024 + h * 64 + 4 * hi);
        asm volatile("s_waitcnt lgkmcnt(0)" ::: "memory");
    }
    const int mrows = (layer == 0) ? MT : MX;
    const int nskip = (layer == 0) ? 64 : 0;
    if (gw < nskip) return;
    for (int wi = gw - nskip; wi < mrows; wi += NGW - nskip) {
        const int g = wi & 3, m = (wi & ~3) + (lane >> 4), ch = g * 16 + (lane & 15);
        int jj, len;
        if (m < MX) { jj = m & 63; len = 64; } else { jj = (m - MX) & 255; len = 256; }
        const int base = m - jj;
        float a[8];
#pragma unroll
        for (int e = 0; e < 8; ++e) a[e] = 0.f;
        const bf16_t* up = Ub + (size_t)base * 512 + ch * 8;
#define POOLW(W2) do { const int lo = max(jj - (W2), 0), hi2 = min(jj + (W2), len); u32x4 uv[2 * (W2)]; \
            _Pragma("unroll") for (int t = 0; t < 2 * (W2); ++t) uv[t] = *(const u32x4*)(up + (size_t)min(lo + t, hi2 - 1) * 512); \
            _Pragma("unroll") for (int t = 0; t < 2 * (W2); ++t) { const float wgt = (lo + t < hi2) ? 1.0f : 0.0f; \
                _Pragma("unroll") for (int e = 0; e < 4; ++e) { a[2 * e] += wgt * __uint_as_float(uv[t][e] << 16); a[2 * e + 1] += wgt * __uint_as_float(uv[t][e] & 0xffff0000u); } } \
            const float ic = 1.0f / (float)(hi2 - lo); _Pragma("unroll") for (int e = 0; e < 8; ++e) a[e] *= ic; } while (0)
        if (g == 0) POOLW(1); else if (g == 1) POOLW(2); else if (g == 2) POOLW(4); else POOLW(8);
#undef POOLW
        const u32x4 us = *(const u32x4*)(Ub + (size_t)m * 512 + ch * 8);
        u32x4 o;
#pragma unroll
        for (int e = 0; e < 4; ++e) o[e] = cvtpk(a[2 * e] - __uint_as_float(us[e] << 16), a[2 * e + 1] - __uint_as_float(us[e] & 0xffff0000u));
        *(u32x4*)(MIXb + (size_t)m * 1024 + 512 + ch * 8) = o;
    }
}

__device__ __forceinline__ void run_phase(KParams P, int ph, LAS unsigned char* lds, int tid, int wave, int lane, int bx, int G) {
    unsigned char* ws = P->ws;
    float* MOD = (float*)(ws + WS_MOD);
    bf16_t* XN = (bf16_t*)(ws + WS_XN); bf16_t* Yb = (bf16_t*)(ws + WS_Y); bf16_t* H = (bf16_t*)(ws + WS_H);
    float* CTXS = (float*)(ws + WS_CTXS);
    if (ph == 0) { phase_p0(P, lds, tid, wave, lane, bx, G); return; }
    const int l = (ph == NPHASE - 1) ? 2 : (ph - 1) / 10, s = (ph == NPHASE - 1) ? 0 : (ph - 1) % 10;
    const int Mlate = (l == 1) ? MX : MT;
    if (s == 0 || s == 3 || s == 7) {
        int yl = l, gidx = 5, gpi = 3, nl = l, npre = 4, nsh = 6, M = Mlate; bool hasY = true, hasXN = true, useIn = false; float coef = 1.0f;
        if (s == 0) { yl = (l > 0) ? l - 1 : 0; gidx = 8; gpi = 5; npre = 0; nsh = 0; M = MT; coef = 0.5f; hasY = (l > 0); useIn = (l == 0);
                      if (l == 2) { hasXN = false; M = MX; nl = 1; } }
        else if (s == 3) { gidx = 2; gpi = 1; npre = 2; nsh = 3; M = MT; coef = 0.5f; useIn = (l == 0); }
        RowPass R;
        R.srcX = P->x; R.srcXb = useIn ? (const bf16_t*)nullptr : (const bf16_t*)(ws + WS_XS); R.srcC = useIn ? P->ctx : (const float*)CTXS;
        R.dstX = P->out; R.dstXb = (l == 2) ? (bf16_t*)nullptr : (bf16_t*)(ws + WS_XS); R.dstC = CTXS;
        R.YP = (const float*)(ws + WS_YP); R.nparts = (s == 7) ? 4 : 11;
        R.Yb = Yb; R.XN = XN; R.hasY = hasY; R.hasXN = hasXN; R.M = M; R.coef = coef;
        R.gate = MOD + (size_t)yl * 3 * NMODW + gidx * DM; R.gpost = P->normg + (yl * 6 + gpi) * DM;
        R.gpre = P->normg + (nl * 6 + npre) * DM; R.shift = MOD + (size_t)nl * 3 * NMODW + nsh * DM; R.scale = R.shift + DM;
        phase_row(R, wave, lane, bx, G);
        return;
    }
    if (s == 5) { phase_mix(P, l, lds, tid, wave, lane, bx, G); return; }
    const bool split = (s == 2 || s == 9 || s == 6) && (Mlate == MT || s == 2);
    const int npass = (s == 4 || split) ? 2 : 1;
    for (int pass = 0; pass < npass; ++pass) {
        pg8::Gemm g; EpiAny E; E.ropeC = (const float*)(ws + WS_ROPEC); E.ropeS = (const float*)(ws + WS_ROPES); E.pstride = 0; E.ntp = 0; int cu = bx, pm0 = 0, ksplit = 1, ntp = 0;
        if (s == 1 || s == 8) {
            const int sub = (s == 1) ? 0 : 1; const int M = (s == 1) ? MT : Mlate;
            g = pg8::Gemm{XN, (const bf16_t*)(ws + WS_WGU) + (size_t)(l * 2 + sub) * 5632 * 1024, M, 5632, 1024, 1024};
            E.mode = EPI_SWIGLU; E.perm = true; E.O = H; E.ldc = DFF;
        } else if (s == 6 || s == 2 || s == 9) {
            const bf16_t* A; const bf16_t* Bt; int K;
            if (s == 6) { A = (const bf16_t*)(ws + WS_MIX); Bt = (const bf16_t*)(ws + WS_WOUT) + (size_t)l * 1024 * 1024; K = 1024; }
            else { const int sub = (s == 2) ? 0 : 1; A = H; Bt = (const bf16_t*)(ws + WS_WD) + (size_t)(l * 2 + sub) * 1024 * DFF; K = DFF; }
            E.mode = EPI_F32; E.perm = false; E.ldc = 1024;
            if (pass == 0) { g = pg8::Gemm{A, Bt, MX, 1024, K, K}; E.mode = EPI_BF16; E.perm = true; E.O = Yb; }
            else { ntp = 4; ksplit = K / 256; pm0 = MX / 256; g = pg8::Gemm{A, Bt, MC, 1024, 256, K};
                   E.O = (float*)(ws + WS_YP) - (size_t)MX * 1024; E.pstride = MC * 1024; E.ntp = 4; }
        } else {
            const bf16_t* Wt = (const bf16_t*)(ws + WS_WIN) + (size_t)l * INW * 1024;
            if (pass == 0) { g = pg8::Gemm{XN, Wt, MT, 1536, 1024, 1024}; E.mode = EPI_QKU; E.perm = false; E.O = ws + WS_Q; E.ldc = 512; }
            else { g = pg8::Gemm{Wt + (size_t)1536 * 1024, XN, 512, MT, 1024, 1024}; E.mode = EPI_BF16; E.perm = true; E.O = ws + WS_VT; E.ldc = MT; cu = G - 1 - bx; }
        }
        pg8::StaticOrder S; S.init(g.M, g.N, G, cu, pm0, ksplit, ntp);
        pg8::gemm_phase<EpiAny, pg8::StaticOrder, true, true>(lds, g, S, E);
    }
}

__global__ void __launch_bounds__(NTHREADS, 2) mega(Params P, int ph_lo, int ph_hi) {
    extern __shared__ __attribute__((aligned(16))) unsigned char lds_raw[];
    LAS unsigned char* lds = (LAS unsigned char*)lds_raw;
    cg::grid_group grid = cg::this_grid();
    volatile LAS unsigned* bst = (volatile LAS unsigned*)(lds + 131072 + 64);
    if (threadIdx.x < 2) bst[threadIdx.x] = 0u;
    __syncthreads();
    XcdBarrier bar;
    { KParams kp0 = (KParams)__builtin_amdgcn_kernarg_segment_ptr(); bar = xcd_barrier_post((unsigned*)(kp0->ws + WS_BAR), bst); }
    KParams kp = (KParams)__builtin_amdgcn_kernarg_segment_ptr();
#if defined(PROBE_REP_PH)
    const int nextra = PROBE_REPS - 1;
#else
    const int nextra = 0;
#endif
    const int nsteps = ph_hi - ph_lo + nextra;
    for (int step = 0; step < nsteps; ++step) {
        int ph = ph_lo + step;
#if defined(PROBE_REP_PH)
        if (ph > PROBE_REP_PH) ph = (ph <= PROBE_REP_PH + nextra) ? PROBE_REP_PH : ph - nextra;
#endif
        asm volatile("" : "+s"(kp));
        int tid = threadIdx.x; asm volatile("" : "+v"(tid));
        const int lane = tid & 63, wave = __builtin_amdgcn_readfirstlane(tid >> 6);
        int bx = blockIdx.x, G = gridDim.x; asm volatile("" : "+s"(bx), "+s"(G));
        run_phase(kp, ph, lds, tid, wave, lane, bx, G);
        if (step + 1 < nsteps) { if (ph_lo < 0) grid.sync(); else xcd_barrier(bar); }
    }
}

extern "C" void kernel_launch(void* const* d_in, const int* in_sizes, int n_in, void* d_out, int out_size, void* d_ws, size_t ws_size, hipStream_t stream) {
    static int grid = 0;
    if (grid == 0) {
        if (n_in != 14 || in_sizes[0] != MX * DM || out_size != MX * DM || ws_size < WS_END) {
            fprintf(stderr, "kernel_launch: unexpected shapes (n_in %d, in0 %d, out %d, ws %zu < %zu)\n", n_in, n_in > 0 ? in_sizes[0] : -1, out_size, ws_size, (size_t)WS_END); grid = -1; return; }
        int dev = 0, cus = 0, per_cu = 0;
        (void)hipGetDevice(&dev); (void)hipDeviceGetAttribute(&cus, hipDeviceAttributeMultiprocessorCount, dev);
        if (hipFuncSetAttribute((const void*)mega, hipFuncAttributeMaxDynamicSharedMemorySize, LDS_BYTES) != hipSuccess) { fprintf(stderr, "kernel_launch: hipFuncSetAttribute failed\n"); grid = -1; return; }
        if (hipOccupancyMaxActiveBlocksPerMultiprocessor(&per_cu, (const void*)mega, NTHREADS, LDS_BYTES) != hipSuccess || per_cu < 1) { fprintf(stderr, "kernel_launch: occupancy query gave %d\n", per_cu); per_cu = 1; }
        (void)hipGetLastError();
        grid = cus * 1;
        if (grid <= 0) grid = 256;
    }
    if (grid < 0) return;
    if (hipMemsetAsync((char*)d_ws + WS_BAR, 0, 65536, stream) != hipSuccess) { fprintf(stderr, "kernel_launch: memset failed\n"); return; }
    Params p{};
    p.x = (const float*)d_in[0]; p.c = (const float*)d_in[1]; p.ctx = (const float*)d_in[2]; p.cctx = (const float*)d_in[3];
    p.wmod = (const float*)d_in[4]; p.bmod = (const float*)d_in[5]; p.normg = (const float*)d_in[6]; p.wgu = (const float*)d_in[7];
    p.wd = (const float*)d_in[8]; p.win = (const float*)d_in[9]; p.wout = (const float*)d_in[10]; p.rpb = (const float*)d_in[11];
    p.wpool = (const float*)d_in[12]; p.pscale = (const float*)d_in[13];
    p.out = (float*)d_out; p.ws = (unsigned char*)d_ws;
#if MK_MULTI
    for (int ph = 0; ph < NPHASE; ++ph) {
        int lo = ph, hi = ph + 1; void* args[] = {&p, &lo, &hi};
        hipError_t e = hipLaunchCooperativeKernel((const void*)mega, dim3(grid), dim3(NTHREADS), args, LDS_BYTES, stream);
        if (e != hipSuccess) { fprintf(stderr, "launch %d failed: %s\n", ph, hipGetErrorString(e)); break; }
    }
#else
#ifndef MK_PH_HI
#define MK_PH_HI NPHASE
#endif
#ifndef MK_PH_LO
#define MK_PH_LO 0
#endif
    int lo = MK_PH_LO, hi = MK_PH_HI; void* args[] = {&p, &lo, &hi};
    hipError_t e = hipLaunchCooperativeKernel((const void*)mega, dim3(grid), dim3(NTHREADS), args, LDS_BYTES, stream);
    if (e != hipSuccess) fprintf(stderr, "cooperative launch failed: %s (grid %d)\n", hipGetErrorString(e), grid);
#endif
}
```

```cpp
#include <hip/hip_runtime.h>
#include <hip/hip_cooperative_groups.h>
#include <cstdio>
#include <cstdint>
namespace cg = cooperative_groups;
namespace pg8 {
#define PG8_LAS __attribute__((address_space(3)))
typedef unsigned short bf16_t;
typedef short bf16x8 __attribute__((ext_vector_type(8)));
typedef float f32x4 __attribute__((ext_vector_type(4)));
typedef unsigned u32x4 __attribute__((ext_vector_type(4)));
constexpr int BM = 256, BK = 64, HALF = 128, HTB = HALF * BK * 2  , STAGE_BYTES = 8 * HTB, NXCD = 8, WGM = 8;

__host__ __device__ __forceinline__ int lds_byte(int r, int c) { const int st = (r >> 4) * 2 + (c >> 5), rr = r & 15, cc = c & 31, ob = rr * 64 + cc * 2; return st * 1024 + (ob ^ (((ob >> 9) & 1) << 5)); }
__host__ __device__ __forceinline__ void stage_rc(int b, int& R, int& C) { const int st = b / 1024, sb = b % 1024, swz = sb ^ (((sb >> 9) & 1) << 5); R = (st >> 1) * 16 + swz / 64; C = (st & 1) * 32 + (swz % 64) / 2; }
__host__ __device__ __forceinline__ int perm32(int rho) { const int n = rho >> 4, i = rho & 15; return 8 * (i >> 2) + 4 * n + (i & 3); }

struct Unit { int pm, pn, kb; };
struct Gemm { const bf16_t* A; const bf16_t* Bt; int M, N, K, ld; };

struct StaticOrder {
    int nM, nN, nwg, G, c, pm0, ksplit, ntp;
    __host__ __device__ void init(int M, int N, int G_, int c_, int pm0_ = 0, int ksplit_ = 1, int ntp_ = 0) { nM = M / BM; nN = N / BM; nwg = nM * nN * ksplit_; G = G_; c = c_; pm0 = pm0_; ksplit = ksplit_; ntp = ntp_; }
    __host__ __device__ bool next(int i, Unit& u) const {
        const long L = (long)i * G + c; if (L >= nwg) return false;
        int wgid = (int)L; u.kb = (wgid % ksplit) * ntp; wgid /= ksplit; { const int nwg = nM * nN; const int q = nwg / NXCD, r = nwg % NXCD, xcd = wgid % NXCD, off = wgid / NXCD; wgid = (xcd < r ? xcd * (q + 1) : r * (q + 1) + (xcd - r) * q) + off; }
        const int nig = WGM * nN, gid = wgid / nig, fm = gid * WGM, gsz = (nM - fm) < WGM ? (nM - fm) : WGM;
        u.pm = pm0 + fm + ((wgid % nig) % gsz); u.pn = (wgid % nig) / gsz; return true;
    }
    __device__ __forceinline__ void a_ready(const Unit&) const {}
    __device__ __forceinline__ void done(const Unit&) const {}
};

__device__ __forceinline__ unsigned cvt_pk_bf16(float lo, float hi) { unsigned r; asm volatile("v_cvt_pk_bf16_f32 %0, %1, %2" : "=v"(r) : "v"(lo), "v"(hi)); return r; }
typedef float f32x2 __attribute__((ext_vector_type(2)));
template <class Epi, class Sched, bool ALIGN_EPI = false, bool SP2 = false>
__device__ __forceinline__ void gemm_phase(PG8_LAS unsigned char* lds, const Gemm g, const Sched& S, const Epi& E) {
    int tid_raw = threadIdx.x; asm volatile("" : "+v"(tid_raw));
    const int tid = tid_raw, wid = __builtin_amdgcn_readfirstlane(tid >> 6), lane = tid & 63, wr = wid >> 2, wc = wid & 3, fr = lane & 15, fq = lane >> 4;
    const int K = g.ld, nt = g.K / BK;
    unsigned voffA[2], voffB[2];
#pragma unroll
    for (int i = 0; i < 2; ++i) { int R, C; stage_rc(tid * 16 + i * 8192, R, C); const int Rb = E.perm ? ((R & ~31) + perm32(R & 31)) : R;
        voffA[i] = (unsigned)(R * K + C) * 2u; voffB[i] = (unsigned)(Rb * K + C) * 2u; }
    const size_t kstep = (size_t)(BK * 2);
    const size_t hstep = (size_t)HALF * K * 2;
    const size_t tstep = 2 * hstep;
    const unsigned ldsw = (unsigned)wid * 1024u;
    const int aoff = lds_byte(wr * 64 + fr, fq * 8), boff = lds_byte(wc * 32 + fr, fq * 8);
#define PG8_SA(b, h) (((b) * 2 + (h)) * HTB)
#define PG8_SB(b, h) ((4 + (b) * 2 + (h)) * HTB)
#define PG8_STAGE(bufoff, gbase, voff) do { _Pragma("unroll") for (int _i = 0; _i < 2; ++_i) \
        __builtin_amdgcn_global_load_lds((const unsigned*)((const char*)(gbase) + (voff)[_i]), (PG8_LAS unsigned*)(lds + (bufoff) + ldsw + _i * 8192), 16, 0, 0); } while (0)
#define PG8_LDA(dst, b, h) do { _Pragma("unroll") for (int m = 0; m < 4; ++m) _Pragma("unroll") for (int k = 0; k < 2; ++k) dst[m][k] = *(const PG8_LAS bf16x8*)(lds + PG8_SA(b, h) + aoff + m * 2048 + k * 1024); } while (0)
#define PG8_LDB(dst, b, h) do { _Pragma("unroll") for (int n = 0; n < 2; ++n) _Pragma("unroll") for (int k = 0; k < 2; ++k) dst[n][k] = *(const PG8_LAS bf16x8*)(lds + PG8_SB(b, h) + boff + n * 2048 + k * 1024); } while (0)
#define PG8_MMA(ai, bj, At, Bt) do { __builtin_amdgcn_s_setprio(1); _Pragma("unroll") for (int m = 0; m < 4; ++m) _Pragma("unroll") for (int n = 0; n < 2; ++n) _Pragma("unroll") for (int k = 0; k < 2; ++k) \
        acc[ai][bj][m][n] = __builtin_amdgcn_mfma_f32_16x16x32_bf16(Bt[n][k], At[m][k], acc[ai][bj][m][n], 0, 0, 0); __builtin_amdgcn_s_setprio(0); } while (0)
#define PG8_WAIT_V(n) asm volatile("s_waitcnt vmcnt(" #n ")" ::: "memory")
#define PG8_WAIT_L(n) asm volatile("s_waitcnt lgkmcnt(" #n ")" ::: "memory")
#define PG8_BAR __builtin_amdgcn_s_barrier()
#define PG8_SCHED __builtin_amdgcn_sched_barrier(0)
    Unit cur, nxt; int ui = 0;
    if (!S.next(0, cur)) return;
    f32x4 acc[2][2][4][2];
#pragma unroll
    for (int a = 0; a < 2; ++a)
#pragma unroll
        for (int b = 0; b < 2; ++b)
#pragma unroll
            for (int m = 0; m < 4; ++m)
#pragma unroll
                for (int n = 0; n < 2; ++n) acc[a][b][m][n] = (f32x4){0.f, 0.f, 0.f, 0.f};
    bf16x8 At[4][2], B0[2][2], B1[2][2];
    const char* cA = (const char*)g.A + (size_t)cur.pm * tstep + (size_t)cur.kb * (BK * 2); const char* cB = (const char*)g.Bt + (size_t)cur.pn * tstep + (size_t)cur.kb * (BK * 2);
    S.a_ready(cur);
    if constexpr (SP2) {
        PG8_STAGE(PG8_SB(0, 0), cB, voffB); PG8_STAGE(PG8_SB(0, 1), cB + hstep, voffB); PG8_STAGE(PG8_SA(0, 0), cA, voffA); PG8_STAGE(PG8_SA(0, 1), cA + hstep, voffA);
        if (wr == 1) PG8_BAR;
        PG8_WAIT_V(2); PG8_BAR;
        PG8_STAGE(PG8_SB(1, 0), cB + kstep, voffB); PG8_STAGE(PG8_SA(1, 0), cA + kstep, voffA); PG8_STAGE(PG8_SB(1, 1), cB + hstep + kstep, voffB);
        PG8_WAIT_V(6); PG8_BAR;
    } else {
        PG8_STAGE(PG8_SB(0, 0), cB, voffB); PG8_STAGE(PG8_SA(0, 0), cA, voffA); PG8_STAGE(PG8_SB(0, 1), cB + hstep, voffB); PG8_STAGE(PG8_SA(0, 1), cA + hstep, voffA);
        if (wr == 1) PG8_BAR;
        PG8_WAIT_V(4); PG8_BAR;
        PG8_STAGE(PG8_SB(1, 0), cB + kstep, voffB); PG8_STAGE(PG8_SA(1, 0), cA + kstep, voffA); PG8_STAGE(PG8_SB(1, 1), cB + hstep + kstep, voffB);
        PG8_WAIT_V(6); PG8_BAR;
    }
    for (;;) {
        const bool has_next = S.next(ui + 1, nxt);
        const char* nA = has_next ? (const char*)g.A + (size_t)nxt.pm * tstep + (size_t)nxt.kb * (BK * 2) : cA; const char* nB = has_next ? (const char*)g.Bt + (size_t)nxt.pn * tstep + (size_t)nxt.kb * (BK * 2) : cB;
        for (int t = 0; t < nt; t += 2) {
            const bool last = (t == nt - 2);
            const char* a1 = cA + (size_t)(t + 1) * kstep;
            const char* a2 = last ? nA : cA + (size_t)(t + 2) * kstep; const char* b2 = last ? nB : cB + (size_t)(t + 2) * kstep;
            const char* a3 = a2 + kstep; const char* b3 = b2 + kstep;
            if (last && has_next) S.a_ready(nxt);
            if constexpr (SP2) {
            PG8_LDB(B0, 0, 0); PG8_LDB(B1, 0, 1); PG8_SCHED; PG8_LDA(At, 0, 0); PG8_STAGE(PG8_SA(1, 1), a1 + hstep, voffA);
            PG8_WAIT_V(8); PG8_WAIT_L(0); PG8_BAR; PG8_MMA(0, 0, At, B0); PG8_MMA(0, 1, At, B1); PG8_BAR; PG8_SCHED;
            PG8_LDA(At, 0, 1); PG8_STAGE(PG8_SB(0, 0), b2, voffB); PG8_STAGE(PG8_SB(0, 1), b2 + hstep, voffB); PG8_STAGE(PG8_SA(0, 0), a2, voffA);
            PG8_WAIT_V(8); PG8_WAIT_L(0); PG8_BAR; PG8_MMA(1, 0, At, B0); PG8_MMA(1, 1, At, B1); PG8_BAR; PG8_SCHED;
            PG8_LDB(B0, 1, 0); PG8_LDB(B1, 1, 1); PG8_SCHED; PG8_LDA(At, 1, 0); PG8_STAGE(PG8_SA(0, 1), a2 + hstep, voffA);
            PG8_WAIT_V(8); PG8_WAIT_L(0); PG8_BAR; PG8_MMA(0, 0, At, B0); PG8_MMA(0, 1, At, B1); PG8_BAR; PG8_SCHED;
            PG8_LDA(At, 1, 1); PG8_STAGE(PG8_SB(1, 0), b3, voffB); PG8_STAGE(PG8_SB(1, 1), b3 + hstep, voffB); PG8_STAGE(PG8_SA(1, 0), a3, voffA);
            PG8_WAIT_V(8); PG8_WAIT_L(0); PG8_BAR; PG8_MMA(1, 0, At, B0); PG8_MMA(1, 1, At, B1); PG8_BAR; PG8_SCHED;
            } else {
            PG8_LDB(B0, 0, 0); PG8_SCHED; PG8_LDA(At, 0, 0); PG8_STAGE(PG8_SA(1, 1), a1 + hstep, voffA);
            PG8_WAIT_L(8); PG8_BAR; PG8_WAIT_L(0); PG8_MMA(0, 0, At, B0); PG8_BAR; PG8_SCHED;
            PG8_LDB(B1, 0, 1); PG8_STAGE(PG8_SB(0, 0), b2, voffB);
            PG8_BAR; PG8_WAIT_L(0); PG8_MMA(0, 1, At, B1); PG8_BAR;
            PG8_LDA(At, 0, 1); PG8_STAGE(PG8_SA(0, 0), a2, voffA);
            PG8_BAR; PG8_WAIT_L(0); PG8_MMA(1, 0, At, B0); PG8_BAR; PG8_SCHED;
            PG8_STAGE(PG8_SB(0, 1), b2 + hstep, voffB);
            PG8_WAIT_V(6); PG8_BAR; PG8_MMA(1, 1, At, B1); PG8_BAR;
            PG8_LDB(B0, 1, 0); PG8_SCHED; PG8_LDA(At, 1, 0); PG8_STAGE(PG8_SA(0, 1), a2 + hstep, voffA);
            PG8_WAIT_L(8); PG8_BAR; PG8_WAIT_L(0); PG8_MMA(0, 0, At, B0); PG8_BAR; PG8_SCHED;
            PG8_LDB(B1, 1, 1); PG8_STAGE(PG8_SB(1, 0), b3, voffB);
            PG8_BAR; PG8_WAIT_L(0); PG8_MMA(0, 1, At, B1); PG8_BAR;
            PG8_LDA(At, 1, 1); PG8_STAGE(PG8_SA(1, 0), a3, voffA);
            PG8_BAR; PG8_WAIT_L(0); PG8_MMA(1, 0, At, B0); PG8_BAR; PG8_SCHED;
            PG8_STAGE(PG8_SB(1, 1), b3 + hstep, voffB);
            PG8_WAIT_V(6); PG8_BAR; PG8_MMA(1, 1, At, B1); PG8_BAR;
            }
        }
        if constexpr (ALIGN_EPI) { if (wr == 0) PG8_BAR; }
        if constexpr (!Epi::AFTER_DRAIN) { E(acc, cur, wr, wc, fr, fq); S.done(cur); }
        if (!has_next) break;
#pragma unroll
        for (int a = 0; a < 2; ++a)
#pragma unroll
            for (int b = 0; b < 2; ++b)
#pragma unroll
                for (int m = 0; m < 4; ++m)
#pragma unroll
                    for (int n = 0; n < 2; ++n) acc[a][b][m][n] = (f32x4){0.f, 0.f, 0.f, 0.f};
        cur = nxt; cA = nA; cB = nB; ++ui;
        if constexpr (ALIGN_EPI) { if (wr == 1) PG8_BAR; }
    }
    PG8_WAIT_V(0);
    if constexpr (!ALIGN_EPI) { if (wr == 0) PG8_BAR; }
    PG8_BAR;
    if constexpr (Epi::AFTER_DRAIN) { E.fused(acc, cur, wr, wc, fr, fq, lds, wid, lane); S.done(cur); }
#undef PG8_SA
#undef PG8_SB
#undef PG8_STAGE
#undef PG8_LDA
#undef PG8_LDB
#undef PG8_MMA
#undef PG8_WAIT_V
#undef PG8_WAIT_L
#undef PG8_BAR
#undef PG8_SCHED
}
}

#ifndef MK_MULTI
#define MK_MULTI 0
#endif
typedef unsigned short bf16_t;
typedef short bf16x8 __attribute__((ext_vector_type(8)));
typedef float f32x4 __attribute__((ext_vector_type(4)));
typedef float f32x16 __attribute__((ext_vector_type(16)));
typedef unsigned u32x4 __attribute__((ext_vector_type(4)));
typedef unsigned u32x2 __attribute__((ext_vector_type(2)));
typedef float f32x2_t __attribute__((ext_vector_type(2)));
typedef __bf16 bf16x2_t __attribute__((ext_vector_type(2)));
#define LAS __attribute__((address_space(3)))

constexpr int DM = 1024, SEQ = 8192, NB = 2, CTXL = 256, MX = NB * SEQ, MC = NB * CTXL, MT = MX + MC;
constexpr int DFF = 2816, NH = 8, HD = 64, INW = 2048, NMODW = 9 * DM;
constexpr float RMS_EPS = 1e-6f;
constexpr float LOG2E = 1.4426950408889634f;
constexpr float QSCALE = 0.125f * LOG2E;
constexpr int NPHASE = 22;
constexpr int NTHREADS = 512, NWAVES = 8;
constexpr int LDS_BYTES = 147456;

constexpr size_t MiB = 1u << 20;
constexpr size_t WS_MOD = 0;
constexpr size_t WS_ROPEC = 256 * 1024;
constexpr size_t WS_ROPES = 256 * 1024 + 8192;
constexpr size_t WS_BAR = 3 * MiB;
constexpr size_t WS_CTXS = 512 * 1024;
constexpr size_t WS_WGU = 4 * MiB;
constexpr size_t WS_WD = 48 * MiB;
constexpr size_t WS_WIN = 70 * MiB;
constexpr size_t WS_WOUT = 78 * MiB;
constexpr size_t WS_XN = 82 * MiB;
constexpr size_t WS_Y = 115 * MiB;
constexpr size_t WS_XS = 147 * MiB;
constexpr size_t WS_H = 211 * MiB;
constexpr size_t SZ_QK = (size_t)MT * 512 * 2;
constexpr size_t WS_Q = WS_H, WS_K = WS_Q + SZ_QK, WS_U = WS_K + SZ_QK, WS_VT = WS_U + SZ_QK, WS_MIX = WS_VT + SZ_QK;
constexpr size_t WS_YP = WS_MIX + (size_t)MT * 1024 * 2;
constexpr size_t WS_END = WS_YP + (size_t)11 * MC * 1024 * 4;
static_assert(WS_XN + (size_t)MT * 1024 * 2 <= WS_Y && WS_Y + (size_t)MX * 1024 * 2 <= WS_XS && WS_XS + (size_t)MX * 1024 * 4 <= WS_H && WS_H + (size_t)MT * DFF * 2 <= WS_YP, "ws map");

struct Params {
    const float *x, *c, *ctx, *cctx, *wmod, *bmod, *normg, *wgu, *wd, *win, *wout, *rpb, *wpool, *pscale;
    float* out; unsigned char* ws;
};
typedef const __attribute__((address_space(4))) Params* KParams;

__device__ __forceinline__ unsigned cvtpk(float lo, float hi) { f32x2_t v = {lo, hi}; bf16x2_t b = __builtin_convertvector(v, bf16x2_t); return __builtin_bit_cast(unsigned, b); }
__device__ __forceinline__ float bf2f(unsigned short h) { return __uint_as_float(((unsigned)h) << 16); }
__device__ __forceinline__ float wave_sum(float v) {
#pragma unroll
    for (int o = 1; o < 64; o <<= 1) v += __shfl_xor(v, o);
    return v;
}

#define XB_TMO      128
#define XB_XCNT(j)  (256  + 64 * (j))
#define XB_XSUB(j)  (1280 + 64 * (j))
#define XB_XGEN(j)  (2304 + 64 * (j))
#define XB_TOP      3328
#define XB_TOPGEN   3392
#define XCD_BAR_WORDS 3456
#define XB_SPIN_CAP (1u << 18)

__device__ __forceinline__ unsigned xb_ld(unsigned* p)              { return __hip_atomic_load(p, __ATOMIC_RELAXED, __HIP_MEMORY_SCOPE_AGENT); }
__device__ __forceinline__ unsigned xb_add(unsigned* p, unsigned v) { return __hip_atomic_fetch_add(p, v, __ATOMIC_RELAXED, __HIP_MEMORY_SCOPE_AGENT); }
__device__ __forceinline__ unsigned xb_xcc_id() { return (unsigned)__builtin_amdgcn_s_getreg((3 << 11) | 20) & 0xFu; }
#define XB_SPIN(cond, bar) do { unsigned _sp = 0; while (cond) { __builtin_amdgcn_s_sleep(1); \
    if ((++_sp & 255u) == 0u) { if (xb_ld(&(bar)[XB_TMO])) break; if (_sp > XB_SPIN_CAP) { atomicAdd(&(bar)[XB_TMO], 1u); break; } } } } while (0)

struct XcdBarrier {
    unsigned* bar; unsigned x;
    volatile LAS unsigned* st;
};

__device__ __forceinline__ XcdBarrier xcd_barrier_post(unsigned* bar, volatile LAS unsigned* st) {
    XcdBarrier b; b.bar = bar; b.x = xb_xcc_id(); b.st = st;
    if (threadIdx.x == 0) (void)xb_add(&bar[XB_XCNT(b.x)], 1u);
    return b;
}
__device__ __forceinline__ void xcd_barrier_complete(unsigned* bar, unsigned x, unsigned& nloc, unsigned& nx) {
    const unsigned G = gridDim.x * gridDim.y * gridDim.z;
    unsigned sum, cnt, mine, sp = 0u;
    for (;;) {
        sum = 0u; cnt = 0u; mine = 0u;
#pragma unroll
        for (unsigned j = 0; j < 16; ++j) { const unsigned c = xb_ld(&bar[XB_XCNT(j)]); sum += c; cnt += (c > 0u) ? 1u : 0u; mine = (j == x) ? c : mine; }
        if (sum == G) break;
        __builtin_amdgcn_s_sleep(1);
        if ((++sp & 255u) == 0u) { if (xb_ld(&bar[XB_TMO])) break; if (sp > XB_SPIN_CAP) { atomicAdd(&bar[XB_TMO], 1u); break; } }
    }
    nloc = mine > 0u ? mine : 1u; nx = cnt > 0u ? cnt : 1u;
}

__device__ __forceinline__ void xcd_barrier(const XcdBarrier& b) {
    asm volatile("s_waitcnt vmcnt(0)" ::: "memory");
    __syncthreads();
    if (threadIdx.x == 0) {
        unsigned* bar = b.bar;
        __builtin_amdgcn_s_waitcnt(0);
        unsigned nloc = b.st[0], nx = b.st[1];
        if (nloc == 0u) { xcd_barrier_complete(bar, b.x, nloc, nx); b.st[0] = nloc; b.st[1] = nx; }
        const unsigned old = xb_add(&bar[XB_XSUB(b.x)], 1u);
        const unsigned gen = old / nloc;
        if (old + 1u == (gen + 1u) * nloc) {
            __builtin_amdgcn_fence(__ATOMIC_RELEASE, "agent");
            asm volatile("s_waitcnt vmcnt(0)" ::: "memory");
            const unsigned og = xb_add(&bar[XB_TOP], 1u);
            const unsigned tg = og / nx;
            if (og + 1u == (tg + 1u) * nx) xb_add(&bar[XB_TOPGEN], 1u);
            else XB_SPIN(xb_ld(&bar[XB_TOPGEN]) == tg, bar);
            __builtin_amdgcn_fence(__ATOMIC_ACQUIRE, "agent");
            xb_add(&bar[XB_XGEN(b.x)], 1u);
            asm volatile("s_waitcnt vmcnt(0)" ::: "memory");
        } else {
            XB_SPIN(xb_ld(&bar[XB_XGEN(b.x)]) == gen, bar);
            __builtin_amdgcn_fence(__ATOMIC_ACQUIRE, "agent");
            asm volatile("s_waitcnt vmcnt(0)" ::: "memory");
        }
    }
    __syncthreads();
}

using pg8::Unit;
enum { EPI_SWIGLU = 0, EPI_F32 = 1, EPI_QKU = 2, EPI_BF16 = 3 };
struct EpiAny {
    static constexpr bool AFTER_DRAIN = false;
    int mode; bool perm; void* O; int ldc; const float *ropeC, *ropeS; int pstride, ntp;
    __device__ __forceinline__ static float sw(float g, float u) { return g * u * __builtin_amdgcn_rcpf(1.0f + __builtin_amdgcn_exp2f(-g * LOG2E)); }
    __device__ __forceinline__ void operator()(const f32x4 (&acc)[2][2][4][2], const Unit& u, int wr, int wc, int fr, int fq) const {
        if (mode == EPI_SWIGLU) {
            bf16_t* H = (bf16_t*)O;
            const int row0 = u.pm * 256 + wr * 64 + fr, col0 = u.pn * 128 + wc * 32 + 8 * fq;
#pragma unroll
            for (int ai = 0; ai < 2; ++ai)
#pragma unroll
                for (int m = 0; m < 4; ++m) {
                    bf16_t* p = H + (size_t)(row0 + ai * 128 + m * 16) * DFF + col0;
                    const f32x4 g0 = acc[ai][0][m][0], g1 = acc[ai][0][m][1], u0 = acc[ai][1][m][0], u1 = acc[ai][1][m][1];
                    f32x4 e0 = g0 * (-LOG2E), e1 = g1 * (-LOG2E);
#pragma unroll
                    for (int i = 0; i < 4; ++i) { e0[i] = __builtin_amdgcn_exp2f(e0[i]); e1[i] = __builtin_amdgcn_exp2f(e1[i]); }
                    e0 = e0 + 1.0f; e1 = e1 + 1.0f;
#pragma unroll
                    for (int i = 0; i < 4; ++i) { e0[i] = __builtin_amdgcn_rcpf(e0[i]); e1[i] = __builtin_amdgcn_rcpf(e1[i]); }
                    const f32x4 o0 = (g0 * u0) * e0, o1 = (g1 * u1) * e1;
                    u32x4 w; w.x = cvtpk(o0[0], o0[1]); w.y = cvtpk(o0[2], o0[3]); w.z = cvtpk(o1[0], o1[1]); w.w = cvtpk(o1[2], o1[3]);
                    *(u32x4*)p = w;
                }
        } else if (mode == EPI_F32) {
            float* Y = (float*)O + ((ntp > 0) ? (size_t)(u.kb / ntp) * (size_t)pstride : (size_t)0);
            const int row0 = u.pm * 256 + wr * 64 + fr, col0 = u.pn * 256 + wc * 32 + 4 * fq;
#pragma unroll
            for (int ai = 0; ai < 2; ++ai)
#pragma unroll
                for (int m = 0; m < 4; ++m) {
                    float* p = Y + (size_t)(row0 + ai * 128 + m * 16) * ldc + col0;
#pragma unroll
                    for (int bj = 0; bj < 2; ++bj)
#pragma unroll
                        for (int n = 0; n < 2; ++n) *(f32x4*)(p + bj * 128 + n * 16) = acc[ai][bj][m][n];
                }
        } else if (mode == EPI_QKU) {
            const int t = u.pn >> 1; bf16_t* base = (bf16_t*)O + (size_t)t * ((size_t)MT * 512);
            const float sc = (t == 0) ? QSCALE : 1.0f;
            const bool rope = (t < 2) && (u.pm < MX / 256);
            const int cb = (u.pn & 1) * 256 + wc * 32 + 4 * fq;
#pragma unroll
            for (int ai = 0; ai < 2; ++ai)
#pragma unroll
                for (int m = 0; m < 4; ++m) {
                    const int row = u.pm * 256 + ai * 128 + wr * 64 + m * 16 + fr;
                    bf16_t* p = base + (size_t)row * 512 + cb;
                    f32x4 c4 = {1.f, 1.f, 1.f, 1.f}, s4 = {0.f, 0.f, 0.f, 0.f};
                    if (rope) { const int s = row & (SEQ - 1); const int pos = (wc & 1) ? (s & 63) : (s >> 6);
                        c4 = *(const f32x4*)(ropeC + pos * 16 + 4 * fq); s4 = *(const f32x4*)(ropeS + pos * 16 + 4 * fq); }
#pragma unroll
                    for (int bj = 0; bj < 2; ++bj) {
                        const f32x4 x1 = acc[ai][bj][m][0], x2 = acc[ai][bj][m][1];
                        const f32x4 o1 = (x1 * c4 - x2 * s4) * sc, o2 = (x2 * c4 + x1 * s4) * sc;
                        u32x2 w1, w2; w1.x = cvtpk(o1[0], o1[1]); w1.y = cvtpk(o1[2], o1[3]); w2.x = cvtpk(o2[0], o2[1]); w2.y = cvtpk(o2[2], o2[3]);
                        *(u32x2*)(p + bj * 128) = w1; *(u32x2*)(p + bj * 128 + 16) = w2;
                    }
                }
        } else {
            bf16_t* Ob = (bf16_t*)O;
            const int row0 = u.pm * 256 + wr * 64 + fr, col0 = u.pn * 256 + wc * 32 + 8 * fq;
#pragma unroll
            for (int ai = 0; ai < 2; ++ai)
#pragma unroll
                for (int m = 0; m < 4; ++m) {
                    bf16_t* p = Ob + (size_t)(row0 + ai * 128 + m * 16) * ldc + col0;
#pragma unroll
                    for (int bj = 0; bj < 2; ++bj) { const f32x4 v0 = acc[ai][bj][m][0], v1 = acc[ai][bj][m][1];
                        u32x4 w; w.x = cvtpk(v0[0], v0[1]); w.y = cvtpk(v0[2], v0[3]); w.z = cvtpk(v1[0], v1[1]); w.w = cvtpk(v1[2], v1[3]);
                        *(u32x4*)(p + bj * 128) = w; }
                }
        }
    }
};

__device__ __forceinline__ void p0_transpose_item(const float* W, int ldw, int k0, int n0, bf16_t* WT, int ldt, int dst_row0, LAS unsigned char* scr, int lane) {
    f32x4 v[16];
    const float* src = W + (size_t)(k0 + (lane >> 4)) * ldw + n0 + 4 * (lane & 15);
#pragma unroll
    for (int i = 0; i < 16; ++i) v[i] = __builtin_nontemporal_load((const f32x4*)(src + (size_t)(4 * i) * ldw));
#pragma unroll
    for (int i = 0; i < 16; ++i) { LAS unsigned* p = (LAS unsigned*)(scr + (4 * i + (lane >> 4)) * 132 + 8 * (lane & 15)); p[0] = cvtpk(v[i][0], v[i][1]); p[1] = cvtpk(v[i][2], v[i][3]); }
    asm volatile("s_waitcnt lgkmcnt(0)" ::: "memory");
    const int c = lane & 7;
#pragma unroll
    for (int j = 0; j < 4; ++j) { const int np = (lane >> 3) + 8 * j; unsigned w[8];
#pragma unroll
        for (int i = 0; i < 8; ++i) w[i] = *(const LAS unsigned*)(scr + (8 * c + i) * 132 + 4 * np);
        u32x4 lo, hi;
        lo.x = (w[0] & 0xffffu) | (w[1] << 16); lo.y = (w[2] & 0xffffu) | (w[3] << 16); lo.z = (w[4] & 0xffffu) | (w[5] << 16); lo.w = (w[6] & 0xffffu) | (w[7] << 16);
        hi.x = (w[0] >> 16) | (w[1] & 0xffff0000u); hi.y = (w[2] >> 16) | (w[3] & 0xffff0000u); hi.z = (w[4] >> 16) | (w[5] & 0xffff0000u); hi.w = (w[6] >> 16) | (w[7] & 0xffff0000u);
        *(u32x4*)(WT + (size_t)(dst_row0 + 2 * np) * ldt + k0 + 8 * c) = lo;
        *(u32x4*)(WT + (size_t)(dst_row0 + 2 * np + 1) * ldt + k0 + 8 * c) = hi; }
    asm volatile("s_waitcnt lgkmcnt(0)" ::: "memory");
}

__device__ __forceinline__ void phase_p0(KParams P, LAS unsigned char* lds, int tid, int wave, int lane, int bx, int G) {
    unsigned char* ws = P->ws;
    float* MOD = (float*)(ws + WS_MOD);
    const int gt = bx * NTHREADS + tid;
    if (gt < 2048) {
        const int pos = gt >> 4, i = gt & 15;
        const float inv = exp2f(-(float)i * 0.83048202372184058696f);
        const float angf = (float)pos * inv;
        const double a = (double)angf; const double kq = rint(a * 0.63661977236758134308); const double r = a - kq * 1.57079632679489661923; const double r2 = r * r;
        double sr = r, cr = 1.0, ts = r, tc = 1.0;
#pragma unroll 1
        for (int k = 1; k <= 8; ++k) { const double k2 = (double)(2 * k); tc *= -r2 / (k2 * (k2 - 1.0)); ts *= -r2 / (k2 * (k2 + 1.0)); cr += tc; sr += ts; }
        const int q = ((int)kq) & 3;
        const double cv = (q == 0) ? cr : (q == 1) ? -sr : (q == 2) ? -cr : sr;
        const double sv = (q == 0) ? sr : (q == 1) ? cr : (q == 2) ? -sr : -cr;
        ((float*)(ws + WS_ROPEC))[gt] = (float)cv; ((float*)(ws + WS_ROPES))[gt] = (float)sv;
    }
    constexpr int J_MOD = 72, J_FOLD = 128, J_TR = 1216, NJOBS = J_MOD + J_FOLD + J_TR;
    unsigned* jq = (unsigned*)(ws + WS_BAR + 32768);
    LAS int* jb = (LAS int*)(lds + 131072 + 128);
    for (;;) {
        if (tid == 0) *jb = (int)__hip_atomic_fetch_add(jq, 1u, __ATOMIC_RELAXED, __HIP_MEMORY_SCOPE_AGENT);
        __syncthreads();
        const int job = *jb;
        __syncthreads();
        if (job >= NJOBS) break;
        if (job < J_MOD) {
            LAS float* sc = (LAS float*)lds;
            LAS float* red = sc + 3072;
            for (int i = tid; i < 3072; i += NTHREADS) { const int who = i >> 10, k = i & 1023; const float v = (who < 2) ? P->c[who * 1024 + k] : P->cctx[k]; sc[i] = v / (1.0f + __expf(-v)); }
            __syncthreads();
            const int l = job / 36, cc = job % 36, col = cc * 256 + 4 * lane;
            const float* W = P->wmod + ((size_t)l * 1024 + wave * 128) * NMODW + col;
            f32x4 a0 = {0.f, 0.f, 0.f, 0.f}, a1 = a0, a2 = a0;
#pragma unroll 16
            for (int k = 0; k < 128; ++k) { const f32x4 w = __builtin_nontemporal_load((const f32x4*)(W + (size_t)k * NMODW)); const int kk = wave * 128 + k; a0 += w * sc[kk]; a1 += w * sc[1024 + kk]; a2 += w * sc[2048 + kk]; }
            *(LAS f32x4*)(red + (wave * 3 + 0) * 256 + 4 * lane) = a0; *(LAS f32x4*)(red + (wave * 3 + 1) * 256 + 4 * lane) = a1; *(LAS f32x4*)(red + (wave * 3 + 2) * 256 + 4 * lane) = a2;
            __syncthreads();
            for (int o = tid; o < 768; o += NTHREADS) { const int who = o >> 8, cl = o & 255; float s = 0.f;
#pragma unroll
                for (int w = 0; w < 8; ++w) s += red[(w * 3 + who) * 256 + cl];
                MOD[(size_t)(l * 3 + who) * NMODW + cc * 256 + cl] = s + P->bmod[l * NMODW + cc * 256 + cl]; }
            __syncthreads();
        } else if (job < J_MOD + J_FOLD) {
            const int r = job - J_MOD, nb = r & 15, g = (r >> 4) & 3, l = r >> 6;
            LAS float* A = (LAS float*)lds;
            LAS float* B = (LAS float*)(lds + 128 * 132 * 4);
            LAS bf16_t* OT = (LAS bf16_t*)(lds + 128 * 132 * 4 + 128 * 64 * 4);
            const float* wp = P->wpool + (size_t)(l * 4 + g) * 128 * 128; const float* ps = P->pscale + l * 512 + g * 128;
            const float* wo = P->wout + ((size_t)l * 1024 + 512 + g * 128) * 1024 + nb * 64;
#pragma unroll 8
            for (int i = 0; i < 32; ++i) { const int idx = tid + NTHREADS * i, c = idx >> 7, d = idx & 127; A[c * 132 + d] = wp[idx] * ps[d]; }
#pragma unroll 8
            for (int i = 0; i < 16; ++i) { const int idx = tid + NTHREADS * i, d = idx >> 6, n = idx & 63; B[idx] = wo[(size_t)d * 1024 + n]; }
            __syncthreads();
            const int c = tid >> 2, nq = tid & 3;
            f32x4 acc[4];
#pragma unroll
            for (int j = 0; j < 4; ++j) acc[j] = (f32x4){0.f, 0.f, 0.f, 0.f};
#pragma unroll 4
            for (int d = 0; d < 128; ++d) { const float a = A[c * 132 + d];
#pragma unroll
                for (int j = 0; j < 4; ++j) acc[j] += *(const LAS f32x4*)(B + d * 64 + 16 * nq + 4 * j) * a; }
#pragma unroll
            for (int j = 0; j < 4; ++j)
#pragma unroll
                for (int e = 0; e < 4; ++e) OT[(16 * nq + 4 * j + e) * 128 + c] = (bf16_t)(cvtpk(acc[j][e], 0.f) & 0xffffu);
            __syncthreads();
            bf16_t* dst = (bf16_t*)(ws + WS_WOUT) + ((size_t)l * 1024 + nb * 64) * 1024 + 512 + g * 128;
#pragma unroll
            for (int i = 0; i < 2; ++i) { const int ch = tid + NTHREADS * i, n = ch >> 4, cc8 = ch & 15; *(u32x4*)(dst + (size_t)n * 1024 + cc8 * 8) = *(const LAS u32x4*)(OT + n * 128 + cc8 * 8); }
            __syncthreads();
        } else {
            LAS unsigned char* scr = lds + wave * 8448;
            int tj = job - J_MOD - J_FOLD; const int wk = wave >> 2, wn = wave & 3;
            if (tj < 704) { const int ls = tj / 176, r = tj % 176, kb = r / 22, nb = r % 22, k0 = kb * 128 + wk * 64, n0 = nb * 256 + wn * 64;
                const int cidx = (n0 < DFF) ? n0 : n0 - DFF; const int drow = 256 * (cidx >> 7) + (cidx & 127) + ((n0 < DFF) ? 0 : 128);
                p0_transpose_item(P->wgu + (size_t)ls * 1024 * 5632, 5632, k0, n0, (bf16_t*)(ws + WS_WGU) + (size_t)ls * 5632 * 1024, 1024, drow, scr, lane); }
            else if ((tj -= 704) < 352) { const int ls = tj / 88, r = tj % 88, kb = r / 4, nb = r % 4, k0 = kb * 128 + wk * 64, n0 = nb * 256 + wn * 64;
                p0_transpose_item(P->wd + (size_t)ls * DFF * 1024, 1024, k0, n0, (bf16_t*)(ws + WS_WD) + (size_t)ls * 1024 * DFF, DFF, n0, scr, lane); }
            else if ((tj -= 352) < 128) { const int l = tj / 64, r = tj % 64, kb = r / 8, nb = r % 8, k0 = kb * 128 + wk * 64, n0 = nb * 256 + wn * 64;
                const int drow = (n0 < 1024) ? n0 : (n0 < 1536) ? n0 + 512 : n0 - 512;
                p0_transpose_item(P->win + (size_t)l * 1024 * INW, INW, k0, n0, (bf16_t*)(ws + WS_WIN) + (size_t)l * INW * 1024, 1024, drow, scr, lane); }
            else { tj -= 128; const int l = tj / 16, r = tj % 16, kb = r / 4, nb = r % 4, k0 = kb * 128 + wk * 64, n0 = nb * 256 + wn * 64;
                p0_transpose_item(P->wout + (size_t)l * 1024 * 1024, 1024, k0, n0, (bf16_t*)(ws + WS_WOUT) + (size_t)l * 1024 * 1024, 1024, n0, scr, lane); }
        }
    }
}

struct RowPass {
    const float *srcX, *srcC; float *dstX, *dstC; const bf16_t* srcXb; bf16_t* dstXb;
    const bf16_t* Yb; const float *gate, *gpost; float coef;
    const float *shift, *scale, *gpre; bf16_t* XN;
    int M; bool hasY, hasXN; const float* YP; int nparts;
};
template <int RPT> __device__ __forceinline__ void row_range(const RowPass& R, const LAS float* mv, int lane, int gw, int NGW, int mlo, int mhi) {
    for (int m0 = mlo + RPT * gw; m0 < mhi; m0 += RPT * NGW) {
        const int who = (m0 < SEQ) ? 0 : (m0 < MX) ? 1 : 2;
        const bool isx = m0 < MX;
        f32x4 v[RPT][4];
#pragma unroll
        for (int rr = 0; rr < RPT; ++rr) { const int m = m0 + rr;
            if (isx && R.srcXb) {
#pragma unroll
                for (int j = 0; j < 4; ++j) { const u32x2 w = __builtin_nontemporal_load((const u32x2*)(R.srcXb + (size_t)m * DM + 4 * lane + 256 * j));
                    v[rr][j] = (f32x4){__uint_as_float(w.x << 16), __uint_as_float(w.x & 0xffff0000u), __uint_as_float(w.y << 16), __uint_as_float(w.y & 0xffff0000u)}; }
            } else { const float* xin = isx ? R.srcX + (size_t)m * DM : R.srcC + (size_t)(m - MX) * DM;
#pragma unroll
                for (int j = 0; j < 4; ++j) v[rr][j] = __builtin_nontemporal_load((const f32x4*)(xin + 4 * lane + 256 * j)); } }
        if (R.hasY) {
            f32x4 y[RPT][4]; float ss[RPT];
#pragma unroll
            for (int rr = 0; rr < RPT; ++rr) ss[rr] = 0.f;
#pragma unroll
            for (int rr = 0; rr < RPT; ++rr) { const int m = m0 + rr;
#pragma unroll
                for (int j = 0; j < 4; ++j) {
                    if (isx) { const u32x2 w = __builtin_nontemporal_load((const u32x2*)(R.Yb + (size_t)m * DM + 4 * lane + 256 * j));
                        y[rr][j] = (f32x4){__uint_as_float(w.x << 16), __uint_as_float(w.x & 0xffff0000u), __uint_as_float(w.y << 16), __uint_as_float(w.y & 0xffff0000u)}; }
                    else { f32x4 tp[11];
#pragma unroll
                        for (int p = 0; p < 11; ++p) tp[p] = *(const f32x4*)(R.YP + ((size_t)min(p, R.nparts - 1) * MC + (m - MX)) * DM + 4 * lane + 256 * j);
                        f32x4 t = tp[0];
#pragma unroll
                        for (int p = 1; p < 11; ++p) t += tp[p] * ((p < R.nparts) ? 1.0f : 0.0f);
                        y[rr][j] = t; }
                    ss[rr] += (y[rr][j].x * y[rr][j].x + y[rr][j].y * y[rr][j].y) + (y[rr][j].z * y[rr][j].z + y[rr][j].w * y[rr][j].w); } }
#pragma unroll
            for (int rr = 0; rr < RPT; ++rr) ss[rr] = wave_sum(ss[rr]);
#pragma unroll
            for (int rr = 0; rr < RPT; ++rr) { const int m = m0 + rr;
                const float rs = rsqrtf(ss[rr] * (1.0f / DM) + RMS_EPS) * R.coef;
#pragma unroll
                for (int j = 0; j < 4; ++j) { const int col = 4 * lane + 256 * j; const f32x4 gt = *(const LAS f32x4*)(mv + who * 1024 + col), gp = *(const LAS f32x4*)(mv + 9 * 1024 + col);
                    v[rr][j] = v[rr][j] + gt * (y[rr][j] * rs * gp); }
                if (isx && R.dstXb) {
#pragma unroll
                    for (int j = 0; j < 4; ++j) { u32x2 w; w.x = cvtpk(v[rr][j][0], v[rr][j][1]); w.y = cvtpk(v[rr][j][2], v[rr][j][3]); *(u32x2*)(R.dstXb + (size_t)m * DM + 4 * lane + 256 * j) = w;
                        v[rr][j] = (f32x4){__uint_as_float(w.x << 16), __uint_as_float(w.x & 0xffff0000u), __uint_as_float(w.y << 16), __uint_as_float(w.y & 0xffff0000u)}; }
                } else { float* xo = isx ? R.dstX + (size_t)m * DM : R.dstC + (size_t)(m - MX) * DM;
#pragma unroll
                    for (int j = 0; j < 4; ++j) *(f32x4*)(xo + 4 * lane + 256 * j) = v[rr][j]; } }
        }
        if (R.hasXN) {
            float ss[RPT];
#pragma unroll
            for (int rr = 0; rr < RPT; ++rr) ss[rr] = 0.f;
#pragma unroll
            for (int rr = 0; rr < RPT; ++rr)
#pragma unroll
                for (int j = 0; j < 4; ++j) ss[rr] += (v[rr][j].x * v[rr][j].x + v[rr][j].y * v[rr][j].y) + (v[rr][j].z * v[rr][j].z + v[rr][j].w * v[rr][j].w);
#pragma unroll
            for (int rr = 0; rr < RPT; ++rr) ss[rr] = wave_sum(ss[rr]);
#pragma unroll
            for (int rr = 0; rr < RPT; ++rr) { const int m = m0 + rr;
                const float rs = rsqrtf(ss[rr] * (1.0f / DM) + RMS_EPS);
#pragma unroll
                for (int j = 0; j < 4; ++j) { const int col = 4 * lane + 256 * j;
                    const f32x4 gp = *(const LAS f32x4*)(mv + 10 * 1024 + col), sh = *(const LAS f32x4*)(mv + (3 + who) * 1024 + col), sc = *(const LAS f32x4*)(mv + (6 + who) * 1024 + col);
                    const f32x4 o = (v[rr][j] * rs * gp) * (sc + 1.0f) + sh;
                    u32x2 w; w.x = cvtpk(o[0], o[1]); w.y = cvtpk(o[2], o[3]);
                    *(u32x2*)(R.XN + (size_t)m * DM + col) = w; } }
        }
    }
}

__device__ __forceinline__ void phase_row(const RowPass& R, LAS unsigned char* lds, int tid, int wave, int lane, int bx, int G) {
    const int gw = bx * NWAVES + wave, NGW = G * NWAVES;
    LAS float* mv = (LAS float*)lds;
    for (int i = tid; i < 11 * 256; i += NTHREADS) { const int vec = i >> 8, c4 = (i & 255) * 4;
        const float* src = (vec < 3) ? R.gate + vec * NMODW : (vec < 6) ? R.shift + (vec - 3) * NMODW : (vec < 9) ? R.scale + (vec - 6) * NMODW : (vec == 9) ? R.gpost : R.gpre;
        *(LAS f32x4*)(mv + vec * 1024 + c4) = *(const f32x4*)(src + c4); }
    __syncthreads();
    row_range<4>(R, mv, lane, gw, NGW, 0, (R.M < MX) ? R.M : MX);
    if (R.M > MX) row_range<2>(R, mv, lane, NGW - 1 - gw, NGW, MX, R.M);
}

#define MFMA32(a, b, c) __builtin_amdgcn_mfma_f32_32x32x16_bf16((a), (b), (c), 0, 0, 0)
struct KFrag { bf16x8 k[4]; };
struct VFrag { bf16x8 v[4]; };
__device__ __forceinline__ void attn_loadk(KFrag& f, const bf16_t* kbase, int krow0) {
    const bf16_t* kp = kbase + (size_t)krow0 * 512;
#pragma unroll
    for (int dk = 0; dk < 4; ++dk) f.k[dk] = *(const bf16x8*)(kp + dk * 16);
}
__device__ __forceinline__ void attn_loadv(VFrag& f, const bf16_t* vbase, int krow0) {
    const bf16_t* vp = vbase + krow0;
    f.v[0] = *(const bf16x8*)(vp); f.v[1] = *(const bf16x8*)(vp + 16); f.v[2] = *(const bf16x8*)(vp + (size_t)32 * MT); f.v[3] = *(const bf16x8*)(vp + (size_t)32 * MT + 16);
}
constexpr int KL_OFF = 32768, KL_PITCH = 144, VL_OFF = KL_OFF + 256 * KL_PITCH, VL_PITCH = 528;
__device__ __forceinline__ void attn_loadk_lds(KFrag& f, const LAS unsigned char* kl, int t) {
    const LAS unsigned char* p = kl + t * (32 * KL_PITCH);
#pragma unroll
    for (int dk = 0; dk < 4; ++dk) f.k[dk] = *(const LAS bf16x8*)(p + dk * 32);
}
__device__ __forceinline__ void attn_loadv_lds(VFrag& f, const LAS unsigned char* vl, int t) {
    const LAS unsigned char* p = vl + t * 64;
    f.v[0] = *(const LAS bf16x8*)(p); f.v[1] = *(const LAS bf16x8*)(p + 32); f.v[2] = *(const LAS bf16x8*)(p + 32 * VL_PITCH); f.v[3] = *(const LAS bf16x8*)(p + 32 * VL_PITCH + 32);
}
__device__ __forceinline__ void attn_soft(f32x16& S, f32x16& o0, f32x16& o1, float& mrun, float& lrun, bool masked, const LAS float* bt, int relb, int idxb, bf16x8& pb0, bf16x8& pb1) {
    if (masked) {
        const LAS float* bp = bt + idxb;
        float bv[16];
#pragma unroll
        for (int r = 0; r < 16; ++r) bv[r] = bp[16 * (r >> 3) + (r & 7)];
#pragma unroll
        for (int r = 0; r < 16; ++r) {
            const int off = 16 * (r >> 3) + (r & 7);
            const bool valid = (unsigned)(relb + off) < 16u;
            S[r] = valid ? S[r] + bv[r] : -1e30f;
        }
    }
    float tm = S[0];
#pragma unroll
    for (int r = 1; r < 16; ++r) tm = fmaxf(tm, S[r]);
    tm = fmaxf(tm, __shfl_xor(tm, 32));
    if (__any(tm > mrun)) {
        const float mn = fmaxf(mrun, tm);
        const float fs = __builtin_amdgcn_exp2f(mrun - mn);
        mrun = mn; lrun *= fs;
#pragma unroll
        for (int r = 0; r < 16; ++r) { o0[r] *= fs; o1[r] *= fs; }
    }
    float ps = 0.f;
#pragma unroll
    for (int r = 0; r < 16; ++r) { S[r] = __builtin_amdgcn_exp2f(S[r] - mrun); ps += S[r]; }
    lrun += ps;
    u32x4 w0, w1;
    w0.x = cvtpk(S[0], S[1]); w0.y = cvtpk(S[2], S[3]); w0.z = cvtpk(S[4], S[5]); w0.w = cvtpk(S[6], S[7]);
    w1.x = cvtpk(S[8], S[9]); w1.y = cvtpk(S[10], S[11]); w1.z = cvtpk(S[12], S[13]); w1.w = cvtpk(S[14], S[15]);
    pb0 = __builtin_bit_cast(bf16x8, w0); pb1 = __builtin_bit_cast(bf16x8, w1);
}
struct AttnState { f32x16 o0, o1; float m, l; };
__device__ __forceinline__ void attn_comp2(KFrag& fk, const VFrag& f, const bf16x8 (&qa)[4], const bf16x8 (&qb)[4], AttnState& A, AttnState& B,
                                           bool masked, const LAS float* bt, int relA, int idxA, int relB, int idxB, const bf16_t* kbase, int nextrow, const LAS unsigned char* kl, int nextlds) {
    f32x16 SA, SB;
#pragma unroll
    for (int r = 0; r < 16; ++r) { SA[r] = 0.f; SB[r] = 0.f; }
#pragma unroll
    for (int dk = 0; dk < 4; ++dk) { SA = MFMA32(fk.k[dk], qa[dk], SA); SB = MFMA32(fk.k[dk], qb[dk], SB); }
    if (nextlds >= 0) attn_loadk_lds(fk, kl, nextlds);
    else if (nextrow >= 0) attn_loadk(fk, kbase, nextrow);
    bf16x8 p0, p1;
    attn_soft(SA, A.o0, A.o1, A.m, A.l, masked, bt, relA, idxA, p0, p1);
    A.o0 = MFMA32(f.v[0], p0, A.o0); A.o0 = MFMA32(f.v[1], p1, A.o0); A.o1 = MFMA32(f.v[2], p0, A.o1); A.o1 = MFMA32(f.v[3], p1, A.o1);
    attn_soft(SB, B.o0, B.o1, B.m, B.l, masked, bt, relB, idxB, p0, p1);
    B.o0 = MFMA32(f.v[0], p0, B.o0); B.o0 = MFMA32(f.v[1], p1, B.o0); B.o1 = MFMA32(f.v[2], p0, B.o1); B.o1 = MFMA32(f.v[3], p1, B.o1);
}
__device__ __forceinline__ void attn_store(const AttnState& A, bf16_t* op) {
    const float lt = A.l + __shfl_xor(A.l, 32);
    const float inv = 1.0f / lt;
#pragma unroll
    for (int g4 = 0; g4 < 4; ++g4) {
        u32x2 w; w.x = cvtpk(A.o0[4 * g4] * inv, A.o0[4 * g4 + 1] * inv); w.y = cvtpk(A.o0[4 * g4 + 2] * inv, A.o0[4 * g4 + 3] * inv); *(u32x2*)(op + 8 * g4) = w;
        u32x2 z; z.x = cvtpk(A.o1[4 * g4] * inv, A.o1[4 * g4 + 1] * inv); z.y = cvtpk(A.o1[4 * g4 + 2] * inv, A.o1[4 * g4 + 3] * inv); *(u32x2*)(op + 32 + 8 * g4) = z;
    }
}

__device__ __forceinline__ void phase_mix(KParams P, int layer, LAS unsigned char* lds, int tid, int wave, int lane, int bx, int G) {
    unsigned char* ws = P->ws;
    const bf16_t* Qb = (const bf16_t*)(ws + WS_Q); const bf16_t* Kb = (const bf16_t*)(ws + WS_K); const bf16_t* Ub = (const bf16_t*)(ws + WS_U);
    const bf16_t* Vt = (const bf16_t*)(ws + WS_VT); bf16_t* MIXb = (bf16_t*)(ws + WS_MIX);
    LAS float* bt = (LAS float*)(lds + wave * 2560) + 64;
    const int vb = (G % 8 == 0) ? (bx % 8) * (G / 8) + bx / 8 : bx;
    const int gw = vb * NWAVES + wave, NGW = G * NWAVES;
    const int q = lane & 31, hi = lane >> 5, pi = (q & 0x13) | ((q & 4) << 1) | ((q & 8) >> 1);
    const int nunits = 2048 + ((layer == 0) ? 64 : 0);
    for (int un = gw; un < nunits; un += NGW) {
        int b, h, qrow0, r = 0; const bool local = un < 2048;
        if (local) { r = un & 127; h = (un >> 7) & 7; b = un >> 10; qrow0 = b * SEQ + r * 64; }
        else { const int v = un - 2048; const int qb = v & 3; h = (v >> 2) & 7; b = v >> 5; qrow0 = MX + b * CTXL + qb * 64; }
        if (local) {
            const float* rp = P->rpb + (size_t)(layer * NH + h) * 465;
            for (int i = lane; i < 465; i += 64) bt[i] = rp[i] * LOG2E;
        }
        const int crow0 = MX + b * CTXL;
        if (local) {
            const bf16_t* ksrc = Kb + (size_t)crow0 * 512 + h * 64; const bf16_t* vsrc = Vt + (size_t)(h * 64) * MT + crow0;
#pragma unroll
            for (int i = 0; i < 4; ++i) { const int c = tid + NTHREADS * i;
                *(LAS u32x4*)(lds + KL_OFF + (c >> 3) * KL_PITCH + (c & 7) * 16) = *(const u32x4*)(ksrc + (size_t)(c >> 3) * 512 + (c & 7) * 8);
                *(LAS u32x4*)(lds + VL_OFF + (c >> 5) * VL_PITCH + (c & 31) * 16) = *(const u32x4*)(vsrc + (size_t)(c >> 5) * MT + (c & 31) * 8); }
            __syncthreads();
        }
        const LAS unsigned char* kl = lds + KL_OFF + pi * KL_PITCH + hi * 16; const LAS unsigned char* vl = lds + VL_OFF + q * VL_PITCH + hi * 16;
        bf16x8 qa[4], qb4[4];
#pragma unroll
        for (int dk = 0; dk < 4; ++dk) { qa[dk] = *(const bf16x8*)(Qb + (size_t)(qrow0 + q) * 512 + h * 64 + dk * 16 + hi * 8);
                                         qb4[dk] = *(const bf16x8*)(Qb + (size_t)(qrow0 + 32 + q) * 512 + h * 64 + dk * 16 + hi * 8); }
        AttnState A, B;
#pragma unroll
        for (int i = 0; i < 16; ++i) { A.o0[i] = 0.f; A.o1[i] = 0.f; B.o0[i] = 0.f; B.o1[i] = 0.f; }
        A.m = -1e30f; A.l = 0.f; B.m = -1e30f; B.l = 0.f;
        const int rs = min(max(r - 4, 0), 120);
        const int jA = q, jB = 32 + q, csA = min(max(jA - 8, 0), 48), csB = min(max(jB - 8, 0), 48);
        const int lrow0 = b * SEQ + rs * 64;
        const bf16_t* kbase = Kb + (size_t)pi * 512 + h * 64 + hi * 8;
        const bf16_t* vbase = Vt + (size_t)(h * 64 + q) * MT + hi * 8;
        const int ntiles = local ? 24 : 8;
#define TROW(t) (((t) < 8) ? crow0 + 32 * (t) : lrow0 + 32 * ((t) - 8))
#define TCOMP(FK, FV, t, NXT) do { const int t_ = (t); const int kr_ = (t_ - 8) >> 1, ct_ = (t_ - 8) & 1; const int br_ = (rs + kr_ - r + 7) * 31 + ct_ * 32 + 8 * hi + 15; \
            int ra_ = ct_ * 32 + 8 * hi - csA, rb_ = ct_ * 32 + 8 * hi - csB; asm volatile("" : "+v"(ra_), "+v"(rb_));     \
            attn_comp2(FK, FV, qa, qb4, A, B, t_ >= 8, bt, ra_, br_ - jA, rb_, br_ - jB, kbase, (NXT), kl, (local && t_ + 1 < 8) ? t_ + 1 : -1); } while (0)
        KFrag k0; VFrag fv;
        if (local) attn_loadk_lds(k0, kl, 0); else attn_loadk(k0, kbase, TROW(0));
        asm volatile("s_waitcnt lgkmcnt(0)" ::: "memory");
        for (int t = 0; t < ntiles; ++t) {
            if (local && t < 8) attn_loadv_lds(fv, vl, t); else attn_loadv(fv, vbase, TROW(t));
            TCOMP(k0, fv, t, (t + 1 < ntiles) ? TROW(t + 1) : -1);
        }
#undef TROW
#undef TCOMP
        attn_store(A, MIXb + (size_t)(qrow0 + q) * 1024 + h * 64 + 4 * hi);
        attn_store(B, MIXb + (size_t)(qrow0 + 32 + q) * 1024 + h * 64 + 4 * hi);
        asm volatile("s_waitcnt lgkmcnt(0)" ::: "memory");
    }
    const int mrows = (layer == 0) ? MT : MX;
    const int nskip = (layer == 0) ? 64 : 0;
    if (gw < nskip) return;
    for (int wi = gw - nskip; wi < mrows; wi += NGW - nskip) {
        const int g = wi & 3, m = (wi & ~3) + (lane >> 4), ch = g * 16 + (lane & 15);
        int jj, len;
        if (m < MX) { jj = m & 63; len = 64; } else { jj = (m - MX) & 255; len = 256; }
        const int base = m - jj;
        float a[8];
#pragma unroll
        for (int e = 0; e < 8; ++e) a[e] = 0.f;
        const bf16_t* up = Ub + (size_t)base * 512 + ch * 8;
#define POOLW(W2) do { const int lo = max(jj - (W2), 0), hi2 = min(jj + (W2), len); u32x4 uv[2 * (W2)]; \
            _Pragma("unroll") for (int t = 0; t < 2 * (W2); ++t) uv[t] = *(const u32x4*)(up + (size_t)min(lo + t, hi2 - 1) * 512); \
            _Pragma("unroll") for (int t = 0; t < 2 * (W2); ++t) { const float wgt = (lo + t < hi2) ? 1.0f : 0.0f; \
                _Pragma("unroll") for (int e = 0; e < 4; ++e) { a[2 * e] += wgt * __uint_as_float(uv[t][e] << 16); a[2 * e + 1] += wgt * __uint_as_float(uv[t][e] & 0xffff0000u); } } \
            const float ic = 1.0f / (float)(hi2 - lo); _Pragma("unroll") for (int e = 0; e < 8; ++e) a[e] *= ic; } while (0)
        if (g == 0) POOLW(1); else if (g == 1) POOLW(2); else if (g == 2) POOLW(4); else POOLW(8);
#undef POOLW
        const u32x4 us = *(const u32x4*)(Ub + (size_t)m * 512 + ch * 8);
        u32x4 o;
#pragma unroll
        for (int e = 0; e < 4; ++e) o[e] = cvtpk(a[2 * e] - __uint_as_float(us[e] << 16), a[2 * e + 1] - __uint_as_float(us[e] & 0xffff0000u));
        *(u32x4*)(MIXb + (size_t)m * 1024 + 512 + ch * 8) = o;
    }
}

__device__ __forceinline__ void run_phase(KParams P, int ph, LAS unsigned char* lds, int tid, int wave, int lane, int bx, int G) {
    unsigned char* ws = P->ws;
    float* MOD = (float*)(ws + WS_MOD);
    bf16_t* XN = (bf16_t*)(ws + WS_XN); bf16_t* Yb = (bf16_t*)(ws + WS_Y); bf16_t* H = (bf16_t*)(ws + WS_H);
    float* CTXS = (float*)(ws + WS_CTXS);
    if (ph == 0) { phase_p0(P, lds, tid, wave, lane, bx, G); return; }
    const int l = (ph == NPHASE - 1) ? 2 : (ph - 1) / 10, s = (ph == NPHASE - 1) ? 0 : (ph - 1) % 10;
    const int Mlate = (l == 1) ? MX : MT;
    if (s == 0 || s == 3 || s == 7) {
        int yl = l, gidx = 5, gpi = 3, nl = l, npre = 4, nsh = 6, M = Mlate; bool hasY = true, hasXN = true, useIn = false; float coef = 1.0f;
        if (s == 0) { yl = (l > 0) ? l - 1 : 0; gidx = 8; gpi = 5; npre = 0; nsh = 0; M = MT; coef = 0.5f; hasY = (l > 0); useIn = (l == 0);
                      if (l == 2) { hasXN = false; M = MX; nl = 1; } }
        else if (s == 3) { gidx = 2; gpi = 1; npre = 2; nsh = 3; M = MT; coef = 0.5f; useIn = (l == 0); }
        RowPass R;
        R.srcX = P->x; R.srcXb = useIn ? (const bf16_t*)nullptr : (const bf16_t*)(ws + WS_XS); R.srcC = useIn ? P->ctx : (const float*)CTXS;
        R.dstX = P->out; R.dstXb = (l == 2) ? (bf16_t*)nullptr : (bf16_t*)(ws + WS_XS); R.dstC = CTXS;
        R.YP = (const float*)(ws + WS_YP); R.nparts = (s == 7) ? 4 : 11;
        R.Yb = Yb; R.XN = XN; R.hasY = hasY; R.hasXN = hasXN; R.M = M; R.coef = coef;
        R.gate = MOD + (size_t)yl * 3 * NMODW + gidx * DM; R.gpost = P->normg + (yl * 6 + gpi) * DM;
        R.gpre = P->normg + (nl * 6 + npre) * DM; R.shift = MOD + (size_t)nl * 3 * NMODW + nsh * DM; R.scale = R.shift + DM;
        phase_row(R, lds, tid, wave, lane, bx, G);
        return;
    }
    if (s == 5) { phase_mix(P, l, lds, tid, wave, lane, bx, G); return; }
    const bool split = (s == 2 || s == 9 || s == 6) && (Mlate == MT || s == 2);
    const int npass = (s == 4 || split) ? 2 : 1;
    for (int pass = 0; pass < npass; ++pass) {
        pg8::Gemm g; EpiAny E; E.ropeC = (const float*)(ws + WS_ROPEC); E.ropeS = (const float*)(ws + WS_ROPES); E.pstride = 0; E.ntp = 0; int cu = bx, pm0 = 0, ksplit = 1, ntp = 0;
        if (s == 1 || s == 8) {
            const int sub = (s == 1) ? 0 : 1; const int M = (s == 1) ? MT : Mlate;
            g = pg8::Gemm{XN, (const bf16_t*)(ws + WS_WGU) + (size_t)(l * 2 + sub) * 5632 * 1024, M, 5632, 1024, 1024};
            E.mode = EPI_SWIGLU; E.perm = true; E.O = H; E.ldc = DFF;
        } else if (s == 6 || s == 2 || s == 9) {
            const bf16_t* A; const bf16_t* Bt; int K;
            if (s == 6) { A = (const bf16_t*)(ws + WS_MIX); Bt = (const bf16_t*)(ws + WS_WOUT) + (size_t)l * 1024 * 1024; K = 1024; }
            else { const int sub = (s == 2) ? 0 : 1; A = H; Bt = (const bf16_t*)(ws + WS_WD) + (size_t)(l * 2 + sub) * 1024 * DFF; K = DFF; }
            E.mode = EPI_F32; E.perm = false; E.ldc = 1024;
            if (pass == 0) { g = pg8::Gemm{A, Bt, MX, 1024, K, K}; E.mode = EPI_BF16; E.perm = true; E.O = Yb; }
            else { ntp = 4; ksplit = K / 256; pm0 = MX / 256; g = pg8::Gemm{A, Bt, MC, 1024, 256, K};
                   E.O = (float*)(ws + WS_YP) - (size_t)MX * 1024; E.pstride = MC * 1024; E.ntp = 4; }
        } else {
            const bf16_t* Wt = (const bf16_t*)(ws + WS_WIN) + (size_t)l * INW * 1024;
            if (pass == 0) { g = pg8::Gemm{XN, Wt, MT, 1536, 1024, 1024}; E.mode = EPI_QKU; E.perm = false; E.O = ws + WS_Q; E.ldc = 512; }
            else { g = pg8::Gemm{Wt + (size_t)1536 * 1024, XN, 512, MT, 1024, 1024}; E.mode = EPI_BF16; E.perm = true; E.O = ws + WS_VT; E.ldc = MT; cu = G - 1 - bx; }
        }
        pg8::StaticOrder S; S.init(g.M, g.N, G, cu, pm0, ksplit, ntp);
        pg8::gemm_phase<EpiAny, pg8::StaticOrder, true, true>(lds, g, S, E);
    }
}

__global__ void __launch_bounds__(NTHREADS, 2) mega(Params P, int ph_lo, int ph_hi) {
    extern __shared__ __attribute__((aligned(16))) unsigned char lds_raw[];
    LAS unsigned char* lds = (LAS unsigned char*)lds_raw;
    cg::grid_group grid = cg::this_grid();
    volatile LAS unsigned* bst = (volatile LAS unsigned*)(lds + 131072 + 64);
    if (threadIdx.x < 2) bst[threadIdx.x] = 0u;
    __syncthreads();
    XcdBarrier bar;
    { KParams kp0 = (KParams)__builtin_amdgcn_kernarg_segment_ptr(); bar = xcd_barrier_post((unsigned*)(kp0->ws + WS_BAR), bst); }
    KParams kp = (KParams)__builtin_amdgcn_kernarg_segment_ptr();
#if defined(PROBE_REP_PH)
    const int nextra = PROBE_REPS - 1;
#else
    const int nextra = 0;
#endif
    const int nsteps = ph_hi - ph_lo + nextra;
    for (int step = 0; step < nsteps; ++step) {
        int ph = ph_lo + step;
#if defined(PROBE_REP_PH)
        if (ph > PROBE_REP_PH) ph = (ph <= PROBE_REP_PH + nextra) ? PROBE_REP_PH : ph - nextra;
#endif
        asm volatile("" : "+s"(kp));
        int tid = threadIdx.x; asm volatile("" : "+v"(tid));
        const int lane = tid & 63, wave = __builtin_amdgcn_readfirstlane(tid >> 6);
        int bx = blockIdx.x, G = gridDim.x; asm volatile("" : "+s"(bx), "+s"(G));
        run_phase(kp, ph, lds, tid, wave, lane, bx, G);
        if (step + 1 < nsteps) { if (ph_lo < 0) grid.sync(); else xcd_barrier(bar); }
    }
}

extern "C" void kernel_launch(void* const* d_in, const int* in_sizes, int n_in, void* d_out, int out_size, void* d_ws, size_t ws_size, hipStream_t stream) {
    static int grid = 0;
    if (grid == 0) {
        if (n_in != 14 || in_sizes[0] != MX * DM || out_size != MX * DM || ws_size < WS_END) {
            fprintf(stderr, "kernel_launch: unexpected shapes (n_in %d, in0 %d, out %d, ws %zu < %zu)\n", n_in, n_in > 0 ? in_sizes[0] : -1, out_size, ws_size, (size_t)WS_END); grid = -1; return; }
        int dev = 0, cus = 0, per_cu = 0;
        (void)hipGetDevice(&dev); (void)hipDeviceGetAttribute(&cus, hipDeviceAttributeMultiprocessorCount, dev);
        if (hipFuncSetAttribute((const void*)mega, hipFuncAttributeMaxDynamicSharedMemorySize, LDS_BYTES) != hipSuccess) { fprintf(stderr, "kernel_launch: hipFuncSetAttribute failed\n"); grid = -1; return; }
        if (hipOccupancyMaxActiveBlocksPerMultiprocessor(&per_cu, (const void*)mega, NTHREADS, LDS_BYTES) != hipSuccess || per_cu < 1) { fprintf(stderr, "kernel_launch: occupancy query gave %d\n", per_cu); per_cu = 1; }
        (void)hipGetLastError();
        grid = cus * 1;
        if (grid <= 0) grid = 256;
    }
    if (grid < 0) return;
    if (hipMemsetAsync((char*)d_ws + WS_BAR, 0, 65536, stream) != hipSuccess) { fprintf(stderr, "kernel_launch: memset failed\n"); return; }
    Params p{};
    p.x = (const float*)d_in[0]; p.c = (const float*)d_in[1]; p.ctx = (const float*)d_in[2]; p.cctx = (const float*)d_in[3];
    p.wmod = (const float*)d_in[4]; p.bmod = (const float*)d_in[5]; p.normg = (const float*)d_in[6]; p.wgu = (const float*)d_in[7];
    p.wd = (const float*)d_in[8]; p.win = (const float*)d_in[9]; p.wout = (const float*)d_in[10]; p.rpb = (const float*)d_in[11];
    p.wpool = (const float*)d_in[12]; p.pscale = (const float*)d_in[13];
    p.out = (float*)d_out; p.ws = (unsigned char*)d_ws;
#if MK_MULTI
    for (int ph = 0; ph < NPHASE; ++ph) {
        int lo = ph, hi = ph + 1; void* args[] = {&p, &lo, &hi};
        hipError_t e = hipLaunchCooperativeKernel((const void*)mega, dim3(grid), dim3(NTHREADS), args, LDS_BYTES, stream);
        if (e != hipSuccess) { fprintf(stderr, "launch %d failed: %s\n", ph, hipGetErrorString(e)); break; }
    }
#else
#ifndef MK_PH_HI
#define MK_PH_HI NPHASE
#endif
#ifndef MK_PH_LO
#define MK_PH_LO 0
#endif
    int lo = MK_PH_LO, hi = MK_PH_HI; void* args[] = {&p, &lo, &hi};
    hipError_t e = hipLaunchCooperativeKernel((const void*)mega, dim3(grid), dim3(NTHREADS), args, LDS_BYTES, stream);
    if (e != hipSuccess) fprintf(stderr, "cooperative launch failed: %s (grid %d)\n", hipGetErrorString(e), grid);
#endif
}
```

```cpp
#include <hip/hip_runtime.h>
#include <hip/hip_cooperative_groups.h>
#include <cstdio>
#include <cstdint>
namespace cg = cooperative_groups;
namespace pg8 {
#define PG8_LAS __attribute__((address_space(3)))
typedef unsigned short bf16_t;
typedef short bf16x8 __attribute__((ext_vector_type(8)));
typedef float f32x4 __attribute__((ext_vector_type(4)));
typedef unsigned u32x4 __attribute__((ext_vector_type(4)));
constexpr int BM = 256, BK = 64, HALF = 128, HTB = HALF * BK * 2  , STAGE_BYTES = 8 * HTB, NXCD = 8, WGM = 8;

__host__ __device__ __forceinline__ int lds_byte(int r, int c) { const int st = (r >> 4) * 2 + (c >> 5), rr = r & 15, cc = c & 31, ob = rr * 64 + cc * 2; return st * 1024 + (ob ^ (((ob >> 9) & 1) << 5)); }
__host__ __device__ __forceinline__ void stage_rc(int b, int& R, int& C) { const int st = b / 1024, sb = b % 1024, swz = sb ^ (((sb >> 9) & 1) << 5); R = (st >> 1) * 16 + swz / 64; C = (st & 1) * 32 + (swz % 64) / 2; }
__host__ __device__ __forceinline__ int perm32(int rho) { const int n = rho >> 4, i = rho & 15; return 8 * (i >> 2) + 4 * n + (i & 3); }

struct Unit { int pm, pn, kb; };
struct Gemm { const bf16_t* A; const bf16_t* Bt; int M, N, K, ld; };

struct StaticOrder {
    int nM, nN, nwg, G, c, pm0, ksplit, ntp;
    __host__ __device__ void init(int M, int N, int G_, int c_, int pm0_ = 0, int ksplit_ = 1, int ntp_ = 0) { nM = M / BM; nN = N / BM; nwg = nM * nN * ksplit_; G = G_; c = c_; pm0 = pm0_; ksplit = ksplit_; ntp = ntp_; }
    __host__ __device__ bool next(int i, Unit& u) const {
        const long L = (long)i * G + c; if (L >= nwg) return false;
        int wgid = (int)L; u.kb = (wgid % ksplit) * ntp; wgid /= ksplit; { const int nwg = nM * nN; const int q = nwg / NXCD, r = nwg % NXCD, xcd = wgid % NXCD, off = wgid / NXCD; wgid = (xcd < r ? xcd * (q + 1) : r * (q + 1) + (xcd - r) * q) + off; }
        const int nig = WGM * nN, gid = wgid / nig, fm = gid * WGM, gsz = (nM - fm) < WGM ? (nM - fm) : WGM;
        u.pm = pm0 + fm + ((wgid % nig) % gsz); u.pn = (wgid % nig) / gsz; return true;
    }
    __device__ __forceinline__ void a_ready(const Unit&) const {}
    __device__ __forceinline__ void done(const Unit&) const {}
};

__device__ __forceinline__ unsigned cvt_pk_bf16(float lo, float hi) { unsigned r; asm volatile("v_cvt_pk_bf16_f32 %0, %1, %2" : "=v"(r) : "v"(lo), "v"(hi)); return r; }
typedef float f32x2 __attribute__((ext_vector_type(2)));
template <class Epi, class Sched, bool ALIGN_EPI = false, bool SP2 = false>
__device__ __forceinline__ void gemm_phase(PG8_LAS unsigned char* lds, const Gemm g, const Sched& S, const Epi& E) {
    int tid_raw = threadIdx.x; asm volatile("" : "+v"(tid_raw));
    const int tid = tid_raw, wid = __builtin_amdgcn_readfirstlane(tid >> 6), lane = tid & 63, wr = wid >> 2, wc = wid & 3, fr = lane & 15, fq = lane >> 4;
    const int K = g.ld, nt = g.K / BK;
    unsigned voffA[2], voffB[2];
#pragma unroll
    for (int i = 0; i < 2; ++i) { int R, C; stage_rc(tid * 16 + i * 8192, R, C); const int Rb = E.perm ? ((R & ~31) + perm32(R & 31)) : R;
        voffA[i] = (unsigned)(R * K + C) * 2u; voffB[i] = (unsigned)(Rb * K + C) * 2u; }
    const size_t kstep = (size_t)(BK * 2);
    const size_t hstep = (size_t)HALF * K * 2;
    const size_t tstep = 2 * hstep;
    const unsigned ldsw = (unsigned)wid * 1024u;
    const int aoff = lds_byte(wr * 64 + fr, fq * 8), boff = lds_byte(wc * 32 + fr, fq * 8);
#define PG8_SA(b, h) (((b) * 2 + (h)) * HTB)
#define PG8_SB(b, h) ((4 + (b) * 2 + (h)) * HTB)
#define PG8_STAGE(bufoff, gbase, voff) do { _Pragma("unroll") for (int _i = 0; _i < 2; ++_i) \
        __builtin_amdgcn_global_load_lds((const unsigned*)((const char*)(gbase) + (voff)[_i]), (PG8_LAS unsigned*)(lds + (bufoff) + ldsw + _i * 8192), 16, 0, 0); } while (0)
#define PG8_LDA(dst, b, h) do { _Pragma("unroll") for (int m = 0; m < 4; ++m) _Pragma("unroll") for (int k = 0; k < 2; ++k) dst[m][k] = *(const PG8_LAS bf16x8*)(lds + PG8_SA(b, h) + aoff + m * 2048 + k * 1024); } while (0)
#define PG8_LDB(dst, b, h) do { _Pragma("unroll") for (int n = 0; n < 2; ++n) _Pragma("unroll") for (int k = 0; k < 2; ++k) dst[n][k] = *(const PG8_LAS bf16x8*)(lds + PG8_SB(b, h) + boff + n * 2048 + k * 1024); } while (0)
#define PG8_MMA(ai, bj, At, Bt) do { __builtin_amdgcn_s_setprio(1); _Pragma("unroll") for (int m = 0; m < 4; ++m) _Pragma("unroll") for (int n = 0; n < 2; ++n) _Pragma("unroll") for (int k = 0; k < 2; ++k) \
        acc[ai][bj][m][n] = __builtin_amdgcn_mfma_f32_16x16x32_bf16(Bt[n][k], At[m][k], acc[ai][bj][m][n], 0, 0, 0); __builtin_amdgcn_s_setprio(0); } while (0)
#define PG8_WAIT_V(n) asm volatile("s_waitcnt vmcnt(" #n ")" ::: "memory")
#define PG8_WAIT_L(n) asm volatile("s_waitcnt lgkmcnt(" #n ")" ::: "memory")
#define PG8_BAR __builtin_amdgcn_s_barrier()
#define PG8_SCHED __builtin_amdgcn_sched_barrier(0)
    Unit cur, nxt; int ui = 0;
    if (!S.next(0, cur)) return;
    f32x4 acc[2][2][4][2];
#pragma unroll
    for (int a = 0; a < 2; ++a)
#pragma unroll
        for (int b = 0; b < 2; ++b)
#pragma unroll
            for (int m = 0; m < 4; ++m)
#pragma unroll
                for (int n = 0; n < 2; ++n) acc[a][b][m][n] = (f32x4){0.f, 0.f, 0.f, 0.f};
    bf16x8 At[4][2], B0[2][2], B1[2][2];
    const char* cA = (const char*)g.A + (size_t)cur.pm * tstep + (size_t)cur.kb * (BK * 2); const char* cB = (const char*)g.Bt + (size_t)cur.pn * tstep + (size_t)cur.kb * (BK * 2);
    S.a_ready(cur);
    if constexpr (SP2) {
        PG8_STAGE(PG8_SB(0, 0), cB, voffB); PG8_STAGE(PG8_SB(0, 1), cB + hstep, voffB); PG8_STAGE(PG8_SA(0, 0), cA, voffA); PG8_STAGE(PG8_SA(0, 1), cA + hstep, voffA);
        if (wr == 1) PG8_BAR;
        PG8_WAIT_V(2); PG8_BAR;
        PG8_STAGE(PG8_SB(1, 0), cB + kstep, voffB); PG8_STAGE(PG8_SA(1, 0), cA + kstep, voffA); PG8_STAGE(PG8_SB(1, 1), cB + hstep + kstep, voffB);
        PG8_WAIT_V(6); PG8_BAR;
    } else {
        PG8_STAGE(PG8_SB(0, 0), cB, voffB); PG8_STAGE(PG8_SA(0, 0), cA, voffA); PG8_STAGE(PG8_SB(0, 1), cB + hstep, voffB); PG8_STAGE(PG8_SA(0, 1), cA + hstep, voffA);
        if (wr == 1) PG8_BAR;
        PG8_WAIT_V(4); PG8_BAR;
        PG8_STAGE(PG8_SB(1, 0), cB + kstep, voffB); PG8_STAGE(PG8_SA(1, 0), cA + kstep, voffA); PG8_STAGE(PG8_SB(1, 1), cB + hstep + kstep, voffB);
        PG8_WAIT_V(6); PG8_BAR;
    }
    for (;;) {
        const bool has_next = S.next(ui + 1, nxt);
        const char* nA = has_next ? (const char*)g.A + (size_t)nxt.pm * tstep + (size_t)nxt.kb * (BK * 2) : cA; const char* nB = has_next ? (const char*)g.Bt + (size_t)nxt.pn * tstep + (size_t)nxt.kb * (BK * 2) : cB;
        for (int t = 0; t < nt; t += 2) {
            const bool last = (t == nt - 2);
            const char* a1 = cA + (size_t)(t + 1) * kstep;
            const char* a2 = last ? nA : cA + (size_t)(t + 2) * kstep; const char* b2 = last ? nB : cB + (size_t)(t + 2) * kstep;
            const char* a3 = a2 + kstep; const char* b3 = b2 + kstep;
            if (last && has_next) S.a_ready(nxt);
            if constexpr (SP2) {
            PG8_LDB(B0, 0, 0); PG8_LDB(B1, 0, 1); PG8_SCHED; PG8_LDA(At, 0, 0); PG8_STAGE(PG8_SA(1, 1), a1 + hstep, voffA);
            PG8_WAIT_V(8); PG8_WAIT_L(0); PG8_BAR; PG8_MMA(0, 0, At, B0); PG8_MMA(0, 1, At, B1); PG8_BAR; PG8_SCHED;
            PG8_LDA(At, 0, 1); PG8_STAGE(PG8_SB(0, 0), b2, voffB); PG8_STAGE(PG8_SB(0, 1), b2 + hstep, voffB); PG8_STAGE(PG8_SA(0, 0), a2, voffA);
            PG8_WAIT_V(8); PG8_WAIT_L(0); PG8_BAR; PG8_MMA(1, 0, At, B0); PG8_MMA(1, 1, At, B1); PG8_BAR; PG8_SCHED;
            PG8_LDB(B0, 1, 0); PG8_LDB(B1, 1, 1); PG8_SCHED; PG8_LDA(At, 1, 0); PG8_STAGE(PG8_SA(0, 1), a2 + hstep, voffA);
            PG8_WAIT_V(8); PG8_WAIT_L(0); PG8_BAR; PG8_MMA(0, 0, At, B0); PG8_MMA(0, 1, At, B1); PG8_BAR; PG8_SCHED;
            PG8_LDA(At, 1, 1); PG8_STAGE(PG8_SB(1, 0), b3, voffB); PG8_STAGE(PG8_SB(1, 1), b3 + hstep, voffB); PG8_STAGE(PG8_SA(1, 0), a3, voffA);
            PG8_WAIT_V(8); PG8_WAIT_L(0); PG8_BAR; PG8_MMA(1, 0, At, B0); PG8_MMA(1, 1, At, B1); PG8_BAR; PG8_SCHED;
            } else {
            PG8_LDB(B0, 0, 0); PG8_SCHED; PG8_LDA(At, 0, 0); PG8_STAGE(PG8_SA(1, 1), a1 + hstep, voffA);
            PG8_WAIT_L(8); PG8_BAR; PG8_WAIT_L(0); PG8_MMA(0, 0, At, B0); PG8_BAR; PG8_SCHED;
            PG8_LDB(B1, 0, 1); PG8_STAGE(PG8_SB(0, 0), b2, voffB);
            PG8_BAR; PG8_WAIT_L(0); PG8_MMA(0, 1, At, B1); PG8_BAR;
            PG8_LDA(At, 0, 1); PG8_STAGE(PG8_SA(0, 0), a2, voffA);
            PG8_BAR; PG8_WAIT_L(0); PG8_MMA(1, 0, At, B0); PG8_BAR; PG8_SCHED;
            PG8_STAGE(PG8_SB(0, 1), b2 + hstep, voffB);
            PG8_WAIT_V(6); PG8_BAR; PG8_MMA(1, 1, At, B1); PG8_BAR;
            PG8_LDB(B0, 1, 0); PG8_SCHED; PG8_LDA(At, 1, 0); PG8_STAGE(PG8_SA(0, 1), a2 + hstep, voffA);
            PG8_WAIT_L(8); PG8_BAR; PG8_WAIT_L(0); PG8_MMA(0, 0, At, B0); PG8_BAR; PG8_SCHED;
            PG8_LDB(B1, 1, 1); PG8_STAGE(PG8_SB(1, 0), b3, voffB);
            PG8_BAR; PG8_WAIT_L(0); PG8_MMA(0, 1, At, B1); PG8_BAR;
            PG8_LDA(At, 1, 1); PG8_STAGE(PG8_SA(1, 0), a3, voffA);
            PG8_BAR; PG8_WAIT_L(0); PG8_MMA(1, 0, At, B0); PG8_BAR; PG8_SCHED;
            PG8_STAGE(PG8_SB(1, 1), b3 + hstep, voffB);
            PG8_WAIT_V(6); PG8_BAR; PG8_MMA(1, 1, At, B1); PG8_BAR;
            }
        }
        if constexpr (ALIGN_EPI) { if (wr == 0) PG8_BAR; }
        if constexpr (!Epi::AFTER_DRAIN) { E(acc, cur, wr, wc, fr, fq); S.done(cur); }
        if (!has_next) break;
#pragma unroll
        for (int a = 0; a < 2; ++a)
#pragma unroll
            for (int b = 0; b < 2; ++b)
#pragma unroll
                for (int m = 0; m < 4; ++m)
#pragma unroll
                    for (int n = 0; n < 2; ++n) acc[a][b][m][n] = (f32x4){0.f, 0.f, 0.f, 0.f};
        cur = nxt; cA = nA; cB = nB; ++ui;
        if constexpr (ALIGN_EPI) { if (wr == 1) PG8_BAR; }
    }
    PG8_WAIT_V(0);
    if constexpr (!ALIGN_EPI) { if (wr == 0) PG8_BAR; }
    PG8_BAR;
    if constexpr (Epi::AFTER_DRAIN) { E.fused(acc, cur, wr, wc, fr, fq, lds, wid, lane); S.done(cur); }
#undef PG8_SA
#undef PG8_SB
#undef PG8_STAGE
#undef PG8_LDA
#undef PG8_LDB
#undef PG8_MMA
#undef PG8_WAIT_V
#undef PG8_WAIT_L
#undef PG8_BAR
#undef PG8_SCHED
}
}

#ifndef MK_MULTI
#define MK_MULTI 0
#endif
typedef unsigned short bf16_t;
typedef short bf16x8 __attribute__((ext_vector_type(8)));
typedef float f32x4 __attribute__((ext_vector_type(4)));
typedef float f32x16 __attribute__((ext_vector_type(16)));
typedef unsigned u32x4 __attribute__((ext_vector_type(4)));
typedef unsigned u32x2 __attribute__((ext_vector_type(2)));
typedef float f32x2_t __attribute__((ext_vector_type(2)));
typedef __bf16 bf16x2_t __attribute__((ext_vector_type(2)));
#define LAS __attribute__((address_space(3)))

constexpr int DM = 1024, SEQ = 8192, NB = 2, CTXL = 256, MX = NB * SEQ, MC = NB * CTXL, MT = MX + MC;
constexpr int DFF = 2816, NH = 8, HD = 64, INW = 2048, NMODW = 9 * DM;
constexpr float RMS_EPS = 1e-6f;
constexpr float LOG2E = 1.4426950408889634f;
constexpr float QSCALE = 0.125f * LOG2E;
constexpr int NPHASE = 22;
constexpr int NTHREADS = 512, NWAVES = 8;
constexpr int LDS_BYTES = 147456;

constexpr size_t MiB = 1u << 20;
constexpr size_t WS_MOD = 0;
constexpr size_t WS_ROPEC = 256 * 1024;
constexpr size_t WS_ROPES = 256 * 1024 + 8192;
constexpr size_t WS_BAR = 3 * MiB;
constexpr size_t WS_CTXS = 512 * 1024;
constexpr size_t WS_WGU = 4 * MiB;
constexpr size_t WS_WD = 48 * MiB;
constexpr size_t WS_WIN = 70 * MiB;
constexpr size_t WS_WOUT = 78 * MiB;
constexpr size_t WS_XN = 82 * MiB;
constexpr size_t WS_Y = 115 * MiB;
constexpr size_t WS_XS = 147 * MiB;
constexpr size_t WS_H = 211 * MiB;
constexpr size_t SZ_QK = (size_t)MT * 512 * 2;
constexpr size_t WS_Q = WS_H, WS_K = WS_Q + SZ_QK, WS_U = WS_K + SZ_QK, WS_VT = WS_U + SZ_QK, WS_MIX = WS_VT + SZ_QK;
constexpr size_t WS_YP = WS_MIX + (size_t)MT * 1024 * 2;
constexpr size_t WS_END = WS_YP + (size_t)11 * MC * 1024 * 4;
static_assert(WS_XN + (size_t)MT * 1024 * 2 <= WS_Y && WS_Y + (size_t)MX * 1024 * 2 <= WS_XS && WS_XS + (size_t)MX * 1024 * 4 <= WS_H && WS_H + (size_t)MT * DFF * 2 <= WS_YP, "ws map");

struct Params {
    const float *x, *c, *ctx, *cctx, *wmod, *bmod, *normg, *wgu, *wd, *win, *wout, *rpb, *wpool, *pscale;
    float* out; unsigned char* ws;
};
typedef const __attribute__((address_space(4))) Params* KParams;

__device__ __forceinline__ unsigned cvtpk(float lo, float hi) { f32x2_t v = {lo, hi}; bf16x2_t b = __builtin_convertvector(v, bf16x2_t); return __builtin_bit_cast(unsigned, b); }
__device__ __forceinline__ float bf2f(unsigned short h) { return __uint_as_float(((unsigned)h) << 16); }
__device__ __forceinline__ float wave_sum(float v) {
#define WS_DPP(ctrl, rmask) { const int x_ = __builtin_amdgcn_update_dpp(0, __float_as_int(v), (ctrl), (rmask), 0xf, false); v += __int_as_float(x_); }
    WS_DPP(0xB1, 0xf) WS_DPP(0x4E, 0xf) WS_DPP(0x141, 0xf) WS_DPP(0x140, 0xf) WS_DPP(0x142, 0xa) WS_DPP(0x143, 0xc)
#undef WS_DPP
    return __int_as_float(__builtin_amdgcn_readlane(__float_as_int(v), 63));
}

#define XB_TMO      128
#define XB_XCNT(j)  (256  + 64 * (j))
#define XB_XSUB(j)  (1280 + 64 * (j))
#define XB_XGEN(j)  (2304 + 64 * (j))
#define XB_TOP      3328
#define XB_TOPGEN   3392
#define XCD_BAR_WORDS 3456
#define XB_SPIN_CAP (1u << 18)

__device__ __forceinline__ unsigned xb_ld(unsigned* p)              { return __hip_atomic_load(p, __ATOMIC_RELAXED, __HIP_MEMORY_SCOPE_AGENT); }
__device__ __forceinline__ unsigned xb_add(unsigned* p, unsigned v) { return __hip_atomic_fetch_add(p, v, __ATOMIC_RELAXED, __HIP_MEMORY_SCOPE_AGENT); }
__device__ __forceinline__ unsigned xb_xcc_id() { return (unsigned)__builtin_amdgcn_s_getreg((3 << 11) | 20) & 0xFu; }
#define XB_SPIN(cond, bar) do { unsigned _sp = 0; while (cond) { __builtin_amdgcn_s_sleep(1); \
    if ((++_sp & 255u) == 0u) { if (xb_ld(&(bar)[XB_TMO])) break; if (_sp > XB_SPIN_CAP) { atomicAdd(&(bar)[XB_TMO], 1u); break; } } } } while (0)

struct XcdBarrier {
    unsigned* bar; unsigned x;
    volatile LAS unsigned* st;
};

__device__ __forceinline__ XcdBarrier xcd_barrier_post(unsigned* bar, volatile LAS unsigned* st) {
    XcdBarrier b; b.bar = bar; b.x = xb_xcc_id(); b.st = st;
    if (threadIdx.x == 0) (void)xb_add(&bar[XB_XCNT(b.x)], 1u);
    return b;
}
__device__ __forceinline__ void xcd_barrier_complete(unsigned* bar, unsigned x, unsigned& nloc, unsigned& nx) {
    const unsigned G = gridDim.x * gridDim.y * gridDim.z;
    unsigned sum, cnt, mine, sp = 0u;
    for (;;) {
        sum = 0u; cnt = 0u; mine = 0u;
#pragma unroll
        for (unsigned j = 0; j < 16; ++j) { const unsigned c = xb_ld(&bar[XB_XCNT(j)]); sum += c; cnt += (c > 0u) ? 1u : 0u; mine = (j == x) ? c : mine; }
        if (sum == G) break;
        __builtin_amdgcn_s_sleep(1);
        if ((++sp & 255u) == 0u) { if (xb_ld(&bar[XB_TMO])) break; if (sp > XB_SPIN_CAP) { atomicAdd(&bar[XB_TMO], 1u); break; } }
    }
    nloc = mine > 0u ? mine : 1u; nx = cnt > 0u ? cnt : 1u;
}

__device__ __forceinline__ void xcd_barrier(const XcdBarrier& b) {
    asm volatile("s_waitcnt vmcnt(0)" ::: "memory");
    __syncthreads();
    if (threadIdx.x == 0) {
        unsigned* bar = b.bar;
        __builtin_amdgcn_s_waitcnt(0);
        unsigned nloc = b.st[0], nx = b.st[1];
        if (nloc == 0u) { xcd_barrier_complete(bar, b.x, nloc, nx); b.st[0] = nloc; b.st[1] = nx; }
        const unsigned old = xb_add(&bar[XB_XSUB(b.x)], 1u);
        const unsigned gen = old / nloc;
        if (old + 1u == (gen + 1u) * nloc) {
            __builtin_amdgcn_fence(__ATOMIC_RELEASE, "agent");
            asm volatile("s_waitcnt vmcnt(0)" ::: "memory");
            const unsigned og = xb_add(&bar[XB_TOP], 1u);
            const unsigned tg = og / nx;
            if (og + 1u == (tg + 1u) * nx) xb_add(&bar[XB_TOPGEN], 1u);
            else XB_SPIN(xb_ld(&bar[XB_TOPGEN]) == tg, bar);
            __builtin_amdgcn_fence(__ATOMIC_ACQUIRE, "agent");
            xb_add(&bar[XB_XGEN(b.x)], 1u);
            asm volatile("s_waitcnt vmcnt(0)" ::: "memory");
        } else {
            XB_SPIN(xb_ld(&bar[XB_XGEN(b.x)]) == gen, bar);
            __builtin_amdgcn_fence(__ATOMIC_ACQUIRE, "agent");
            asm volatile("s_waitcnt vmcnt(0)" ::: "memory");
        }
    }
    __syncthreads();
}

using pg8::Unit;
enum { EPI_SWIGLU = 0, EPI_F32 = 1, EPI_QKU = 2, EPI_BF16 = 3 };
struct EpiAny {
    static constexpr bool AFTER_DRAIN = false;
    int mode; bool perm; void* O; int ldc; const float *ropeC, *ropeS; int pstride, ntp;
    __device__ __forceinline__ static float sw(float g, float u) { return g * u * __builtin_amdgcn_rcpf(1.0f + __builtin_amdgcn_exp2f(-g * LOG2E)); }
    __device__ __forceinline__ void operator()(const f32x4 (&acc)[2][2][4][2], const Unit& u, int wr, int wc, int fr, int fq) const {
        if (mode == EPI_SWIGLU) {
            bf16_t* H = (bf16_t*)O;
            const int row0 = u.pm * 256 + wr * 64 + fr, col0 = u.pn * 128 + wc * 32 + 8 * fq;
#pragma unroll
            for (int ai = 0; ai < 2; ++ai)
#pragma unroll
                for (int m = 0; m < 4; ++m) {
                    bf16_t* p = H + (size_t)(row0 + ai * 128 + m * 16) * DFF + col0;
                    const f32x4 g0 = acc[ai][0][m][0], g1 = acc[ai][0][m][1], u0 = acc[ai][1][m][0], u1 = acc[ai][1][m][1];
                    f32x4 e0 = g0 * (-LOG2E), e1 = g1 * (-LOG2E);
#pragma unroll
                    for (int i = 0; i < 4; ++i) { e0[i] = __builtin_amdgcn_exp2f(e0[i]); e1[i] = __builtin_amdgcn_exp2f(e1[i]); }
                    e0 = e0 + 1.0f; e1 = e1 + 1.0f;
#pragma unroll
                    for (int i = 0; i < 4; ++i) { e0[i] = __builtin_amdgcn_rcpf(e0[i]); e1[i] = __builtin_amdgcn_rcpf(e1[i]); }
                    const f32x4 o0 = (g0 * u0) * e0, o1 = (g1 * u1) * e1;
                    u32x4 w; w.x = cvtpk(o0[0], o0[1]); w.y = cvtpk(o0[2], o0[3]); w.z = cvtpk(o1[0], o1[1]); w.w = cvtpk(o1[2], o1[3]);
                    *(u32x4*)p = w;
                }
        } else if (mode == EPI_F32) {
            float* Y = (float*)O + ((ntp > 0) ? (size_t)(u.kb / ntp) * (size_t)pstride : (size_t)0);
            const int row0 = u.pm * 256 + wr * 64 + fr, col0 = u.pn * 256 + wc * 32 + 4 * fq;
#pragma unroll
            for (int ai = 0; ai < 2; ++ai)
#pragma unroll
                for (int m = 0; m < 4; ++m) {
                    float* p = Y + (size_t)(row0 + ai * 128 + m * 16) * ldc + col0;
#pragma unroll
                    for (int bj = 0; bj < 2; ++bj)
#pragma unroll
                        for (int n = 0; n < 2; ++n) *(f32x4*)(p + bj * 128 + n * 16) = acc[ai][bj][m][n];
                }
        } else if (mode == EPI_QKU) {
            const int t = u.pn >> 1; bf16_t* base = (bf16_t*)O + (size_t)t * ((size_t)MT * 512);
            const float sc = (t == 0) ? QSCALE : 1.0f;
            const bool rope = (t < 2) && (u.pm < MX / 256);
            const int cb = (u.pn & 1) * 256 + wc * 32 + 4 * fq;
#pragma unroll
            for (int ai = 0; ai < 2; ++ai)
#pragma unroll
                for (int m = 0; m < 4; ++m) {
                    const int row = u.pm * 256 + ai * 128 + wr * 64 + m * 16 + fr;
                    bf16_t* p = base + (size_t)row * 512 + cb;
                    f32x4 c4 = {1.f, 1.f, 1.f, 1.f}, s4 = {0.f, 0.f, 0.f, 0.f};
                    if (rope) { const int s = row & (SEQ - 1); const int pos = (wc & 1) ? (s & 63) : (s >> 6);
                        c4 = *(const f32x4*)(ropeC + pos * 16 + 4 * fq); s4 = *(const f32x4*)(ropeS + pos * 16 + 4 * fq); }
#pragma unroll
                    for (int bj = 0; bj < 2; ++bj) {
                        const f32x4 x1 = acc[ai][bj][m][0], x2 = acc[ai][bj][m][1];
                        const f32x4 o1 = (x1 * c4 - x2 * s4) * sc, o2 = (x2 * c4 + x1 * s4) * sc;
                        u32x2 w1, w2; w1.x = cvtpk(o1[0], o1[1]); w1.y = cvtpk(o1[2], o1[3]); w2.x = cvtpk(o2[0], o2[1]); w2.y = cvtpk(o2[2], o2[3]);
                        *(u32x2*)(p + bj * 128) = w1; *(u32x2*)(p + bj * 128 + 16) = w2;
                    }
                }
        } else {
            bf16_t* Ob = (bf16_t*)O;
            const int row0 = u.pm * 256 + wr * 64 + fr, col0 = u.pn * 256 + wc * 32 + 8 * fq;
#pragma unroll
            for (int ai = 0; ai < 2; ++ai)
#pragma unroll
                for (int m = 0; m < 4; ++m) {
                    bf16_t* p = Ob + (size_t)(row0 + ai * 128 + m * 16) * ldc + col0;
#pragma unroll
                    for (int bj = 0; bj < 2; ++bj) { const f32x4 v0 = acc[ai][bj][m][0], v1 = acc[ai][bj][m][1];
                        u32x4 w; w.x = cvtpk(v0[0], v0[1]); w.y = cvtpk(v0[2], v0[3]); w.z = cvtpk(v1[0], v1[1]); w.w = cvtpk(v1[2], v1[3]);
                        *(u32x4*)(p + bj * 128) = w; }
                }
        }
    }
};

__device__ __forceinline__ void p0_transpose_item(const float* W, int ldw, int k0, int n0, bf16_t* WT, int ldt, int dst_row0, LAS unsigned char* scr, int lane) {
    f32x4 v[16];
    const float* src = W + (size_t)(k0 + (lane >> 4)) * ldw + n0 + 4 * (lane & 15);
#pragma unroll
    for (int i = 0; i < 16; ++i) v[i] = __builtin_nontemporal_load((const f32x4*)(src + (size_t)(4 * i) * ldw));
#pragma unroll
    for (int i = 0; i < 16; ++i) { LAS unsigned* p = (LAS unsigned*)(scr + (4 * i + (lane >> 4)) * 132 + 8 * (lane & 15)); p[0] = cvtpk(v[i][0], v[i][1]); p[1] = cvtpk(v[i][2], v[i][3]); }
    asm volatile("s_waitcnt lgkmcnt(0)" ::: "memory");
    const int c = lane & 7;
#pragma unroll
    for (int j = 0; j < 4; ++j) { const int np = (lane >> 3) + 8 * j; unsigned w[8];
#pragma unroll
        for (int i = 0; i < 8; ++i) w[i] = *(const LAS unsigned*)(scr + (8 * c + i) * 132 + 4 * np);
        u32x4 lo, hi;
        lo.x = (w[0] & 0xffffu) | (w[1] << 16); lo.y = (w[2] & 0xffffu) | (w[3] << 16); lo.z = (w[4] & 0xffffu) | (w[5] << 16); lo.w = (w[6] & 0xffffu) | (w[7] << 16);
        hi.x = (w[0] >> 16) | (w[1] & 0xffff0000u); hi.y = (w[2] >> 16) | (w[3] & 0xffff0000u); hi.z = (w[4] >> 16) | (w[5] & 0xffff0000u); hi.w = (w[6] >> 16) | (w[7] & 0xffff0000u);
        *(u32x4*)(WT + (size_t)(dst_row0 + 2 * np) * ldt + k0 + 8 * c) = lo;
        *(u32x4*)(WT + (size_t)(dst_row0 + 2 * np + 1) * ldt + k0 + 8 * c) = hi; }
    asm volatile("s_waitcnt lgkmcnt(0)" ::: "memory");
}

__device__ __forceinline__ void phase_p0(KParams P, LAS unsigned char* lds, int tid, int wave, int lane, int bx, int G) {
    unsigned char* ws = P->ws;
    float* MOD = (float*)(ws + WS_MOD);
    const int gt = bx * NTHREADS + tid;
    if (gt < 2048) {
        const int pos = gt >> 4, i = gt & 15;
        const float inv = exp2f(-(float)i * 0.83048202372184058696f);
        const float angf = (float)pos * inv;
        const double a = (double)angf; const double kq = rint(a * 0.63661977236758134308); const double r = a - kq * 1.57079632679489661923; const double r2 = r * r;
        double sr = r, cr = 1.0, ts = r, tc = 1.0;
#pragma unroll 1
        for (int k = 1; k <= 8; ++k) { const double k2 = (double)(2 * k); tc *= -r2 / (k2 * (k2 - 1.0)); ts *= -r2 / (k2 * (k2 + 1.0)); cr += tc; sr += ts; }
        const int q = ((int)kq) & 3;
        const double cv = (q == 0) ? cr : (q == 1) ? -sr : (q == 2) ? -cr : sr;
        const double sv = (q == 0) ? sr : (q == 1) ? cr : (q == 2) ? -sr : -cr;
        ((float*)(ws + WS_ROPEC))[gt] = (float)cv; ((float*)(ws + WS_ROPES))[gt] = (float)sv;
    }
    constexpr int J_MOD = 72, J_FOLD = 128, J_TR = 1216, NJOBS = J_MOD + J_FOLD + J_TR;
    unsigned* jq = (unsigned*)(ws + WS_BAR + 32768);
    LAS int* jb = (LAS int*)(lds + 131072 + 128);
    for (;;) {
        if (tid == 0) *jb = (int)__hip_atomic_fetch_add(jq, 1u, __ATOMIC_RELAXED, __HIP_MEMORY_SCOPE_AGENT);
        __syncthreads();
        const int job = *jb;
        __syncthreads();
        if (job >= NJOBS) break;
        if (job < J_MOD) {
            LAS float* sc = (LAS float*)lds;
            LAS float* red = sc + 3072;
            for (int i = tid; i < 3072; i += NTHREADS) { const int who = i >> 10, k = i & 1023; const float v = (who < 2) ? P->c[who * 1024 + k] : P->cctx[k]; sc[i] = v / (1.0f + __expf(-v)); }
            __syncthreads();
            const int l = job / 36, cc = job % 36, col = cc * 256 + 4 * lane;
            const float* W = P->wmod + ((size_t)l * 1024 + wave * 128) * NMODW + col;
            f32x4 a0 = {0.f, 0.f, 0.f, 0.f}, a1 = a0, a2 = a0;
#pragma unroll 16
            for (int k = 0; k < 128; ++k) { const f32x4 w = __builtin_nontemporal_load((const f32x4*)(W + (size_t)k * NMODW)); const int kk = wave * 128 + k; a0 += w * sc[kk]; a1 += w * sc[1024 + kk]; a2 += w * sc[2048 + kk]; }
            *(LAS f32x4*)(red + (wave * 3 + 0) * 256 + 4 * lane) = a0; *(LAS f32x4*)(red + (wave * 3 + 1) * 256 + 4 * lane) = a1; *(LAS f32x4*)(red + (wave * 3 + 2) * 256 + 4 * lane) = a2;
            __syncthreads();
            for (int o = tid; o < 768; o += NTHREADS) { const int who = o >> 8, cl = o & 255; float s = 0.f;
#pragma unroll
                for (int w = 0; w < 8; ++w) s += red[(w * 3 + who) * 256 + cl];
                MOD[(size_t)(l * 3 + who) * NMODW + cc * 256 + cl] = s + P->bmod[l * NMODW + cc * 256 + cl]; }
            __syncthreads();
        } else if (job < J_MOD + J_FOLD) {
            const int r = job - J_MOD, nb = r & 15, g = (r >> 4) & 3, l = r >> 6;
            LAS float* A = (LAS float*)lds;
            LAS float* B = (LAS float*)(lds + 128 * 132 * 4);
            LAS bf16_t* OT = (LAS bf16_t*)(lds + 128 * 132 * 4 + 128 * 64 * 4);
            const float* wp = P->wpool + (size_t)(l * 4 + g) * 128 * 128; const float* ps = P->pscale + l * 512 + g * 128;
            const float* wo = P->wout + ((size_t)l * 1024 + 512 + g * 128) * 1024 + nb * 64;
#pragma unroll 8
            for (int i = 0; i < 32; ++i) { const int idx = tid + NTHREADS * i, c = idx >> 7, d = idx & 127; A[c * 132 + d] = wp[idx] * ps[d]; }
#pragma unroll 8
            for (int i = 0; i < 16; ++i) { const int idx = tid + NTHREADS * i, d = idx >> 6, n = idx & 63; B[idx] = wo[(size_t)d * 1024 + n]; }
            __syncthreads();
            const int c = tid >> 2, nq = tid & 3;
            f32x4 acc[4];
#pragma unroll
            for (int j = 0; j < 4; ++j) acc[j] = (f32x4){0.f, 0.f, 0.f, 0.f};
#pragma unroll 4
            for (int d = 0; d < 128; ++d) { const float a = A[c * 132 + d];
#pragma unroll
                for (int j = 0; j < 4; ++j) acc[j] += *(const LAS f32x4*)(B + d * 64 + 16 * nq + 4 * j) * a; }
#pragma unroll
            for (int j = 0; j < 4; ++j)
#pragma unroll
                for (int e = 0; e < 4; ++e) OT[(16 * nq + 4 * j + e) * 128 + c] = (bf16_t)(cvtpk(acc[j][e], 0.f) & 0xffffu);
            __syncthreads();
            bf16_t* dst = (bf16_t*)(ws + WS_WOUT) + ((size_t)l * 1024 + nb * 64) * 1024 + 512 + g * 128;
#pragma unroll
            for (int i = 0; i < 2; ++i) { const int ch = tid + NTHREADS * i, n = ch >> 4, cc8 = ch & 15; *(u32x4*)(dst + (size_t)n * 1024 + cc8 * 8) = *(const LAS u32x4*)(OT + n * 128 + cc8 * 8); }
            __syncthreads();
        } else {
            LAS unsigned char* scr = lds + wave * 8448;
            int tj = job - J_MOD - J_FOLD; const int wk = wave >> 2, wn = wave & 3;
            if (tj < 704) { const int ls = tj / 176, r = tj % 176, kb = r / 22, nb = r % 22, k0 = kb * 128 + wk * 64, n0 = nb * 256 + wn * 64;
                const int cidx = (n0 < DFF) ? n0 : n0 - DFF; const int drow = 256 * (cidx >> 7) + (cidx & 127) + ((n0 < DFF) ? 0 : 128);
                p0_transpose_item(P->wgu + (size_t)ls * 1024 * 5632, 5632, k0, n0, (bf16_t*)(ws + WS_WGU) + (size_t)ls * 5632 * 1024, 1024, drow, scr, lane); }
            else if ((tj -= 704) < 352) { const int ls = tj / 88, r = tj % 88, kb = r / 4, nb = r % 4, k0 = kb * 128 + wk * 64, n0 = nb * 256 + wn * 64;
                p0_transpose_item(P->wd + (size_t)ls * DFF * 1024, 1024, k0, n0, (bf16_t*)(ws + WS_WD) + (size_t)ls * 1024 * DFF, DFF, n0, scr, lane); }
            else if ((tj -= 352) < 128) { const int l = tj / 64, r = tj % 64, kb = r / 8, nb = r % 8, k0 = kb * 128 + wk * 64, n0 = nb * 256 + wn * 64;
                const int drow = (n0 < 1024) ? n0 : (n0 < 1536) ? n0 + 512 : n0 - 512;
                p0_transpose_item(P->win + (size_t)l * 1024 * INW, INW, k0, n0, (bf16_t*)(ws + WS_WIN) + (size_t)l * INW * 1024, 1024, drow, scr, lane); }
            else { tj -= 128; const int l = tj / 16, r = tj % 16, kb = r / 4, nb = r % 4, k0 = kb * 128 + wk * 64, n0 = nb * 256 + wn * 64;
                p0_transpose_item(P->wout + (size_t)l * 1024 * 1024, 1024, k0, n0, (bf16_t*)(ws + WS_WOUT) + (size_t)l * 1024 * 1024, 1024, n0, scr, lane); }
        }
    }
}

struct RowPass {
    const float *srcX, *srcC; float *dstX, *dstC; const bf16_t* srcXb; bf16_t* dstXb;
    const bf16_t* Yb; const float *gate, *gpost; float coef;
    const float *shift, *scale, *gpre; bf16_t* XN;
    int M; bool hasY, hasXN; const float* YP; int nparts;
};
template <int RPT> __device__ __forceinline__ void row_range(const RowPass& R, const LAS float* mv, int lane, int gw, int NGW, int mlo, int mhi) {
    for (int m0 = mlo + RPT * gw; m0 < mhi; m0 += RPT * NGW) {
        const int who = (m0 < SEQ) ? 0 : (m0 < MX) ? 1 : 2;
        const bool isx = m0 < MX;
        f32x4 v[RPT][4];
#pragma unroll
        for (int rr = 0; rr < RPT; ++rr) { const int m = m0 + rr;
            if (isx && R.srcXb) {
#pragma unroll
                for (int j = 0; j < 4; ++j) { const u32x2 w = __builtin_nontemporal_load((const u32x2*)(R.srcXb + (size_t)m * DM + 4 * lane + 256 * j));
                    v[rr][j] = (f32x4){__uint_as_float(w.x << 16), __uint_as_float(w.x & 0xffff0000u), __uint_as_float(w.y << 16), __uint_as_float(w.y & 0xffff0000u)}; }
            } else { const float* xin = isx ? R.srcX + (size_t)m * DM : R.srcC + (size_t)(m - MX) * DM;
#pragma unroll
                for (int j = 0; j < 4; ++j) v[rr][j] = __builtin_nontemporal_load((const f32x4*)(xin + 4 * lane + 256 * j)); } }
        if (R.hasY) {
            f32x4 y[RPT][4]; float ss[RPT];
#pragma unroll
            for (int rr = 0; rr < RPT; ++rr) ss[rr] = 0.f;
#pragma unroll
            for (int rr = 0; rr < RPT; ++rr) { const int m = m0 + rr;
#pragma unroll
                for (int j = 0; j < 4; ++j) {
                    if (isx) { const u32x2 w = __builtin_nontemporal_load((const u32x2*)(R.Yb + (size_t)m * DM + 4 * lane + 256 * j));
                        y[rr][j] = (f32x4){__uint_as_float(w.x << 16), __uint_as_float(w.x & 0xffff0000u), __uint_as_float(w.y << 16), __uint_as_float(w.y & 0xffff0000u)}; }
                    else { f32x4 tp[11];
#pragma unroll
                        for (int p = 0; p < 11; ++p) tp[p] = *(const f32x4*)(R.YP + ((size_t)min(p, R.nparts - 1) * MC + (m - MX)) * DM + 4 * lane + 256 * j);
                        f32x4 t = tp[0];
#pragma unroll
                        for (int p = 1; p < 11; ++p) t += tp[p] * ((p < R.nparts) ? 1.0f : 0.0f);
                        y[rr][j] = t; }
                    ss[rr] += (y[rr][j].x * y[rr][j].x + y[rr][j].y * y[rr][j].y) + (y[rr][j].z * y[rr][j].z + y[rr][j].w * y[rr][j].w); } }
#pragma unroll
            for (int rr = 0; rr < RPT; ++rr) ss[rr] = wave_sum(ss[rr]);
#pragma unroll
            for (int rr = 0; rr < RPT; ++rr) { const int m = m0 + rr;
                const float rs = rsqrtf(ss[rr] * (1.0f / DM) + RMS_EPS) * R.coef;
#pragma unroll
                for (int j = 0; j < 4; ++j) { const int col = 4 * lane + 256 * j; const f32x4 gt = *(const LAS f32x4*)(mv + who * 1024 + col), gp = *(const LAS f32x4*)(mv + 9 * 1024 + col);
                    v[rr][j] = v[rr][j] + gt * (y[rr][j] * rs * gp); }
                if (isx && R.dstXb) {
#pragma unroll
                    for (int j = 0; j < 4; ++j) { u32x2 w; w.x = cvtpk(v[rr][j][0], v[rr][j][1]); w.y = cvtpk(v[rr][j][2], v[rr][j][3]); *(u32x2*)(R.dstXb + (size_t)m * DM + 4 * lane + 256 * j) = w;
                        v[rr][j] = (f32x4){__uint_as_float(w.x << 16), __uint_as_float(w.x & 0xffff0000u), __uint_as_float(w.y << 16), __uint_as_float(w.y & 0xffff0000u)}; }
                } else { float* xo = isx ? R.dstX + (size_t)m * DM : R.dstC + (size_t)(m - MX) * DM;
#pragma unroll
                    for (int j = 0; j < 4; ++j) *(f32x4*)(xo + 4 * lane + 256 * j) = v[rr][j]; } }
        }
        if (R.hasXN) {
            float ss[RPT];
#pragma unroll
            for (int rr = 0; rr < RPT; ++rr) ss[rr] = 0.f;
#pragma unroll
            for (int rr = 0; rr < RPT; ++rr)
#pragma unroll
                for (int j = 0; j < 4; ++j) ss[rr] += (v[rr][j].x * v[rr][j].x + v[rr][j].y * v[rr][j].y) + (v[rr][j].z * v[rr][j].z + v[rr][j].w * v[rr][j].w);
#pragma unroll
            for (int rr = 0; rr < RPT; ++rr) ss[rr] = wave_sum(ss[rr]);
#pragma unroll
            for (int rr = 0; rr < RPT; ++rr) { const int m = m0 + rr;
                const float rs = rsqrtf(ss[rr] * (1.0f / DM) + RMS_EPS);
#pragma unroll
                for (int j = 0; j < 4; ++j) { const int col = 4 * lane + 256 * j;
                    const f32x4 gp = *(const LAS f32x4*)(mv + 10 * 1024 + col), sh = *(const LAS f32x4*)(mv + (3 + who) * 1024 + col), sc = *(const LAS f32x4*)(mv + (6 + who) * 1024 + col);
                    const f32x4 o = (v[rr][j] * rs * gp) * (sc + 1.0f) + sh;
                    u32x2 w; w.x = cvtpk(o[0], o[1]); w.y = cvtpk(o[2], o[3]);
                    *(u32x2*)(R.XN + (size_t)m * DM + col) = w; } }
        }
    }
}

__device__ __forceinline__ void phase_row(const RowPass& R, LAS unsigned char* lds, int tid, int wave, int lane, int bx, int G) {
    const int gw = bx * NWAVES + wave, NGW = G * NWAVES;
    LAS float* mv = (LAS float*)lds;
    for (int i = tid; i < 11 * 256; i += NTHREADS) { const int vec = i >> 8, c4 = (i & 255) * 4;
        const float* src = (vec < 3) ? R.gate + vec * NMODW : (vec < 6) ? R.shift + (vec - 3) * NMODW : (vec < 9) ? R.scale + (vec - 6) * NMODW : (vec == 9) ? R.gpost : R.gpre;
        *(LAS f32x4*)(mv + vec * 1024 + c4) = *(const f32x4*)(src + c4); }
    __syncthreads();
    row_range<4>(R, mv, lane, gw, NGW, 0, (R.M < MX) ? R.M : MX);
    if (R.M > MX) row_range<2>(R, mv, lane, NGW - 1 - gw, NGW, MX, R.M);
}

#define MFMA32(a, b, c) __builtin_amdgcn_mfma_f32_32x32x16_bf16((a), (b), (c), 0, 0, 0)
struct KFrag { bf16x8 k[4]; };
struct VFrag { bf16x8 v[4]; };
__device__ __forceinline__ void attn_loadk(KFrag& f, const bf16_t* kbase, int krow0) {
    const bf16_t* kp = kbase + (size_t)krow0 * 512;
#pragma unroll
    for (int dk = 0; dk < 4; ++dk) f.k[dk] = *(const bf16x8*)(kp + dk * 16);
}
__device__ __forceinline__ void attn_loadv(VFrag& f, const bf16_t* vbase, int krow0) {
    const bf16_t* vp = vbase + krow0;
    f.v[0] = *(const bf16x8*)(vp); f.v[1] = *(const bf16x8*)(vp + 16); f.v[2] = *(const bf16x8*)(vp + (size_t)32 * MT); f.v[3] = *(const bf16x8*)(vp + (size_t)32 * MT + 16);
}
constexpr int KL_OFF = 32768, KL_PITCH = 144, VL_OFF = KL_OFF + 256 * KL_PITCH, VL_PITCH = 528;
__device__ __forceinline__ void attn_loadk_lds(KFrag& f, const LAS unsigned char* kl, int t) {
    const LAS unsigned char* p = kl + t * (32 * KL_PITCH);
#pragma unroll
    for (int dk = 0; dk < 4; ++dk) f.k[dk] = *(const LAS bf16x8*)(p + dk * 32);
}
__device__ __forceinline__ void attn_loadv_lds(VFrag& f, const LAS unsigned char* vl, int t) {
    const LAS unsigned char* p = vl + t * 64;
    f.v[0] = *(const LAS bf16x8*)(p); f.v[1] = *(const LAS bf16x8*)(p + 32); f.v[2] = *(const LAS bf16x8*)(p + 32 * VL_PITCH); f.v[3] = *(const LAS bf16x8*)(p + 32 * VL_PITCH + 32);
}
__device__ __forceinline__ void attn_soft(f32x16& S, f32x16& o0, f32x16& o1, float& mrun, float& lrun, bool masked, const LAS float* bt, int relb, int idxb, bf16x8& pb0, bf16x8& pb1) {
    if (masked) {
        const LAS float* bp = bt + idxb;
        float bv[16];
#pragma unroll
        for (int r = 0; r < 16; ++r) bv[r] = bp[16 * (r >> 3) + (r & 7)];
#pragma unroll
        for (int r = 0; r < 16; ++r) {
            const int off = 16 * (r >> 3) + (r & 7);
            const bool valid = (unsigned)(relb + off) < 16u;
            S[r] = valid ? S[r] + bv[r] : -1e30f;
        }
    }
    float tm = S[0];
#pragma unroll
    for (int r = 1; r < 16; ++r) tm = fmaxf(tm, S[r]);
    tm = fmaxf(tm, __shfl_xor(tm, 32));
    if (__any(tm > mrun)) {
        const float mn = fmaxf(mrun, tm);
        const float fs = __builtin_amdgcn_exp2f(mrun - mn);
        mrun = mn; lrun *= fs;
#pragma unroll
        for (int r = 0; r < 16; ++r) { o0[r] *= fs; o1[r] *= fs; }
    }
    float ps = 0.f;
#pragma unroll
    for (int r = 0; r < 16; ++r) { S[r] = __builtin_amdgcn_exp2f(S[r] - mrun); ps += S[r]; }
    lrun += ps;
    u32x4 w0, w1;
    w0.x = cvtpk(S[0], S[1]); w0.y = cvtpk(S[2], S[3]); w0.z = cvtpk(S[4], S[5]); w0.w = cvtpk(S[6], S[7]);
    w1.x = cvtpk(S[8], S[9]); w1.y = cvtpk(S[10], S[11]); w1.z = cvtpk(S[12], S[13]); w1.w = cvtpk(S[14], S[15]);
    pb0 = __builtin_bit_cast(bf16x8, w0); pb1 = __builtin_bit_cast(bf16x8, w1);
}
struct AttnState { f32x16 o0, o1; float m, l; };
__device__ __forceinline__ void attn_comp2(KFrag& fk, const VFrag& f, const bf16x8 (&qa)[4], const bf16x8 (&qb)[4], AttnState& A, AttnState& B,
                                           bool masked, const LAS float* bt, int relA, int idxA, int relB, int idxB, const bf16_t* kbase, int nextrow, const LAS unsigned char* kl, int nextlds) {
    f32x16 SA, SB;
#pragma unroll
    for (int r = 0; r < 16; ++r) { SA[r] = 0.f; SB[r] = 0.f; }
#pragma unroll
    for (int dk = 0; dk < 4; ++dk) { SA = MFMA32(fk.k[dk], qa[dk], SA); SB = MFMA32(fk.k[dk], qb[dk], SB); }
    if (nextlds >= 0) attn_loadk_lds(fk, kl, nextlds);
    else if (nextrow >= 0) attn_loadk(fk, kbase, nextrow);
    bf16x8 p0, p1;
    attn_soft(SA, A.o0, A.o1, A.m, A.l, masked, bt, relA, idxA, p0, p1);
    A.o0 = MFMA32(f.v[0], p0, A.o0); A.o0 = MFMA32(f.v[1], p1, A.o0); A.o1 = MFMA32(f.v[2], p0, A.o1); A.o1 = MFMA32(f.v[3], p1, A.o1);
    attn_soft(SB, B.o0, B.o1, B.m, B.l, masked, bt, relB, idxB, p0, p1);
    B.o0 = MFMA32(f.v[0], p0, B.o0); B.o0 = MFMA32(f.v[1], p1, B.o0); B.o1 = MFMA32(f.v[2], p0, B.o1); B.o1 = MFMA32(f.v[3], p1, B.o1);
}
__device__ __forceinline__ void attn_store(const AttnState& A, bf16_t* op) {
    const float lt = A.l + __shfl_xor(A.l, 32);
    const float inv = 1.0f / lt;
#pragma unroll
    for (int g4 = 0; g4 < 4; ++g4) {
        u32x2 w; w.x = cvtpk(A.o0[4 * g4] * inv, A.o0[4 * g4 + 1] * inv); w.y = cvtpk(A.o0[4 * g4 + 2] * inv, A.o0[4 * g4 + 3] * inv); *(u32x2*)(op + 8 * g4) = w;
        u32x2 z; z.x = cvtpk(A.o1[4 * g4] * inv, A.o1[4 * g4 + 1] * inv); z.y = cvtpk(A.o1[4 * g4 + 2] * inv, A.o1[4 * g4 + 3] * inv); *(u32x2*)(op + 32 + 8 * g4) = z;
    }
}

__device__ __forceinline__ void phase_mix(KParams P, int layer, LAS unsigned char* lds, int tid, int wave, int lane, int bx, int G) {
    unsigned char* ws = P->ws;
    const bf16_t* Qb = (const bf16_t*)(ws + WS_Q); const bf16_t* Kb = (const bf16_t*)(ws + WS_K); const bf16_t* Ub = (const bf16_t*)(ws + WS_U);
    const bf16_t* Vt = (const bf16_t*)(ws + WS_VT); bf16_t* MIXb = (bf16_t*)(ws + WS_MIX);
    LAS float* bt = (LAS float*)(lds + wave * 2560) + 64;
    const int vb = (G % 8 == 0) ? (bx % 8) * (G / 8) + bx / 8 : bx;
    const int gw = vb * NWAVES + wave, NGW = G * NWAVES;
    const int q = lane & 31, hi = lane >> 5, pi = (q & 0x13) | ((q & 4) << 1) | ((q & 8) >> 1);
    const int nunits = 2048 + ((layer == 0) ? 64 : 0);
    for (int un = gw; un < nunits; un += NGW) {
        int b, h, qrow0, r = 0; const bool local = un < 2048;
        if (local) { r = un & 127; h = (un >> 7) & 7; b = un >> 10; qrow0 = b * SEQ + r * 64; }
        else { const int v = un - 2048; const int qb = v & 3; h = (v >> 2) & 7; b = v >> 5; qrow0 = MX + b * CTXL + qb * 64; }
        if (local) {
            const float* rp = P->rpb + (size_t)(layer * NH + h) * 465;
            for (int i = lane; i < 465; i += 64) bt[i] = rp[i] * LOG2E;
        }
        const int crow0 = MX + b * CTXL;
        if (local) {
            const bf16_t* ksrc = Kb + (size_t)crow0 * 512 + h * 64; const bf16_t* vsrc = Vt + (size_t)(h * 64) * MT + crow0;
#pragma unroll
            for (int i = 0; i < 4; ++i) { const int c = tid + NTHREADS * i;
                *(LAS u32x4*)(lds + KL_OFF + (c >> 3) * KL_PITCH + (c & 7) * 16) = *(const u32x4*)(ksrc + (size_t)(c >> 3) * 512 + (c & 7) * 8);
                *(LAS u32x4*)(lds + VL_OFF + (c >> 5) * VL_PITCH + (c & 31) * 16) = *(const u32x4*)(vsrc + (size_t)(c >> 5) * MT + (c & 31) * 8); }
            __syncthreads();
        }
        const LAS unsigned char* kl = lds + KL_OFF + pi * KL_PITCH + hi * 16; const LAS unsigned char* vl = lds + VL_OFF + q * VL_PITCH + hi * 16;
        bf16x8 qa[4], qb4[4];
#pragma unroll
        for (int dk = 0; dk < 4; ++dk) { qa[dk] = *(const bf16x8*)(Qb + (size_t)(qrow0 + q) * 512 + h * 64 + dk * 16 + hi * 8);
                                         qb4[dk] = *(const bf16x8*)(Qb + (size_t)(qrow0 + 32 + q) * 512 + h * 64 + dk * 16 + hi * 8); }
        AttnState A, B;
#pragma unroll
        for (int i = 0; i < 16; ++i) { A.o0[i] = 0.f; A.o1[i] = 0.f; B.o0[i] = 0.f; B.o1[i] = 0.f; }
        A.m = -1e30f; A.l = 0.f; B.m = -1e30f; B.l = 0.f;
        const int rs = min(max(r - 4, 0), 120);
        const int jA = q, jB = 32 + q, csA = min(max(jA - 8, 0), 48), csB = min(max(jB - 8, 0), 48);
        const int lrow0 = b * SEQ + rs * 64;
        const bf16_t* kbase = Kb + (size_t)pi * 512 + h * 64 + hi * 8;
        const bf16_t* vbase = Vt + (size_t)(h * 64 + q) * MT + hi * 8;
        const int ntiles = local ? 24 : 8;
#define TROW(t) (((t) < 8) ? crow0 + 32 * (t) : lrow0 + 32 * ((t) - 8))
#define TCOMP(FK, FV, t, NXT) do { const int t_ = (t); const int kr_ = (t_ - 8) >> 1, ct_ = (t_ - 8) & 1; const int br_ = (rs + kr_ - r + 7) * 31 + ct_ * 32 + 8 * hi + 15; \
            int ra_ = ct_ * 32 + 8 * hi - csA, rb_ = ct_ * 32 + 8 * hi - csB; asm volatile("" : "+v"(ra_), "+v"(rb_));     \
            attn_comp2(FK, FV, qa, qb4, A, B, t_ >= 8, bt, ra_, br_ - jA, rb_, br_ - jB, kbase, (NXT), kl, (local && t_ + 1 < 8) ? t_ + 1 : -1); } while (0)
        KFrag k0; VFrag fv;
        if (local) attn_loadk_lds(k0, kl, 0); else attn_loadk(k0, kbase, TROW(0));
        asm volatile("s_waitcnt lgkmcnt(0)" ::: "memory");
        for (int t = 0; t < ntiles; ++t) {
            if (local && t < 8) attn_loadv_lds(fv, vl, t); else attn_loadv(fv, vbase, TROW(t));
            TCOMP(k0, fv, t, (t + 1 < ntiles) ? TROW(t + 1) : -1);
        }
#undef TROW
#undef TCOMP
        attn_store(A, MIXb + (size_t)(qrow0 + q) * 1024 + h * 64 + 4 * hi);
        attn_store(B, MIXb + (size_t)(qrow0 + 32 + q) * 1024 + h * 64 + 4 * hi);
        asm volatile("s_waitcnt lgkmcnt(0)" ::: "memory");
    }
    const int mrows = (layer == 0) ? MT : MX;
    const int nskip = (layer == 0) ? 64 : 0;
    if (gw < nskip) return;
    for (int wi = gw - nskip; wi < mrows; wi += NGW - nskip) {
        const int g = wi & 3, m = (wi & ~3) + (lane >> 4), ch = g * 16 + (lane & 15);
        int jj, len;
        if (m < MX) { jj = m & 63; len = 64; } else { jj = (m - MX) & 255; len = 256; }
        const int base = m - jj;
        float a[8];
#pragma unroll
        for (int e = 0; e < 8; ++e) a[e] = 0.f;
        const bf16_t* up = Ub + (size_t)base * 512 + ch * 8;
#define POOLW(W2) do { const int lo = max(jj - (W2), 0), hi2 = min(jj + (W2), len); u32x4 uv[2 * (W2)]; \
            _Pragma("unroll") for (int t = 0; t < 2 * (W2); ++t) uv[t] = *(const u32x4*)(up + (size_t)min(lo + t, hi2 - 1) * 512); \
            _Pragma("unroll") for (int t = 0; t < 2 * (W2); ++t) { const float wgt = (lo + t < hi2) ? 1.0f : 0.0f; \
                _Pragma("unroll") for (int e = 0; e < 4; ++e) { a[2 * e] += wgt * __uint_as_float(uv[t][e] << 16); a[2 * e + 1] += wgt * __uint_as_float(uv[t][e] & 0xffff0000u); } } \
            const float ic = 1.0f / (float)(hi2 - lo); _Pragma("unroll") for (int e = 0; e < 8; ++e) a[e] *= ic; } while (0)
        if (g == 0) POOLW(1); else if (g == 1) POOLW(2); else if (g == 2) POOLW(4); else POOLW(8);
#undef POOLW
        const u32x4 us = *(const u32x4*)(Ub + (size_t)m * 512 + ch * 8);
        u32x4 o;
#pragma unroll
        for (int e = 0; e < 4; ++e) o[e] = cvtpk(a[2 * e] - __uint_as_float(us[e] << 16), a[2 * e + 1] - __uint_as_float(us[e] & 0xffff0000u));
        *(u32x4*)(MIXb + (size_t)m * 1024 + 512 + ch * 8) = o;
    }
}

__device__ __forceinline__ void run_phase(KParams P, int ph, LAS unsigned char* lds, int tid, int wave, int lane, int bx, int G) {
    unsigned char* ws = P->ws;
    float* MOD = (float*)(ws + WS_MOD);
    bf16_t* XN = (bf16_t*)(ws + WS_XN); bf16_t* Yb = (bf16_t*)(ws + WS_Y); bf16_t* H = (bf16_t*)(ws + WS_H);
    float* CTXS = (float*)(ws + WS_CTXS);
    if (ph == 0) { phase_p0(P, lds, tid, wave, lane, bx, G); return; }
    const int l = (ph == NPHASE - 1) ? 2 : (ph - 1) / 10, s = (ph == NPHASE - 1) ? 0 : (ph - 1) % 10;
    const int Mlate = (l == 1) ? MX : MT;
    if (s == 0 || s == 3 || s == 7) {
        int yl = l, gidx = 5, gpi = 3, nl = l, npre = 4, nsh = 6, M = Mlate; bool hasY = true, hasXN = true, useIn = false; float coef = 1.0f;
        if (s == 0) { yl = (l > 0) ? l - 1 : 0; gidx = 8; gpi = 5; npre = 0; nsh = 0; M = MT; coef = 0.5f; hasY = (l > 0); useIn = (l == 0);
                      if (l == 2) { hasXN = false; M = MX; nl = 1; } }
        else if (s == 3) { gidx = 2; gpi = 1; npre = 2; nsh = 3; M = MT; coef = 0.5f; useIn = (l == 0); }
        RowPass R;
        R.srcX = P->x; R.srcXb = useIn ? (const bf16_t*)nullptr : (const bf16_t*)(ws + WS_XS); R.srcC = useIn ? P->ctx : (const float*)CTXS;
        R.dstX = P->out; R.dstXb = (l == 2) ? (bf16_t*)nullptr : (bf16_t*)(ws + WS_XS); R.dstC = CTXS;
        R.YP = (const float*)(ws + WS_YP); R.nparts = (s == 7) ? 4 : 11;
        R.Yb = Yb; R.XN = XN; R.hasY = hasY; R.hasXN = hasXN; R.M = M; R.coef = coef;
        R.gate = MOD + (size_t)yl * 3 * NMODW + gidx * DM; R.gpost = P->normg + (yl * 6 + gpi) * DM;
        R.gpre = P->normg + (nl * 6 + npre) * DM; R.shift = MOD + (size_t)nl * 3 * NMODW + nsh * DM; R.scale = R.shift + DM;
        phase_row(R, lds, tid, wave, lane, bx, G);
        return;
    }
    if (s == 5) { phase_mix(P, l, lds, tid, wave, lane, bx, G); return; }
    const bool split = (s == 2 || s == 9 || s == 6) && (Mlate == MT || s == 2);
    const int npass = (s == 4 || split) ? 2 : 1;
    for (int pass = 0; pass < npass; ++pass) {
        pg8::Gemm g; EpiAny E; E.ropeC = (const float*)(ws + WS_ROPEC); E.ropeS = (const float*)(ws + WS_ROPES); E.pstride = 0; E.ntp = 0; int cu = bx, pm0 = 0, ksplit = 1, ntp = 0;
        if (s == 1 || s == 8) {
            const int sub = (s == 1) ? 0 : 1; const int M = (s == 1) ? MT : Mlate;
            g = pg8::Gemm{XN, (const bf16_t*)(ws + WS_WGU) + (size_t)(l * 2 + sub) * 5632 * 1024, M, 5632, 1024, 1024};
            E.mode = EPI_SWIGLU; E.perm = true; E.O = H; E.ldc = DFF;
        } else if (s == 6 || s == 2 || s == 9) {
            const bf16_t* A; const bf16_t* Bt; int K;
            if (s == 6) { A = (const bf16_t*)(ws + WS_MIX); Bt = (const bf16_t*)(ws + WS_WOUT) + (size_t)l * 1024 * 1024; K = 1024; }
            else { const int sub = (s == 2) ? 0 : 1; A = H; Bt = (const bf16_t*)(ws + WS_WD) + (size_t)(l * 2 + sub) * 1024 * DFF; K = DFF; }
            E.mode = EPI_F32; E.perm = false; E.ldc = 1024;
            if (pass == 0) { g = pg8::Gemm{A, Bt, MX, 1024, K, K}; E.mode = EPI_BF16; E.perm = true; E.O = Yb; }
            else { ntp = 4; ksplit = K / 256; pm0 = MX / 256; g = pg8::Gemm{A, Bt, MC, 1024, 256, K};
                   E.O = (float*)(ws + WS_YP) - (size_t)MX * 1024; E.pstride = MC * 1024; E.ntp = 4; }
        } else {
            const bf16_t* Wt = (const bf16_t*)(ws + WS_WIN) + (size_t)l * INW * 1024;
            if (pass == 0) { g = pg8::Gemm{XN, Wt, MT, 1536, 1024, 1024}; E.mode = EPI_QKU; E.perm = false; E.O = ws + WS_Q; E.ldc = 512; }
            else { g = pg8::Gemm{Wt + (size_t)1536 * 1024, XN, 512, MT, 1024, 1024}; E.mode = EPI_BF16; E.perm = true; E.O = ws + WS_VT; E.ldc = MT; cu = G - 1 - bx; }
        }
        pg8::StaticOrder S; S.init(g.M, g.N, G, cu, pm0, ksplit, ntp);
        pg8::gemm_phase<EpiAny, pg8::StaticOrder, true, true>(lds, g, S, E);
    }
}

__global__ void __launch_bounds__(NTHREADS, 2) mega(Params P, int ph_lo, int ph_hi) {
    extern __shared__ __attribute__((aligned(16))) unsigned char lds_raw[];
    LAS unsigned char* lds = (LAS unsigned char*)lds_raw;
    cg::grid_group grid = cg::this_grid();
    volatile LAS unsigned* bst = (volatile LAS unsigned*)(lds + 131072 + 64);
    if (threadIdx.x < 2) bst[threadIdx.x] = 0u;
    __syncthreads();
    XcdBarrier bar;
    { KParams kp0 = (KParams)__builtin_amdgcn_kernarg_segment_ptr(); bar = xcd_barrier_post((unsigned*)(kp0->ws + WS_BAR), bst); }
    KParams kp = (KParams)__builtin_amdgcn_kernarg_segment_ptr();
#if defined(PROBE_REP_PH)
    const int nextra = PROBE_REPS - 1;
#else
    const int nextra = 0;
#endif
    const int nsteps = ph_hi - ph_lo + nextra;
    for (int step = 0; step < nsteps; ++step) {
        int ph = ph_lo + step;
#if defined(PROBE_REP_PH)
        if (ph > PROBE_REP_PH) ph = (ph <= PROBE_REP_PH + nextra) ? PROBE_REP_PH : ph - nextra;
#endif
        asm volatile("" : "+s"(kp));
        int tid = threadIdx.x; asm volatile("" : "+v"(tid));
        const int lane = tid & 63, wave = __builtin_amdgcn_readfirstlane(tid >> 6);
        int bx = blockIdx.x, G = gridDim.x; asm volatile("" : "+s"(bx), "+s"(G));
        run_phase(kp, ph, lds, tid, wave, lane, bx, G);
        if (step + 1 < nsteps) { if (ph_lo < 0) grid.sync(); else xcd_barrier(bar); }
    }
}

extern "C" void kernel_launch(void* const* d_in, const int* in_sizes, int n_in, void* d_out, int out_size, void* d_ws, size_t ws_size, hipStream_t stream) {
    static int grid = 0;
    if (grid == 0) {
        if (n_in != 14 || in_sizes[0] != MX * DM || out_size != MX * DM || ws_size < WS_END) {
            fprintf(stderr, "kernel_launch: unexpected shapes (n_in %d, in0 %d, out %d, ws %zu < %zu)\n", n_in, n_in > 0 ? in_sizes[0] : -1, out_size, ws_size, (size_t)WS_END); grid = -1; return; }
        int dev = 0, cus = 0, per_cu = 0;
        (void)hipGetDevice(&dev); (void)hipDeviceGetAttribute(&cus, hipDeviceAttributeMultiprocessorCount, dev);
        if (hipFuncSetAttribute((const void*)mega, hipFuncAttributeMaxDynamicSharedMemorySize, LDS_BYTES) != hipSuccess) { fprintf(stderr, "kernel_launch: hipFuncSetAttribute failed\n"); grid = -1; return; }
        if (hipOccupancyMaxActiveBlocksPerMultiprocessor(&per_cu, (const void*)mega, NTHREADS, LDS_BYTES) != hipSuccess || per_cu < 1) { fprintf(stderr, "kernel_launch: occupancy query gave %d\n", per_cu); per_cu = 1; }
        (void)hipGetLastError();
        grid = cus * 1;
        if (grid <= 0) grid = 256;
    }
    if (grid < 0) return;
    if (hipMemsetAsync((char*)d_ws + WS_BAR, 0, 65536, stream) != hipSuccess) { fprintf(stderr, "kernel_launch: memset failed\n"); return; }
    Params p{};
    p.x = (const float*)d_in[0]; p.c = (const float*)d_in[1]; p.ctx = (const float*)d_in[2]; p.cctx = (const float*)d_in[3];
    p.wmod = (const float*)d_in[4]; p.bmod = (const float*)d_in[5]; p.normg = (const float*)d_in[6]; p.wgu = (const float*)d_in[7];
    p.wd = (const float*)d_in[8]; p.win = (const float*)d_in[9]; p.wout = (const float*)d_in[10]; p.rpb = (const float*)d_in[11];
    p.wpool = (const float*)d_in[12]; p.pscale = (const float*)d_in[13];
    p.out = (float*)d_out; p.ws = (unsigned char*)d_ws;
#if MK_MULTI
    for (int ph = 0; ph < NPHASE; ++ph) {
        int lo = ph, hi = ph + 1; void* args[] = {&p, &lo, &hi};
        hipError_t e = hipLaunchCooperativeKernel((const void*)mega, dim3(grid), dim3(NTHREADS), args, LDS_BYTES, stream);
        if (e != hipSuccess) { fprintf(stderr, "launch %d failed: %s\n", ph, hipGetErrorString(e)); break; }
    }
#else
#ifndef MK_PH_HI
#define MK_PH_HI NPHASE
#endif
#ifndef MK_PH_LO
#define MK_PH_LO 0
#endif
    int lo = MK_PH_LO, hi = MK_PH_HI; void* args[] = {&p, &lo, &hi};
    hipError_t e = hipLaunchCooperativeKernel((const void*)mega, dim3(grid), dim3(NTHREADS), args, LDS_BYTES, stream);
    if (e != hipSuccess) fprintf(stderr, "cooperative launch failed: %s (grid %d)\n", hipGetErrorString(e), grid);
#endif
}
```

```cpp
#include <hip/hip_runtime.h>
#include <hip/hip_cooperative_groups.h>
#include <cstdio>
#include <cstdint>
namespace cg = cooperative_groups;
namespace pg8 {
#define PG8_LAS __attribute__((address_space(3)))
typedef unsigned short bf16_t;
typedef short bf16x8 __attribute__((ext_vector_type(8)));
typedef float f32x4 __attribute__((ext_vector_type(4)));
typedef unsigned u32x4 __attribute__((ext_vector_type(4)));
constexpr int BM = 256, BK = 64, HALF = 128, HTB = HALF * BK * 2  , STAGE_BYTES = 8 * HTB, NXCD = 8, WGM = 8;

__host__ __device__ __forceinline__ int lds_byte(int r, int c) { const int st = (r >> 4) * 2 + (c >> 5), rr = r & 15, cc = c & 31, ob = rr * 64 + cc * 2; return st * 1024 + (ob ^ (((ob >> 9) & 1) << 5)); }
__host__ __device__ __forceinline__ void stage_rc(int b, int& R, int& C) { const int st = b / 1024, sb = b % 1024, swz = sb ^ (((sb >> 9) & 1) << 5); R = (st >> 1) * 16 + swz / 64; C = (st & 1) * 32 + (swz % 64) / 2; }
__host__ __device__ __forceinline__ int perm32(int rho) { const int n = rho >> 4, i = rho & 15; return 8 * (i >> 2) + 4 * n + (i & 3); }

struct Unit { int pm, pn, kb; };
struct Gemm { const bf16_t* A; const bf16_t* Bt; int M, N, K, ld; };

struct StaticOrder {
    int nM, nN, nwg, G, c, pm0, ksplit, ntp;
    __host__ __device__ void init(int M, int N, int G_, int c_, int pm0_ = 0, int ksplit_ = 1, int ntp_ = 0) { nM = M / BM; nN = N / BM; nwg = nM * nN * ksplit_; G = G_; c = c_; pm0 = pm0_; ksplit = ksplit_; ntp = ntp_; }
    __host__ __device__ bool next(int i, Unit& u) const {
        const long L = (long)i * G + c; if (L >= nwg) return false;
        int wgid = (int)L; u.kb = (wgid % ksplit) * ntp; wgid /= ksplit; { const int nwg = nM * nN; const int q = nwg / NXCD, r = nwg % NXCD, xcd = wgid % NXCD, off = wgid / NXCD; wgid = (xcd < r ? xcd * (q + 1) : r * (q + 1) + (xcd - r) * q) + off; }
        const int nig = WGM * nN, gid = wgid / nig, fm = gid * WGM, gsz = (nM - fm) < WGM ? (nM - fm) : WGM;
        u.pm = pm0 + fm + ((wgid % nig) % gsz); u.pn = (wgid % nig) / gsz; return true;
    }
    __device__ __forceinline__ void a_ready(const Unit&) const {}
    __device__ __forceinline__ void done(const Unit&) const {}
};

__device__ __forceinline__ unsigned cvt_pk_bf16(float lo, float hi) { unsigned r; asm volatile("v_cvt_pk_bf16_f32 %0, %1, %2" : "=v"(r) : "v"(lo), "v"(hi)); return r; }
typedef float f32x2 __attribute__((ext_vector_type(2)));
template <class Epi, class Sched, bool ALIGN_EPI = false, bool SP2 = false>
__device__ __forceinline__ void gemm_phase(PG8_LAS unsigned char* lds, const Gemm g, const Sched& S, const Epi& E) {
    int tid_raw = threadIdx.x; asm volatile("" : "+v"(tid_raw));
    const int tid = tid_raw, wid = __builtin_amdgcn_readfirstlane(tid >> 6), lane = tid & 63, wr = wid >> 2, wc = wid & 3, fr = lane & 15, fq = lane >> 4;
    const int K = g.ld, nt = g.K / BK;
    unsigned voffA[2], voffB[2];
#pragma unroll
    for (int i = 0; i < 2; ++i) { int R, C; stage_rc(tid * 16 + i * 8192, R, C); const int Rb = E.perm ? ((R & ~31) + perm32(R & 31)) : R;
        voffA[i] = (unsigned)(R * K + C) * 2u; voffB[i] = (unsigned)(Rb * K + C) * 2u; }
    const size_t kstep = (size_t)(BK * 2);
    const size_t hstep = (size_t)HALF * K * 2;
    const size_t tstep = 2 * hstep;
    const unsigned ldsw = (unsigned)wid * 1024u;
    const int aoff = lds_byte(wr * 64 + fr, fq * 8), boff = lds_byte(wc * 32 + fr, fq * 8);
#define PG8_SA(b, h) (((b) * 2 + (h)) * HTB)
#define PG8_SB(b, h) ((4 + (b) * 2 + (h)) * HTB)
#define PG8_STAGE(bufoff, gbase, voff) do { _Pragma("unroll") for (int _i = 0; _i < 2; ++_i) \
        __builtin_amdgcn_global_load_lds((const unsigned*)((const char*)(gbase) + (voff)[_i]), (PG8_LAS unsigned*)(lds + (bufoff) + ldsw + _i * 8192), 16, 0, 0); } while (0)
#define PG8_LDA(dst, b, h) do { _Pragma("unroll") for (int m = 0; m < 4; ++m) _Pragma("unroll") for (int k = 0; k < 2; ++k) dst[m][k] = *(const PG8_LAS bf16x8*)(lds + PG8_SA(b, h) + aoff + m * 2048 + k * 1024); } while (0)
#define PG8_LDB(dst, b, h) do { _Pragma("unroll") for (int n = 0; n < 2; ++n) _Pragma("unroll") for (int k = 0; k < 2; ++k) dst[n][k] = *(const PG8_LAS bf16x8*)(lds + PG8_SB(b, h) + boff + n * 2048 + k * 1024); } while (0)
#define PG8_MMA(ai, bj, At, Bt) do { __builtin_amdgcn_s_setprio(1); _Pragma("unroll") for (int m = 0; m < 4; ++m) _Pragma("unroll") for (int n = 0; n < 2; ++n) _Pragma("unroll") for (int k = 0; k < 2; ++k) \
        acc[ai][bj][m][n] = __builtin_amdgcn_mfma_f32_16x16x32_bf16(Bt[n][k], At[m][k], acc[ai][bj][m][n], 0, 0, 0); __builtin_amdgcn_s_setprio(0); } while (0)
#define PG8_WAIT_V(n) asm volatile("s_waitcnt vmcnt(" #n ")" ::: "memory")
#define PG8_WAIT_L(n) asm volatile("s_waitcnt lgkmcnt(" #n ")" ::: "memory")
#define PG8_BAR __builtin_amdgcn_s_barrier()
#define PG8_SCHED __builtin_amdgcn_sched_barrier(0)
    Unit cur, nxt; int ui = 0;
    if (!S.next(0, cur)) return;
    f32x4 acc[2][2][4][2];
#pragma unroll
    for (int a = 0; a < 2; ++a)
#pragma unroll
        for (int b = 0; b < 2; ++b)
#pragma unroll
            for (int m = 0; m < 4; ++m)
#pragma unroll
                for (int n = 0; n < 2; ++n) acc[a][b][m][n] = (f32x4){0.f, 0.f, 0.f, 0.f};
    bf16x8 At[4][2], B0[2][2], B1[2][2];
    const char* cA = (const char*)g.A + (size_t)cur.pm * tstep + (size_t)cur.kb * (BK * 2); const char* cB = (const char*)g.Bt + (size_t)cur.pn * tstep + (size_t)cur.kb * (BK * 2);
    S.a_ready(cur);
    if constexpr (SP2) {
        PG8_STAGE(PG8_SB(0, 0), cB, voffB); PG8_STAGE(PG8_SB(0, 1), cB + hstep, voffB); PG8_STAGE(PG8_SA(0, 0), cA, voffA); PG8_STAGE(PG8_SA(0, 1), cA + hstep, voffA);
        if (wr == 1) PG8_BAR;
        PG8_WAIT_V(2); PG8_BAR;
        PG8_STAGE(PG8_SB(1, 0), cB + kstep, voffB); PG8_STAGE(PG8_SA(1, 0), cA + kstep, voffA); PG8_STAGE(PG8_SB(1, 1), cB + hstep + kstep, voffB);
        PG8_WAIT_V(6); PG8_BAR;
    } else {
        PG8_STAGE(PG8_SB(0, 0), cB, voffB); PG8_STAGE(PG8_SA(0, 0), cA, voffA); PG8_STAGE(PG8_SB(0, 1), cB + hstep, voffB); PG8_STAGE(PG8_SA(0, 1), cA + hstep, voffA);
        if (wr == 1) PG8_BAR;
        PG8_WAIT_V(4); PG8_BAR;
        PG8_STAGE(PG8_SB(1, 0), cB + kstep, voffB); PG8_STAGE(PG8_SA(1, 0), cA + kstep, voffA); PG8_STAGE(PG8_SB(1, 1), cB + hstep + kstep, voffB);
        PG8_WAIT_V(6); PG8_BAR;
    }
    for (;;) {
        const bool has_next = S.next(ui + 1, nxt);
        const char* nA = has_next ? (const char*)g.A + (size_t)nxt.pm * tstep + (size_t)nxt.kb * (BK * 2) : cA; const char* nB = has_next ? (const char*)g.Bt + (size_t)nxt.pn * tstep + (size_t)nxt.kb * (BK * 2) : cB;
        for (int t = 0; t < nt; t += 2) {
            const bool last = (t == nt - 2);
            const char* a1 = cA + (size_t)(t + 1) * kstep;
            const char* a2 = last ? nA : cA + (size_t)(t + 2) * kstep; const char* b2 = last ? nB : cB + (size_t)(t + 2) * kstep;
            const char* a3 = a2 + kstep; const char* b3 = b2 + kstep;
            if (last && has_next) S.a_ready(nxt);
            if constexpr (SP2) {
            PG8_LDB(B0, 0, 0); PG8_LDB(B1, 0, 1); PG8_SCHED; PG8_LDA(At, 0, 0); PG8_STAGE(PG8_SA(1, 1), a1 + hstep, voffA);
            PG8_WAIT_V(8); PG8_WAIT_L(0); PG8_BAR; PG8_MMA(0, 0, At, B0); PG8_MMA(0, 1, At, B1); PG8_BAR; PG8_SCHED;
            PG8_LDA(At, 0, 1); PG8_STAGE(PG8_SB(0, 0), b2, voffB); PG8_STAGE(PG8_SB(0, 1), b2 + hstep, voffB); PG8_STAGE(PG8_SA(0, 0), a2, voffA);
            PG8_WAIT_V(8); PG8_WAIT_L(0); PG8_BAR; PG8_MMA(1, 0, At, B0); PG8_MMA(1, 1, At, B1); PG8_BAR; PG8_SCHED;
            PG8_LDB(B0, 1, 0); PG8_LDB(B1, 1, 1); PG8_SCHED; PG8_LDA(At, 1, 0); PG8_STAGE(PG8_SA(0, 1), a2 + hstep, voffA);
            PG8_WAIT_V(8); PG8_WAIT_L(0); PG8_BAR; PG8_MMA(0, 0, At, B0); PG8_MMA(0, 1, At, B1); PG8_BAR; PG8_SCHED;
            PG8_LDA(At, 1, 1); PG8_STAGE(PG8_SB(1, 0), b3, voffB); PG8_STAGE(PG8_SB(1, 1), b3 + hstep, voffB); PG8_STAGE(PG8_SA(1, 0), a3, voffA);
            PG8_WAIT_V(8); PG8_WAIT_L(0); PG8_BAR; PG8_MMA(1, 0, At, B0); PG8_MMA(1, 1, At, B1); PG8_BAR; PG8_SCHED;
            } else {
            PG8_LDB(B0, 0, 0); PG8_SCHED; PG8_LDA(At, 0, 0); PG8_STAGE(PG8_SA(1, 1), a1 + hstep, voffA);
            PG8_WAIT_L(8); PG8_BAR; PG8_WAIT_L(0); PG8_MMA(0, 0, At, B0); PG8_BAR; PG8_SCHED;
            PG8_LDB(B1, 0, 1); PG8_STAGE(PG8_SB(0, 0), b2, voffB);
            PG8_BAR; PG8_WAIT_L(0); PG8_MMA(0, 1, At, B1); PG8_BAR;
            PG8_LDA(At, 0, 1); PG8_STAGE(PG8_SA(0, 0), a2, voffA);
            PG8_BAR; PG8_WAIT_L(0); PG8_MMA(1, 0, At, B0); PG8_BAR; PG8_SCHED;
            PG8_STAGE(PG8_SB(0, 1), b2 + hstep, voffB);
            PG8_WAIT_V(6); PG8_BAR; PG8_MMA(1, 1, At, B1); PG8_BAR;
            PG8_LDB(B0, 1, 0); PG8_SCHED; PG8_LDA(At, 1, 0); PG8_STAGE(PG8_SA(0, 1), a2 + hstep, voffA);
            PG8_WAIT_L(8); PG8_BAR; PG8_WAIT_L(0); PG8_MMA(0, 0, At, B0); PG8_BAR; PG8_SCHED;
            PG8_LDB(B1, 1, 1); PG8_STAGE(PG8_SB(1, 0), b3, voffB);
            PG8_BAR; PG8_WAIT_L(0); PG8_MMA(0, 1, At, B1); PG8_BAR;
            PG8_LDA(At, 1, 1); PG8_STAGE(PG8_SA(1, 0), a3, voffA);
            PG8_BAR; PG8_WAIT_L(0); PG8_MMA(1, 0, At, B0); PG8_BAR; PG8_SCHED;
            PG8_STAGE(PG8_SB(1, 1), b3 + hstep, voffB);
            PG8_WAIT_V(6); PG8_BAR; PG8_MMA(1, 1, At, B1); PG8_BAR;
            }
        }
        if constexpr (ALIGN_EPI) { if (wr == 0) PG8_BAR; }
        if constexpr (!Epi::AFTER_DRAIN) { E(acc, cur, wr, wc, fr, fq); S.done(cur); }
        if (!has_next) break;
#pragma unroll
        for (int a = 0; a < 2; ++a)
#pragma unroll
            for (int b = 0; b < 2; ++b)
#pragma unroll
                for (int m = 0; m < 4; ++m)
#pragma unroll
                    for (int n = 0; n < 2; ++n) acc[a][b][m][n] = (f32x4){0.f, 0.f, 0.f, 0.f};
        cur = nxt; cA = nA; cB = nB; ++ui;
        if constexpr (ALIGN_EPI) { if (wr == 1) PG8_BAR; }
    }
    PG8_WAIT_V(0);
    if constexpr (!ALIGN_EPI) { if (wr == 0) PG8_BAR; }
    PG8_BAR;
    if constexpr (Epi::AFTER_DRAIN) { E.fused(acc, cur, wr, wc, fr, fq, lds, wid, lane); S.done(cur); }
#undef PG8_SA
#undef PG8_SB
#undef PG8_STAGE
#undef PG8_LDA
#undef PG8_LDB
#undef PG8_MMA
#undef PG8_WAIT_V
#undef PG8_WAIT_L
#undef PG8_BAR
#undef PG8_SCHED
}
}

#ifndef MK_MULTI
#define MK_MULTI 0
#endif
typedef unsigned short bf16_t;
typedef short bf16x8 __attribute__((ext_vector_type(8)));
typedef float f32x4 __attribute__((ext_vector_type(4)));
typedef float f32x16 __attribute__((ext_vector_type(16)));
typedef unsigned u32x4 __attribute__((ext_vector_type(4)));
typedef unsigned u32x2 __attribute__((ext_vector_type(2)));
typedef float f32x2_t __attribute__((ext_vector_type(2)));
typedef __bf16 bf16x2_t __attribute__((ext_vector_type(2)));
#define LAS __attribute__((address_space(3)))

constexpr int DM = 1024, SEQ = 8192, NB = 2, CTXL = 256, MX = NB * SEQ, MC = NB * CTXL, MT = MX + MC;
constexpr int DFF = 2816, NH = 8, HD = 64, INW = 2048, NMODW = 9 * DM;
constexpr float RMS_EPS = 1e-6f;
constexpr float LOG2E = 1.4426950408889634f;
constexpr float QSCALE = 0.125f * LOG2E;
constexpr int NPHASE = 22;
constexpr int NTHREADS = 512, NWAVES = 8;
constexpr int LDS_BYTES = 147456;

constexpr size_t MiB = 1u << 20;
constexpr size_t WS_MOD = 0;
constexpr size_t WS_ROPEC = 256 * 1024;
constexpr size_t WS_ROPES = 256 * 1024 + 8192;
constexpr size_t WS_BAR = 3 * MiB;
constexpr size_t WS_CTXS = 512 * 1024;
constexpr size_t WS_WGU = 4 * MiB;
constexpr size_t WS_WD = 48 * MiB;
constexpr size_t WS_WIN = 70 * MiB;
constexpr size_t WS_WOUT = 78 * MiB;
constexpr size_t WS_XN = 82 * MiB;
constexpr size_t WS_Y = 115 * MiB;
constexpr size_t WS_XS = 147 * MiB;
constexpr size_t WS_H = 211 * MiB;
constexpr size_t SZ_QK = (size_t)MT * 512 * 2;
constexpr size_t WS_Q = WS_H, WS_K = WS_Q + SZ_QK, WS_U = WS_K + SZ_QK, WS_VT = WS_U + SZ_QK, WS_MIX = WS_VT + SZ_QK;
constexpr size_t WS_YP = WS_MIX + (size_t)MT * 1024 * 2;
constexpr size_t WS_END = WS_YP + (size_t)11 * MC * 1024 * 4;
static_assert(WS_XN + (size_t)MT * 1024 * 2 <= WS_Y && WS_Y + (size_t)MX * 1024 * 2 <= WS_XS && WS_XS + (size_t)MX * 1024 * 4 <= WS_H && WS_H + (size_t)MT * DFF * 2 <= WS_YP, "ws map");

struct Params {
    const float *x, *c, *ctx, *cctx, *wmod, *bmod, *normg, *wgu, *wd, *win, *wout, *rpb, *wpool, *pscale;
    float* out; unsigned char* ws;
};
typedef const __attribute__((address_space(4))) Params* KParams;

__device__ __forceinline__ unsigned cvtpk(float lo, float hi) { f32x2_t v = {lo, hi}; bf16x2_t b = __builtin_convertvector(v, bf16x2_t); return __builtin_bit_cast(unsigned, b); }
__device__ __forceinline__ float bf2f(unsigned short h) { return __uint_as_float(((unsigned)h) << 16); }
__device__ __forceinline__ float wave_sum(float v) {
#define WS_DPP(ctrl, rmask) { const int x_ = __builtin_amdgcn_update_dpp(0, __float_as_int(v), (ctrl), (rmask), 0xf, false); v += __int_as_float(x_); }
    WS_DPP(0xB1, 0xf) WS_DPP(0x4E, 0xf) WS_DPP(0x141, 0xf) WS_DPP(0x140, 0xf) WS_DPP(0x142, 0xa) WS_DPP(0x143, 0xc)
#undef WS_DPP
    return __int_as_float(__builtin_amdgcn_readlane(__float_as_int(v), 63));
}

#define XB_TMO      128
#define XB_XCNT(j)  (256  + 64 * (j))
#define XB_XSUB(j)  (1280 + 64 * (j))
#define XB_XGEN(j)  (2304 + 64 * (j))
#define XB_TOP      3328
#define XB_TOPGEN   3392
#define XCD_BAR_WORDS 3456
#define XB_SPIN_CAP (1u << 18)

__device__ __forceinline__ unsigned xb_ld(unsigned* p)              { return __hip_atomic_load(p, __ATOMIC_RELAXED, __HIP_MEMORY_SCOPE_AGENT); }
__device__ __forceinline__ unsigned xb_add(unsigned* p, unsigned v) { return __hip_atomic_fetch_add(p, v, __ATOMIC_RELAXED, __HIP_MEMORY_SCOPE_AGENT); }
__device__ __forceinline__ unsigned xb_xcc_id() { return (unsigned)__builtin_amdgcn_s_getreg((3 << 11) | 20) & 0xFu; }
#define XB_SPIN(cond, bar) do { unsigned _sp = 0; while (cond) { __builtin_amdgcn_s_sleep(1); \
    if ((++_sp & 255u) == 0u) { if (xb_ld(&(bar)[XB_TMO])) break; if (_sp > XB_SPIN_CAP) { atomicAdd(&(bar)[XB_TMO], 1u); break; } } } } while (0)

struct XcdBarrier {
    unsigned* bar; unsigned x;
    volatile LAS unsigned* st;
};

__device__ __forceinline__ XcdBarrier xcd_barrier_post(unsigned* bar, volatile LAS unsigned* st) {
    XcdBarrier b; b.bar = bar; b.x = xb_xcc_id(); b.st = st;
    if (threadIdx.x == 0) (void)xb_add(&bar[XB_XCNT(b.x)], 1u);
    return b;
}
__device__ __forceinline__ void xcd_barrier_complete(unsigned* bar, unsigned x, unsigned& nloc, unsigned& nx) {
    const unsigned G = gridDim.x * gridDim.y * gridDim.z;
    unsigned sum, cnt, mine, sp = 0u;
    for (;;) {
        sum = 0u; cnt = 0u; mine = 0u;
#pragma unroll
        for (unsigned j = 0; j < 16; ++j) { const unsigned c = xb_ld(&bar[XB_XCNT(j)]); sum += c; cnt += (c > 0u) ? 1u : 0u; mine = (j == x) ? c : mine; }
        if (sum == G) break;
        __builtin_amdgcn_s_sleep(1);
        if ((++sp & 255u) == 0u) { if (xb_ld(&bar[XB_TMO])) break; if (sp > XB_SPIN_CAP) { atomicAdd(&bar[XB_TMO], 1u); break; } }
    }
    nloc = mine > 0u ? mine : 1u; nx = cnt > 0u ? cnt : 1u;
}

__device__ __forceinline__ void xcd_barrier(const XcdBarrier& b) {
    asm volatile("s_waitcnt vmcnt(0)" ::: "memory");
    __syncthreads();
    if (threadIdx.x == 0) {
        unsigned* bar = b.bar;
        __builtin_amdgcn_s_waitcnt(0);
        unsigned nloc = b.st[0], nx = b.st[1];
        if (nloc == 0u) { xcd_barrier_complete(bar, b.x, nloc, nx); b.st[0] = nloc; b.st[1] = nx; }
        const unsigned old = xb_add(&bar[XB_XSUB(b.x)], 1u);
        const unsigned gen = old / nloc;
        if (old + 1u == (gen + 1u) * nloc) {
            __builtin_amdgcn_fence(__ATOMIC_RELEASE, "agent");
            asm volatile("s_waitcnt vmcnt(0)" ::: "memory");
            const unsigned og = xb_add(&bar[XB_TOP], 1u);
            const unsigned tg = og / nx;
            if (og + 1u == (tg + 1u) * nx) xb_add(&bar[XB_TOPGEN], 1u);
            else XB_SPIN(xb_ld(&bar[XB_TOPGEN]) == tg, bar);
            __builtin_amdgcn_fence(__ATOMIC_ACQUIRE, "agent");
            xb_add(&bar[XB_XGEN(b.x)], 1u);
            asm volatile("s_waitcnt vmcnt(0)" ::: "memory");
        } else {
            XB_SPIN(xb_ld(&bar[XB_XGEN(b.x)]) == gen, bar);
            __builtin_amdgcn_fence(__ATOMIC_ACQUIRE, "agent");
            asm volatile("s_waitcnt vmcnt(0)" ::: "memory");
        }
    }
    __syncthreads();
}

using pg8::Unit;
enum { EPI_SWIGLU = 0, EPI_F32 = 1, EPI_QKU = 2, EPI_BF16 = 3 };
struct EpiAny {
    static constexpr bool AFTER_DRAIN = false;
    int mode; bool perm; void* O; int ldc; const float *ropeC, *ropeS; int pstride, ntp;
    __device__ __forceinline__ static float sw(float g, float u) { return g * u * __builtin_amdgcn_rcpf(1.0f + __builtin_amdgcn_exp2f(-g * LOG2E)); }
    __device__ __forceinline__ void operator()(const f32x4 (&acc)[2][2][4][2], const Unit& u, int wr, int wc, int fr, int fq) const {
        if (mode == EPI_SWIGLU) {
            bf16_t* H = (bf16_t*)O;
            const int row0 = u.pm * 256 + wr * 64 + fr, col0 = u.pn * 128 + wc * 32 + 8 * fq;
#pragma unroll
            for (int ai = 0; ai < 2; ++ai)
#pragma unroll
                for (int m = 0; m < 4; ++m) {
                    bf16_t* p = H + (size_t)(row0 + ai * 128 + m * 16) * DFF + col0;
                    const f32x4 g0 = acc[ai][0][m][0], g1 = acc[ai][0][m][1], u0 = acc[ai][1][m][0], u1 = acc[ai][1][m][1];
                    f32x4 e0 = g0 * (-LOG2E), e1 = g1 * (-LOG2E);
#pragma unroll
                    for (int i = 0; i < 4; ++i) { e0[i] = __builtin_amdgcn_exp2f(e0[i]); e1[i] = __builtin_amdgcn_exp2f(e1[i]); }
                    e0 = e0 + 1.0f; e1 = e1 + 1.0f;
#pragma unroll
                    for (int i = 0; i < 4; ++i) { e0[i] = __builtin_amdgcn_rcpf(e0[i]); e1[i] = __builtin_amdgcn_rcpf(e1[i]); }
                    const f32x4 o0 = (g0 * u0) * e0, o1 = (g1 * u1) * e1;
                    u32x4 w; w.x = cvtpk(o0[0], o0[1]); w.y = cvtpk(o0[2], o0[3]); w.z = cvtpk(o1[0], o1[1]); w.w = cvtpk(o1[2], o1[3]);
                    *(u32x4*)p = w;
                }
        } else if (mode == EPI_F32) {
            float* Y = (float*)O + ((ntp > 0) ? (size_t)(u.kb / ntp) * (size_t)pstride : (size_t)0);
            const int row0 = u.pm * 256 + wr * 64 + fr, col0 = u.pn * 256 + wc * 32 + 4 * fq;
#pragma unroll
            for (int ai = 0; ai < 2; ++ai)
#pragma unroll
                for (int m = 0; m < 4; ++m) {
                    float* p = Y + (size_t)(row0 + ai * 128 + m * 16) * ldc + col0;
#pragma unroll
                    for (int bj = 0; bj < 2; ++bj)
#pragma unroll
                        for (int n = 0; n < 2; ++n) *(f32x4*)(p + bj * 128 + n * 16) = acc[ai][bj][m][n];
                }
        } else if (mode == EPI_QKU) {
            const int t = u.pn >> 1; bf16_t* base = (bf16_t*)O + (size_t)t * ((size_t)MT * 512);
            const float sc = (t == 0) ? QSCALE : 1.0f;
            const bool rope = (t < 2) && (u.pm < MX / 256);
            const int cb = (u.pn & 1) * 256 + wc * 32 + 4 * fq;
#pragma unroll
            for (int ai = 0; ai < 2; ++ai)
#pragma unroll
                for (int m = 0; m < 4; ++m) {
                    const int row = u.pm * 256 + ai * 128 + wr * 64 + m * 16 + fr;
                    bf16_t* p = base + (size_t)row * 512 + cb;
                    f32x4 c4 = {1.f, 1.f, 1.f, 1.f}, s4 = {0.f, 0.f, 0.f, 0.f};
                    if (rope) { const int s = row & (SEQ - 1); const int pos = (wc & 1) ? (s & 63) : (s >> 6);
                        c4 = *(const f32x4*)(ropeC + pos * 16 + 4 * fq); s4 = *(const f32x4*)(ropeS + pos * 16 + 4 * fq); }
#pragma unroll
                    for (int bj = 0; bj < 2; ++bj) {
                        const f32x4 x1 = acc[ai][bj][m][0], x2 = acc[ai][bj][m][1];
                        const f32x4 o1 = (x1 * c4 - x2 * s4) * sc, o2 = (x2 * c4 + x1 * s4) * sc;
                        u32x2 w1, w2; w1.x = cvtpk(o1[0], o1[1]); w1.y = cvtpk(o1[2], o1[3]); w2.x = cvtpk(o2[0], o2[1]); w2.y = cvtpk(o2[2], o2[3]);
                        *(u32x2*)(p + bj * 128) = w1; *(u32x2*)(p + bj * 128 + 16) = w2;
                    }
                }
        } else {
            bf16_t* Ob = (bf16_t*)O;
            const int row0 = u.pm * 256 + wr * 64 + fr, col0 = u.pn * 256 + wc * 32 + 8 * fq;
#pragma unroll
            for (int ai = 0; ai < 2; ++ai)
#pragma unroll
                for (int m = 0; m < 4; ++m) {
                    bf16_t* p = Ob + (size_t)(row0 + ai * 128 + m * 16) * ldc + col0;
#pragma unroll
                    for (int bj = 0; bj < 2; ++bj) { const f32x4 v0 = acc[ai][bj][m][0], v1 = acc[ai][bj][m][1];
                        u32x4 w; w.x = cvtpk(v0[0], v0[1]); w.y = cvtpk(v0[2], v0[3]); w.z = cvtpk(v1[0], v1[1]); w.w = cvtpk(v1[2], v1[3]);
                        *(u32x4*)(p + bj * 128) = w; }
                }
        }
    }
};

__device__ __forceinline__ void p0_transpose_item(const float* W, int ldw, int k0, int n0, bf16_t* WT, int ldt, int dst_row0, LAS unsigned char* scr, int lane) {
    f32x4 v[16];
    const float* src = W + (size_t)(k0 + (lane >> 4)) * ldw + n0 + 4 * (lane & 15);
#pragma unroll
    for (int i = 0; i < 16; ++i) v[i] = __builtin_nontemporal_load((const f32x4*)(src + (size_t)(4 * i) * ldw));
#pragma unroll
    for (int i = 0; i < 16; ++i) { LAS unsigned* p = (LAS unsigned*)(scr + (4 * i + (lane >> 4)) * 132 + 8 * (lane & 15)); p[0] = cvtpk(v[i][0], v[i][1]); p[1] = cvtpk(v[i][2], v[i][3]); }
    asm volatile("s_waitcnt lgkmcnt(0)" ::: "memory");
    const int c = lane & 7;
#pragma unroll
    for (int j = 0; j < 4; ++j) { const int np = (lane >> 3) + 8 * j; unsigned w[8];
#pragma unroll
        for (int i = 0; i < 8; ++i) w[i] = *(const LAS unsigned*)(scr + (8 * c + i) * 132 + 4 * np);
        u32x4 lo, hi;
        lo.x = (w[0] & 0xffffu) | (w[1] << 16); lo.y = (w[2] & 0xffffu) | (w[3] << 16); lo.z = (w[4] & 0xffffu) | (w[5] << 16); lo.w = (w[6] & 0xffffu) | (w[7] << 16);
        hi.x = (w[0] >> 16) | (w[1] & 0xffff0000u); hi.y = (w[2] >> 16) | (w[3] & 0xffff0000u); hi.z = (w[4] >> 16) | (w[5] & 0xffff0000u); hi.w = (w[6] >> 16) | (w[7] & 0xffff0000u);
        *(u32x4*)(WT + (size_t)(dst_row0 + 2 * np) * ldt + k0 + 8 * c) = lo;
        *(u32x4*)(WT + (size_t)(dst_row0 + 2 * np + 1) * ldt + k0 + 8 * c) = hi; }
    asm volatile("s_waitcnt lgkmcnt(0)" ::: "memory");
}

__device__ __forceinline__ void phase_p0(KParams P, LAS unsigned char* lds, int tid, int wave, int lane, int bx, int G) {
    unsigned char* ws = P->ws;
    float* MOD = (float*)(ws + WS_MOD);
    const int gt = bx * NTHREADS + tid;
    if (gt < 2048) {
        const int pos = gt >> 4, i = gt & 15;
        const float inv = exp2f(-(float)i * 0.83048202372184058696f);
        const float angf = (float)pos * inv;
        const double a = (double)angf; const double kq = rint(a * 0.63661977236758134308); const double r = a - kq * 1.57079632679489661923; const double r2 = r * r;
        double sr = r, cr = 1.0, ts = r, tc = 1.0;
#pragma unroll 1
        for (int k = 1; k <= 8; ++k) { const double k2 = (double)(2 * k); tc *= -r2 / (k2 * (k2 - 1.0)); ts *= -r2 / (k2 * (k2 + 1.0)); cr += tc; sr += ts; }
        const int q = ((int)kq) & 3;
        const double cv = (q == 0) ? cr : (q == 1) ? -sr : (q == 2) ? -cr : sr;
        const double sv = (q == 0) ? sr : (q == 1) ? cr : (q == 2) ? -sr : -cr;
        ((float*)(ws + WS_ROPEC))[gt] = (float)cv; ((float*)(ws + WS_ROPES))[gt] = (float)sv;
    }
    constexpr int J_MOD = 72, J_FOLD = 128, J_TR = 1216, NJOBS = J_MOD + J_FOLD + J_TR;
    unsigned* jq = (unsigned*)(ws + WS_BAR + 32768);
    LAS int* jb = (LAS int*)(lds + 131072 + 128);
    for (;;) {
        if (tid == 0) *jb = (int)__hip_atomic_fetch_add(jq, 1u, __ATOMIC_RELAXED, __HIP_MEMORY_SCOPE_AGENT);
        __syncthreads();
        const int job = *jb;
        __syncthreads();
        if (job >= NJOBS) break;
        if (job < J_MOD) {
            LAS float* sc = (LAS float*)lds;
            LAS float* red = sc + 3072;
            for (int i = tid; i < 3072; i += NTHREADS) { const int who = i >> 10, k = i & 1023; const float v = (who < 2) ? P->c[who * 1024 + k] : P->cctx[k]; sc[i] = v / (1.0f + __expf(-v)); }
            __syncthreads();
            const int l = job / 36, cc = job % 36, col = cc * 256 + 4 * lane;
            const float* W = P->wmod + ((size_t)l * 1024 + wave * 128) * NMODW + col;
            f32x4 a0 = {0.f, 0.f, 0.f, 0.f}, a1 = a0, a2 = a0;
#pragma unroll 16
            for (int k = 0; k < 128; ++k) { const f32x4 w = __builtin_nontemporal_load((const f32x4*)(W + (size_t)k * NMODW)); const int kk = wave * 128 + k; a0 += w * sc[kk]; a1 += w * sc[1024 + kk]; a2 += w * sc[2048 + kk]; }
            *(LAS f32x4*)(red + (wave * 3 + 0) * 256 + 4 * lane) = a0; *(LAS f32x4*)(red + (wave * 3 + 1) * 256 + 4 * lane) = a1; *(LAS f32x4*)(red + (wave * 3 + 2) * 256 + 4 * lane) = a2;
            __syncthreads();
            for (int o = tid; o < 768; o += NTHREADS) { const int who = o >> 8, cl = o & 255; float s = 0.f;
#pragma unroll
                for (int w = 0; w < 8; ++w) s += red[(w * 3 + who) * 256 + cl];
                MOD[(size_t)(l * 3 + who) * NMODW + cc * 256 + cl] = s + P->bmod[l * NMODW + cc * 256 + cl]; }
            __syncthreads();
        } else if (job < J_MOD + J_FOLD) {
            const int r = job - J_MOD, nb = r & 15, g = (r >> 4) & 3, l = r >> 6;
            LAS float* A = (LAS float*)lds;
            LAS float* B = (LAS float*)(lds + 128 * 132 * 4);
            LAS bf16_t* OT = (LAS bf16_t*)(lds + 128 * 132 * 4 + 128 * 64 * 4);
            const float* wp = P->wpool + (size_t)(l * 4 + g) * 128 * 128; const float* ps = P->pscale + l * 512 + g * 128;
            const float* wo = P->wout + ((size_t)l * 1024 + 512 + g * 128) * 1024 + nb * 64;
#pragma unroll 8
            for (int i = 0; i < 32; ++i) { const int idx = tid + NTHREADS * i, c = idx >> 7, d = idx & 127; A[c * 132 + d] = wp[idx] * ps[d]; }
#pragma unroll 8
            for (int i = 0; i < 16; ++i) { const int idx = tid + NTHREADS * i, d = idx >> 6, n = idx & 63; B[idx] = wo[(size_t)d * 1024 + n]; }
            __syncthreads();
            const int c = tid >> 2, nq = tid & 3;
            f32x4 acc[4];
#pragma unroll
            for (int j = 0; j < 4; ++j) acc[j] = (f32x4){0.f, 0.f, 0.f, 0.f};
#pragma unroll 4
            for (int d = 0; d < 128; ++d) { const float a = A[c * 132 + d];
#pragma unroll
                for (int j = 0; j < 4; ++j) acc[j] += *(const LAS f32x4*)(B + d * 64 + 16 * nq + 4 * j) * a; }
#pragma unroll
            for (int j = 0; j < 4; ++j)
#pragma unroll
                for (int e = 0; e < 4; ++e) OT[(16 * nq + 4 * j + e) * 128 + c] = (bf16_t)(cvtpk(acc[j][e], 0.f) & 0xffffu);
            __syncthreads();
            bf16_t* dst = (bf16_t*)(ws + WS_WOUT) + ((size_t)l * 1024 + nb * 64) * 1024 + 512 + g * 128;
#pragma unroll
            for (int i = 0; i < 2; ++i) { const int ch = tid + NTHREADS * i, n = ch >> 4, cc8 = ch & 15; *(u32x4*)(dst + (size_t)n * 1024 + cc8 * 8) = *(const LAS u32x4*)(OT + n * 128 + cc8 * 8); }
            __syncthreads();
        } else {
            LAS unsigned char* scr = lds + wave * 8448;
            int tj = job - J_MOD - J_FOLD; const int wk = wave >> 2, wn = wave & 3;
            if (tj < 704) { const int ls = tj / 176, r = tj % 176, kb = r / 22, nb = r % 22, k0 = kb * 128 + wk * 64, n0 = nb * 256 + wn * 64;
                const int cidx = (n0 < DFF) ? n0 : n0 - DFF; const int drow = 256 * (cidx >> 7) + (cidx & 127) + ((n0 < DFF) ? 0 : 128);
                p0_transpose_item(P->wgu + (size_t)ls * 1024 * 5632, 5632, k0, n0, (bf16_t*)(ws + WS_WGU) + (size_t)ls * 5632 * 1024, 1024, drow, scr, lane); }
            else if ((tj -= 704) < 352) { const int ls = tj / 88, r = tj % 88, kb = r / 4, nb = r % 4, k0 = kb * 128 + wk * 64, n0 = nb * 256 + wn * 64;
                p0_transpose_item(P->wd + (size_t)ls * DFF * 1024, 1024, k0, n0, (bf16_t*)(ws + WS_WD) + (size_t)ls * 1024 * DFF, DFF, n0, scr, lane); }
            else if ((tj -= 352) < 128) { const int l = tj / 64, r = tj % 64, kb = r / 8, nb = r % 8, k0 = kb * 128 + wk * 64, n0 = nb * 256 + wn * 64;
                const int drow = (n0 < 1024) ? n0 : (n0 < 1536) ? n0 + 512 : n0 - 512;
                p0_transpose_item(P->win + (size_t)l * 1024 * INW, INW, k0, n0, (bf16_t*)(ws + WS_WIN) + (size_t)l * INW * 1024, 1024, drow, scr, lane); }
            else { tj -= 128; const int l = tj / 16, r = tj % 16, kb = r / 4, nb = r % 4, k0 = kb * 128 + wk * 64, n0 = nb * 256 + wn * 64;
                p0_transpose_item(P->wout + (size_t)l * 1024 * 1024, 1024, k0, n0, (bf16_t*)(ws + WS_WOUT) + (size_t)l * 1024 * 1024, 1024, n0, scr, lane); }
        }
    }
}

struct RowPass {
    const float *srcX, *srcC; float *dstX, *dstC; const bf16_t* srcXb; bf16_t* dstXb;
    const bf16_t* Yb; const float *gate, *gpost; float coef;
    const float *shift, *scale, *gpre; bf16_t* XN;
    int M; bool hasY, hasXN; const float* YP; int nparts;
};
template <int RPT> __device__ __forceinline__ void row_range(const RowPass& R, const LAS float* mv, int lane, int gw, int NGW, int mlo, int mhi) {
    for (int m0 = mlo + RPT * gw; m0 < mhi; m0 += RPT * NGW) {
        const int who = (m0 < SEQ) ? 0 : (m0 < MX) ? 1 : 2;
        const bool isx = m0 < MX;
        f32x4 v[RPT][4];
#pragma unroll
        for (int rr = 0; rr < RPT; ++rr) { const int m = m0 + rr;
            if (isx && R.srcXb) {
#pragma unroll
                for (int j = 0; j < 4; ++j) { const u32x2 w = __builtin_nontemporal_load((const u32x2*)(R.srcXb + (size_t)m * DM + 4 * lane + 256 * j));
                    v[rr][j] = (f32x4){__uint_as_float(w.x << 16), __uint_as_float(w.x & 0xffff0000u), __uint_as_float(w.y << 16), __uint_as_float(w.y & 0xffff0000u)}; }
            } else { const float* xin = isx ? R.srcX + (size_t)m * DM : R.srcC + (size_t)(m - MX) * DM;
#pragma unroll
                for (int j = 0; j < 4; ++j) v[rr][j] = __builtin_nontemporal_load((const f32x4*)(xin + 4 * lane + 256 * j)); } }
        if (R.hasY) {
            f32x4 y[RPT][4]; float ss[RPT];
#pragma unroll
            for (int rr = 0; rr < RPT; ++rr) ss[rr] = 0.f;
#pragma unroll
            for (int rr = 0; rr < RPT; ++rr) { const int m = m0 + rr;
#pragma unroll
                for (int j = 0; j < 4; ++j) {
                    if (isx) { const u32x2 w = __builtin_nontemporal_load((const u32x2*)(R.Yb + (size_t)m * DM + 4 * lane + 256 * j));
                        y[rr][j] = (f32x4){__uint_as_float(w.x << 16), __uint_as_float(w.x & 0xffff0000u), __uint_as_float(w.y << 16), __uint_as_float(w.y & 0xffff0000u)}; }
                    else { f32x4 tp[11];
#pragma unroll
                        for (int p = 0; p < 11; ++p) tp[p] = *(const f32x4*)(R.YP + ((size_t)min(p, R.nparts - 1) * MC + (m - MX)) * DM + 4 * lane + 256 * j);
                        f32x4 t = tp[0];
#pragma unroll
                        for (int p = 1; p < 11; ++p) t += tp[p] * ((p < R.nparts) ? 1.0f : 0.0f);
                        y[rr][j] = t; }
                    ss[rr] += (y[rr][j].x * y[rr][j].x + y[rr][j].y * y[rr][j].y) + (y[rr][j].z * y[rr][j].z + y[rr][j].w * y[rr][j].w); } }
#pragma unroll
            for (int rr = 0; rr < RPT; ++rr) ss[rr] = wave_sum(ss[rr]);
#pragma unroll
            for (int rr = 0; rr < RPT; ++rr) { const int m = m0 + rr;
                const float rs = rsqrtf(ss[rr] * (1.0f / DM) + RMS_EPS) * R.coef;
#pragma unroll
                for (int j = 0; j < 4; ++j) { const int col = 4 * lane + 256 * j; const f32x4 gt = *(const LAS f32x4*)(mv + who * 1024 + col), gp = *(const LAS f32x4*)(mv + 9 * 1024 + col);
                    v[rr][j] = v[rr][j] + gt * (y[rr][j] * rs * gp); }
                if (isx && R.dstXb) {
#pragma unroll
                    for (int j = 0; j < 4; ++j) { u32x2 w; w.x = cvtpk(v[rr][j][0], v[rr][j][1]); w.y = cvtpk(v[rr][j][2], v[rr][j][3]); *(u32x2*)(R.dstXb + (size_t)m * DM + 4 * lane + 256 * j) = w;
                        v[rr][j] = (f32x4){__uint_as_float(w.x << 16), __uint_as_float(w.x & 0xffff0000u), __uint_as_float(w.y << 16), __uint_as_float(w.y & 0xffff0000u)}; }
                } else { float* xo = isx ? R.dstX + (size_t)m * DM : R.dstC + (size_t)(m - MX) * DM;
#pragma unroll
                    for (int j = 0; j < 4; ++j) *(f32x4*)(xo + 4 * lane + 256 * j) = v[rr][j]; } }
        }
        if (R.hasXN) {
            float ss[RPT];
#pragma unroll
            for (int rr = 0; rr < RPT; ++rr) ss[rr] = 0.f;
#pragma unroll
            for (int rr = 0; rr < RPT; ++rr)
#pragma unroll
                for (int j = 0; j < 4; ++j) ss[rr] += (v[rr][j].x * v[rr][j].x + v[rr][j].y * v[rr][j].y) + (v[rr][j].z * v[rr][j].z + v[rr][j].w * v[rr][j].w);
#pragma unroll
            for (int rr = 0; rr < RPT; ++rr) ss[rr] = wave_sum(ss[rr]);
#pragma unroll
            for (int rr = 0; rr < RPT; ++rr) { const int m = m0 + rr;
                const float rs = rsqrtf(ss[rr] * (1.0f / DM) + RMS_EPS);
#pragma unroll
                for (int j = 0; j < 4; ++j) { const int col = 4 * lane + 256 * j;
                    const f32x4 gp = *(const LAS f32x4*)(mv + 10 * 1024 + col), sh = *(const LAS f32x4*)(mv + (3 + who) * 1024 + col), sc = *(const LAS f32x4*)(mv + (6 + who) * 1024 + col);
                    const f32x4 o = (v[rr][j] * rs * gp) * (sc + 1.0f) + sh;
                    u32x2 w; w.x = cvtpk(o[0], o[1]); w.y = cvtpk(o[2], o[3]);
                    *(u32x2*)(R.XN + (size_t)m * DM + col) = w; } }
        }
    }
}

__device__ __forceinline__ void phase_row(const RowPass& R, LAS unsigned char* lds, int tid, int wave, int lane, int bx, int G) {
    const int gw = bx * NWAVES + wave, NGW = G * NWAVES;
    LAS float* mv = (LAS float*)lds;
    for (int i = tid; i < 11 * 256; i += NTHREADS) { const int vec = i >> 8, c4 = (i & 255) * 4;
        const float* src = (vec < 3) ? R.gate + vec * NMODW : (vec < 6) ? R.shift + (vec - 3) * NMODW : (vec < 9) ? R.scale + (vec - 6) * NMODW : (vec == 9) ? R.gpost : R.gpre;
        *(LAS f32x4*)(mv + vec * 1024 + c4) = *(const f32x4*)(src + c4); }
    __syncthreads();
    row_range<4>(R, mv, lane, gw, NGW, 0, (R.M < MX) ? R.M : MX);
    if (R.M > MX && wave == 0) row_range<2>(R, mv, lane, bx, G, MX, R.M);
}

#define MFMA32(a, b, c) __builtin_amdgcn_mfma_f32_32x32x16_bf16((a), (b), (c), 0, 0, 0)
struct KFrag { bf16x8 k[4]; };
struct VFrag { bf16x8 v[4]; };
__device__ __forceinline__ void attn_loadk(KFrag& f, const bf16_t* kbase, int krow0) {
    const bf16_t* kp = kbase + (size_t)krow0 * 512;
#pragma unroll
    for (int dk = 0; dk < 4; ++dk) f.k[dk] = *(const bf16x8*)(kp + dk * 16);
}
__device__ __forceinline__ void attn_loadv(VFrag& f, const bf16_t* vbase, int krow0) {
    const bf16_t* vp = vbase + krow0;
    f.v[0] = *(const bf16x8*)(vp); f.v[1] = *(const bf16x8*)(vp + 16); f.v[2] = *(const bf16x8*)(vp + (size_t)32 * MT); f.v[3] = *(const bf16x8*)(vp + (size_t)32 * MT + 16);
}
constexpr int KL_OFF = 32768, KL_PITCH = 144, VL_OFF = KL_OFF + 256 * KL_PITCH, VL_PITCH = 528;
__device__ __forceinline__ void attn_loadk_lds(KFrag& f, const LAS unsigned char* kl, int t) {
    const LAS unsigned char* p = kl + t * (32 * KL_PITCH);
#pragma unroll
    for (int dk = 0; dk < 4; ++dk) f.k[dk] = *(const LAS bf16x8*)(p + dk * 32);
}
__device__ __forceinline__ void attn_loadv_lds(VFrag& f, const LAS unsigned char* vl, int t) {
    const LAS unsigned char* p = vl + t * 64;
    f.v[0] = *(const LAS bf16x8*)(p); f.v[1] = *(const LAS bf16x8*)(p + 32); f.v[2] = *(const LAS bf16x8*)(p + 32 * VL_PITCH); f.v[3] = *(const LAS bf16x8*)(p + 32 * VL_PITCH + 32);
}
__device__ __forceinline__ void attn_soft(f32x16& S, f32x16& o0, f32x16& o1, float& mrun, float& lrun, bool masked, const LAS float* bt, int relb, int idxb, bf16x8& pb0, bf16x8& pb1) {
    if (masked) {
        const LAS float* bp = bt + idxb;
        float bv[16];
#pragma unroll
        for (int r = 0; r < 16; ++r) bv[r] = bp[16 * (r >> 3) + (r & 7)];
#pragma unroll
        for (int r = 0; r < 16; ++r) {
            const int off = 16 * (r >> 3) + (r & 7);
            const bool valid = (unsigned)(relb + off) < 16u;
            S[r] = valid ? S[r] + bv[r] : -1e30f;
        }
    }
    float tm = S[0];
#pragma unroll
    for (int r = 1; r < 16; ++r) tm = fmaxf(tm, S[r]);
    tm = fmaxf(tm, __shfl_xor(tm, 32));
    if (__any(tm > mrun)) {
        const float mn = fmaxf(mrun, tm);
        const float fs = __builtin_amdgcn_exp2f(mrun - mn);
        mrun = mn; lrun *= fs;
#pragma unroll
        for (int r = 0; r < 16; ++r) { o0[r] *= fs; o1[r] *= fs; }
    }
    float ps = 0.f;
#pragma unroll
    for (int r = 0; r < 16; ++r) { S[r] = __builtin_amdgcn_exp2f(S[r] - mrun); ps += S[r]; }
    lrun += ps;
    u32x4 w0, w1;
    w0.x = cvtpk(S[0], S[1]); w0.y = cvtpk(S[2], S[3]); w0.z = cvtpk(S[4], S[5]); w0.w = cvtpk(S[6], S[7]);
    w1.x = cvtpk(S[8], S[9]); w1.y = cvtpk(S[10], S[11]); w1.z = cvtpk(S[12], S[13]); w1.w = cvtpk(S[14], S[15]);
    pb0 = __builtin_bit_cast(bf16x8, w0); pb1 = __builtin_bit_cast(bf16x8, w1);
}
struct AttnState { f32x16 o0, o1; float m, l; };
__device__ __forceinline__ void attn_comp2(KFrag& fk, const VFrag& f, const bf16x8 (&qa)[4], const bf16x8 (&qb)[4], AttnState& A, AttnState& B,
                                           bool masked, const LAS float* bt, int relA, int idxA, int relB, int idxB, const bf16_t* kbase, int nextrow, const LAS unsigned char* kl, int nextlds) {
    f32x16 SA, SB;
#pragma unroll
    for (int r = 0; r < 16; ++r) { SA[r] = 0.f; SB[r] = 0.f; }
#pragma unroll
    for (int dk = 0; dk < 4; ++dk) { SA = MFMA32(fk.k[dk], qa[dk], SA); SB = MFMA32(fk.k[dk], qb[dk], SB); }
    if (nextlds >= 0) attn_loadk_lds(fk, kl, nextlds);
    else if (nextrow >= 0) attn_loadk(fk, kbase, nextrow);
    bf16x8 p0, p1;
    attn_soft(SA, A.o0, A.o1, A.m, A.l, masked, bt, relA, idxA, p0, p1);
    A.o0 = MFMA32(f.v[0], p0, A.o0); A.o0 = MFMA32(f.v[1], p1, A.o0); A.o1 = MFMA32(f.v[2], p0, A.o1); A.o1 = MFMA32(f.v[3], p1, A.o1);
    attn_soft(SB, B.o0, B.o1, B.m, B.l, masked, bt, relB, idxB, p0, p1);
    B.o0 = MFMA32(f.v[0], p0, B.o0); B.o0 = MFMA32(f.v[1], p1, B.o0); B.o1 = MFMA32(f.v[2], p0, B.o1); B.o1 = MFMA32(f.v[3], p1, B.o1);
}
__device__ __forceinline__ void attn_store(const AttnState& A, bf16_t* op) {
    const float lt = A.l + __shfl_xor(A.l, 32);
    const float inv = 1.0f / lt;
#pragma unroll
    for (int g4 = 0; g4 < 4; ++g4) {
        u32x2 w; w.x = cvtpk(A.o0[4 * g4] * inv, A.o0[4 * g4 + 1] * inv); w.y = cvtpk(A.o0[4 * g4 + 2] * inv, A.o0[4 * g4 + 3] * inv); *(u32x2*)(op + 8 * g4) = w;
        u32x2 z; z.x = cvtpk(A.o1[4 * g4] * inv, A.o1[4 * g4 + 1] * inv); z.y = cvtpk(A.o1[4 * g4 + 2] * inv, A.o1[4 * g4 + 3] * inv); *(u32x2*)(op + 32 + 8 * g4) = z;
    }
}

__device__ __forceinline__ void phase_mix(KParams P, int layer, LAS unsigned char* lds, int tid, int wave, int lane, int bx, int G) {
    unsigned char* ws = P->ws;
    const bf16_t* Qb = (const bf16_t*)(ws + WS_Q); const bf16_t* Kb = (const bf16_t*)(ws + WS_K); const bf16_t* Ub = (const bf16_t*)(ws + WS_U);
    const bf16_t* Vt = (const bf16_t*)(ws + WS_VT); bf16_t* MIXb = (bf16_t*)(ws + WS_MIX);
    LAS float* bt = (LAS float*)(lds + wave * 2560) + 64;
    const int vb = (G % 8 == 0) ? (bx % 8) * (G / 8) + bx / 8 : bx;
    const int gw = vb * NWAVES + wave, NGW = G * NWAVES;
    const int q = lane & 31, hi = lane >> 5, pi = (q & 0x13) | ((q & 4) << 1) | ((q & 8) >> 1);
    const int nunits = 2048 + ((layer == 0) ? 64 : 0);
    for (int un = gw; un < nunits; un += NGW) {
        int b, h, qrow0, r = 0; const bool local = un < 2048;
        if (local) { r = un & 127; h = (un >> 7) & 7; b = un >> 10; qrow0 = b * SEQ + r * 64; }
        else { const int v = un - 2048; const int qb = v & 3; h = (v >> 2) & 7; b = v >> 5; qrow0 = MX + b * CTXL + qb * 64; }
        if (local) {
            const float* rp = P->rpb + (size_t)(layer * NH + h) * 465;
            for (int i = lane; i < 465; i += 64) bt[i] = rp[i] * LOG2E;
        }
        const int crow0 = MX + b * CTXL;
        if (local) {
            const bf16_t* ksrc = Kb + (size_t)crow0 * 512 + h * 64; const bf16_t* vsrc = Vt + (size_t)(h * 64) * MT + crow0;
#pragma unroll
            for (int i = 0; i < 4; ++i) { const int c = tid + NTHREADS * i;
                *(LAS u32x4*)(lds + KL_OFF + (c >> 3) * KL_PITCH + (c & 7) * 16) = *(const u32x4*)(ksrc + (size_t)(c >> 3) * 512 + (c & 7) * 8);
                *(LAS u32x4*)(lds + VL_OFF + (c >> 5) * VL_PITCH + (c & 31) * 16) = *(const u32x4*)(vsrc + (size_t)(c >> 5) * MT + (c & 31) * 8); }
            __syncthreads();
        }
        const LAS unsigned char* kl = lds + KL_OFF + pi * KL_PITCH + hi * 16; const LAS unsigned char* vl = lds + VL_OFF + q * VL_PITCH + hi * 16;
        bf16x8 qa[4], qb4[4];
#pragma unroll
        for (int dk = 0; dk < 4; ++dk) { qa[dk] = *(const bf16x8*)(Qb + (size_t)(qrow0 + q) * 512 + h * 64 + dk * 16 + hi * 8);
                                         qb4[dk] = *(const bf16x8*)(Qb + (size_t)(qrow0 + 32 + q) * 512 + h * 64 + dk * 16 + hi * 8); }
        AttnState A, B;
#pragma unroll
        for (int i = 0; i < 16; ++i) { A.o0[i] = 0.f; A.o1[i] = 0.f; B.o0[i] = 0.f; B.o1[i] = 0.f; }
        A.m = -1e30f; A.l = 0.f; B.m = -1e30f; B.l = 0.f;
        const int rs = min(max(r - 4, 0), 120);
        const int jA = q, jB = 32 + q, csA = min(max(jA - 8, 0), 48), csB = min(max(jB - 8, 0), 48);
        const int lrow0 = b * SEQ + rs * 64;
        const bf16_t* kbase = Kb + (size_t)pi * 512 + h * 64 + hi * 8;
        const bf16_t* vbase = Vt + (size_t)(h * 64 + q) * MT + hi * 8;
        const int ntiles = local ? 24 : 8;
#define TROW(t) (((t) < 8) ? crow0 + 32 * (t) : lrow0 + 32 * ((t) - 8))
#define TCOMP(FK, FV, t, NXT) do { const int t_ = (t); const int kr_ = (t_ - 8) >> 1, ct_ = (t_ - 8) & 1; const int br_ = (rs + kr_ - r + 7) * 31 + ct_ * 32 + 8 * hi + 15; \
            int ra_ = ct_ * 32 + 8 * hi - csA, rb_ = ct_ * 32 + 8 * hi - csB; asm volatile("" : "+v"(ra_), "+v"(rb_));     \
            attn_comp2(FK, FV, qa, qb4, A, B, t_ >= 8, bt, ra_, br_ - jA, rb_, br_ - jB, kbase, (NXT), kl, (local && t_ + 1 < 8) ? t_ + 1 : -1); } while (0)
        KFrag k0; VFrag fv;
        if (local) attn_loadk_lds(k0, kl, 0); else attn_loadk(k0, kbase, TROW(0));
        asm volatile("s_waitcnt lgkmcnt(0)" ::: "memory");
        for (int t = 0; t < ntiles; ++t) {
            if (local && t < 8) attn_loadv_lds(fv, vl, t); else attn_loadv(fv, vbase, TROW(t));
            TCOMP(k0, fv, t, (t + 1 < ntiles) ? TROW(t + 1) : -1);
        }
#undef TROW
#undef TCOMP
        attn_store(A, MIXb + (size_t)(qrow0 + q) * 1024 + h * 64 + 4 * hi);
        attn_store(B, MIXb + (size_t)(qrow0 + 32 + q) * 1024 + h * 64 + 4 * hi);
        asm volatile("s_waitcnt lgkmcnt(0)" ::: "memory");
    }
    const int mrows = (layer == 0) ? MT : MX;
    const int nskip = (layer == 0) ? 64 : 0;
    if (gw < nskip) return;
    for (int wi = gw - nskip; wi < mrows; wi += NGW - nskip) {
        const int g = wi & 3, m = (wi & ~3) + (lane >> 4), ch = g * 16 + (lane & 15);
        int jj, len;
        if (m < MX) { jj = m & 63; len = 64; } else { jj = (m - MX) & 255; len = 256; }
        const int base = m - jj;
        float a[8];
#pragma unroll
        for (int e = 0; e < 8; ++e) a[e] = 0.f;
        const bf16_t* up = Ub + (size_t)base * 512 + ch * 8;
#define POOLW(W2) do { const int lo = max(jj - (W2), 0), hi2 = min(jj + (W2), len); u32x4 uv[2 * (W2)]; \
            _Pragma("unroll") for (int t = 0; t < 2 * (W2); ++t) uv[t] = *(const u32x4*)(up + (size_t)min(lo + t, hi2 - 1) * 512); \
            _Pragma("unroll") for (int t = 0; t < 2 * (W2); ++t) { const float wgt = (lo + t < hi2) ? 1.0f : 0.0f; \
                _Pragma("unroll") for (int e = 0; e < 4; ++e) { a[2 * e] += wgt * __uint_as_float(uv[t][e] << 16); a[2 * e + 1] += wgt * __uint_as_float(uv[t][e] & 0xffff0000u); } } \
            const float ic = 1.0f / (float)(hi2 - lo); _Pragma("unroll") for (int e = 0; e < 8; ++e) a[e] *= ic; } while (0)
        if (g == 0) POOLW(1); else if (g == 1) POOLW(2); else if (g == 2) POOLW(4); else POOLW(8);
#undef POOLW
        const u32x4 us = *(const u32x4*)(Ub + (size_t)m * 512 + ch * 8);
        u32x4 o;
#pragma unroll
        for (int e = 0; e < 4; ++e) o[e] = cvtpk(a[2 * e] - __uint_as_float(us[e] << 16), a[2 * e + 1] - __uint_as_float(us[e] & 0xffff0000u));
        *(u32x4*)(MIXb + (size_t)m * 1024 + 512 + ch * 8) = o;
    }
}

__device__ __forceinline__ void run_phase(KParams P, int ph, LAS unsigned char* lds, int tid, int wave, int lane, int bx, int G) {
    unsigned char* ws = P->ws;
    float* MOD = (float*)(ws + WS_MOD);
    bf16_t* XN = (bf16_t*)(ws + WS_XN); bf16_t* Yb = (bf16_t*)(ws + WS_Y); bf16_t* H = (bf16_t*)(ws + WS_H);
    float* CTXS = (float*)(ws + WS_CTXS);
    if (ph == 0) { phase_p0(P, lds, tid, wave, lane, bx, G); return; }
    const int l = (ph == NPHASE - 1) ? 2 : (ph - 1) / 10, s = (ph == NPHASE - 1) ? 0 : (ph - 1) % 10;
    const int Mlate = (l == 1) ? MX : MT;
    if (s == 0 || s == 3 || s == 7) {
        int yl = l, gidx = 5, gpi = 3, nl = l, npre = 4, nsh = 6, M = Mlate; bool hasY = true, hasXN = true, useIn = false; float coef = 1.0f;
        if (s == 0) { yl = (l > 0) ? l - 1 : 0; gidx = 8; gpi = 5; npre = 0; nsh = 0; M = MT; coef = 0.5f; hasY = (l > 0); useIn = (l == 0);
                      if (l == 2) { hasXN = false; M = MX; nl = 1; } }
        else if (s == 3) { gidx = 2; gpi = 1; npre = 2; nsh = 3; M = MT; coef = 0.5f; useIn = (l == 0); }
        RowPass R;
        R.srcX = P->x; R.srcXb = useIn ? (const bf16_t*)nullptr : (const bf16_t*)(ws + WS_XS); R.srcC = useIn ? P->ctx : (const float*)CTXS;
        R.dstX = P->out; R.dstXb = (l == 2) ? (bf16_t*)nullptr : (bf16_t*)(ws + WS_XS); R.dstC = CTXS;
        R.YP = (const float*)(ws + WS_YP); R.nparts = (s == 7) ? 4 : 11;
        R.Yb = Yb; R.XN = XN; R.hasY = hasY; R.hasXN = hasXN; R.M = M; R.coef = coef;
        R.gate = MOD + (size_t)yl * 3 * NMODW + gidx * DM; R.gpost = P->normg + (yl * 6 + gpi) * DM;
        R.gpre = P->normg + (nl * 6 + npre) * DM; R.shift = MOD + (size_t)nl * 3 * NMODW + nsh * DM; R.scale = R.shift + DM;
        phase_row(R, lds, tid, wave, lane, bx, G);
        return;
    }
    if (s == 5) { phase_mix(P, l, lds, tid, wave, lane, bx, G); return; }
    const bool split = (s == 2 || s == 9 || s == 6) && (Mlate == MT || s == 2);
    const int npass = (s == 4 || split) ? 2 : 1;
    for (int pass = 0; pass < npass; ++pass) {
        pg8::Gemm g; EpiAny E; E.ropeC = (const float*)(ws + WS_ROPEC); E.ropeS = (const float*)(ws + WS_ROPES); E.pstride = 0; E.ntp = 0; int cu = bx, pm0 = 0, ksplit = 1, ntp = 0;
        if (s == 1 || s == 8) {
            const int sub = (s == 1) ? 0 : 1; const int M = (s == 1) ? MT : Mlate;
            g = pg8::Gemm{XN, (const bf16_t*)(ws + WS_WGU) + (size_t)(l * 2 + sub) * 5632 * 1024, M, 5632, 1024, 1024};
            E.mode = EPI_SWIGLU; E.perm = true; E.O = H; E.ldc = DFF;
        } else if (s == 6 || s == 2 || s == 9) {
            const bf16_t* A; const bf16_t* Bt; int K;
            if (s == 6) { A = (const bf16_t*)(ws + WS_MIX); Bt = (const bf16_t*)(ws + WS_WOUT) + (size_t)l * 1024 * 1024; K = 1024; }
            else { const int sub = (s == 2) ? 0 : 1; A = H; Bt = (const bf16_t*)(ws + WS_WD) + (size_t)(l * 2 + sub) * 1024 * DFF; K = DFF; }
            E.mode = EPI_F32; E.perm = false; E.ldc = 1024;
            if (pass == 0) { g = pg8::Gemm{A, Bt, MX, 1024, K, K}; E.mode = EPI_BF16; E.perm = true; E.O = Yb; }
            else { ntp = 4; ksplit = K / 256; pm0 = MX / 256; g = pg8::Gemm{A, Bt, MC, 1024, 256, K};
                   E.O = (float*)(ws + WS_YP) - (size_t)MX * 1024; E.pstride = MC * 1024; E.ntp = 4; }
        } else {
            const bf16_t* Wt = (const bf16_t*)(ws + WS_WIN) + (size_t)l * INW * 1024;
            if (pass == 0) { g = pg8::Gemm{XN, Wt, MT, 1536, 1024, 1024}; E.mode = EPI_QKU; E.perm = false; E.O = ws + WS_Q; E.ldc = 512; }
            else { g = pg8::Gemm{Wt + (size_t)1536 * 1024, XN, 512, MT, 1024, 1024}; E.mode = EPI_BF16; E.perm = true; E.O = ws + WS_VT; E.ldc = MT; cu = G - 1 - bx; }
        }
        pg8::StaticOrder S; S.init(g.M, g.N, G, cu, pm0, ksplit, ntp);
        pg8::gemm_phase<EpiAny, pg8::StaticOrder, true, true>(lds, g, S, E);
    }
}

__global__ void __launch_bounds__(NTHREADS, 2) mega(Params P, int ph_lo, int ph_hi) {
    extern __shared__ __attribute__((aligned(16))) unsigned char lds_raw[];
    LAS unsigned char* lds = (LAS unsigned char*)lds_raw;
    cg::grid_group grid = cg::this_grid();
    volatile LAS unsigned* bst = (volatile LAS unsigned*)(lds + 131072 + 64);
    if (threadIdx.x < 2) bst[threadIdx.x] = 0u;
    __syncthreads();
    XcdBarrier bar;
    { KParams kp0 = (KParams)__builtin_amdgcn_kernarg_segment_ptr(); bar = xcd_barrier_post((unsigned*)(kp0->ws + WS_BAR), bst); }
    KParams kp = (KParams)__builtin_amdgcn_kernarg_segment_ptr();
#if defined(PROBE_REP_PH)
    const int nextra = PROBE_REPS - 1;
#else
    const int nextra = 0;
#endif
    const int nsteps = ph_hi - ph_lo + nextra;
    for (int step = 0; step < nsteps; ++step) {
        int ph = ph_lo + step;
#if defined(PROBE_REP_PH)
        if (ph > PROBE_REP_PH) ph = (ph <= PROBE_REP_PH + nextra) ? PROBE_REP_PH : ph - nextra;
#endif
        asm volatile("" : "+s"(kp));
        int tid = threadIdx.x; asm volatile("" : "+v"(tid));
        const int lane = tid & 63, wave = __builtin_amdgcn_readfirstlane(tid >> 6);
        int bx = blockIdx.x, G = gridDim.x; asm volatile("" : "+s"(bx), "+s"(G));
        run_phase(kp, ph, lds, tid, wave, lane, bx, G);
        if (step + 1 < nsteps) { if (ph_lo < 0) grid.sync(); else xcd_barrier(bar); }
    }
}

extern "C" void kernel_launch(void* const* d_in, const int* in_sizes, int n_in, void* d_out, int out_size, void* d_ws, size_t ws_size, hipStream_t stream) {
    static int grid = 0;
    if (grid == 0) {
        if (n_in != 14 || in_sizes[0] != MX * DM || out_size != MX * DM || ws_size < WS_END) {
            fprintf(stderr, "kernel_launch: unexpected shapes (n_in %d, in0 %d, out %d, ws %zu < %zu)\n", n_in, n_in > 0 ? in_sizes[0] : -1, out_size, ws_size, (size_t)WS_END); grid = -1; return; }
        int dev = 0, cus = 0, per_cu = 0;
        (void)hipGetDevice(&dev); (void)hipDeviceGetAttribute(&cus, hipDeviceAttributeMultiprocessorCount, dev);
        if (hipFuncSetAttribute((const void*)mega, hipFuncAttributeMaxDynamicSharedMemorySize, LDS_BYTES) != hipSuccess) { fprintf(stderr, "kernel_launch: hipFuncSetAttribute failed\n"); grid = -1; return; }
        if (hipOccupancyMaxActiveBlocksPerMultiprocessor(&per_cu, (const void*)mega, NTHREADS, LDS_BYTES) != hipSuccess || per_cu < 1) { fprintf(stderr, "kernel_launch: occupancy query gave %d\n", per_cu); per_cu = 1; }
        (void)hipGetLastError();
        grid = cus * 1;
        if (grid <= 0) grid = 256;
    }
    if (grid < 0) return;
    if (hipMemsetAsync((char*)d_ws + WS_BAR, 0, 65536, stream) != hipSuccess) { fprintf(stderr, "kernel_launch: memset failed\n"); return; }
    Params p{};
    p.x = (const float*)d_in[0]; p.c = (const float*)d_in[1]; p.ctx = (const float*)d_in[2]; p.cctx = (const float*)d_in[3];
    p.wmod = (const float*)d_in[4]; p.bmod = (const float*)d_in[5]; p.normg = (const float*)d_in[6]; p.wgu = (const float*)d_in[7];
    p.wd = (const float*)d_in[8]; p.win = (const float*)d_in[9]; p.wout = (const float*)d_in[10]; p.rpb = (const float*)d_in[11];
    p.wpool = (const float*)d_in[12]; p.pscale = (const float*)d_in[13];
    p.out = (float*)d_out; p.ws = (unsigned char*)d_ws;
#if MK_MULTI
    for (int ph = 0; ph < NPHASE; ++ph) {
        int lo = ph, hi = ph + 1; void* args[] = {&p, &lo, &hi};
        hipError_t e = hipLaunchCooperativeKernel((const void*)mega, dim3(grid), dim3(NTHREADS), args, LDS_BYTES, stream);
        if (e != hipSuccess) { fprintf(stderr, "launch %d failed: %s\n", ph, hipGetErrorString(e)); break; }
    }
#else
#ifndef MK_PH_HI
#define MK_PH_HI NPHASE
#endif
#ifndef MK_PH_LO
#define MK_PH_LO 0
#endif
    int lo = MK_PH_LO, hi = MK_PH_HI; void* args[] = {&p, &lo, &hi};
    hipError_t e = hipLaunchCooperativeKernel((const void*)mega, dim3(grid), dim3(NTHREADS), args, LDS_BYTES, stream);
    if (e != hipSuccess) fprintf(stderr, "cooperative launch failed: %s (grid %d)\n", hipGetErrorString(e), grid);
#endif
}
```
